# Optimizing an MI355X kernel written in HIP

```python
import jax, jax.numpy as jnp
from jax import lax
import numpy as np

D_MODEL = 1024
BATCH = 8
SEQ = 4096
DEPTH = 1

N_F_GROUPS = 4
F_GROUP_DIM = 128
F_WIDTH = N_F_GROUPS * F_GROUP_DIM
N_S_GROUPS = 4
S_GROUP_DIM = 128
S_WIDTH = N_S_GROUPS * S_GROUP_DIM
CHUNK = 128
IN_WIDTH = F_WIDTH + 2 * S_WIDTH + 2 * D_MODEL
N_EXPERTS = 16
CAPACITY_FACTOR = 2
D_FF_EXPERT = 2048
EPS = 1e-6

kernel_name = "hybrid_fnet_gmlp_ec_moe_block"


def rms_norm(x, g):
    xf = x.astype(jnp.float32)
    y = xf * lax.rsqrt(jnp.mean(xf * xf, axis=-1, keepdims=True) + EPS)
    return (y * g.astype(jnp.float32)).astype(x.dtype)


def fourier_mixer(z):
    b, s, _ = z.shape
    zg = z.reshape(b, s, N_F_GROUPS, F_GROUP_DIM).astype(jnp.float32)
    zf = jnp.fft.fft2(zg, axes=(1, 3), norm="ortho").real
    return zf.reshape(b, s, F_WIDTH).astype(z.dtype)


def spatial_gating_mixer(u, v, ln_g, ln_b, w_s, b_s):
    b, s, _ = u.shape
    u = jax.nn.gelu(u)
    v = jax.nn.gelu(v)
    vg = v.reshape(b, s, N_S_GROUPS, S_GROUP_DIM).astype(jnp.float32)
    mu = jnp.mean(vg, axis=-1, keepdims=True)
    var = jnp.mean(jnp.square(vg - mu), axis=-1, keepdims=True)
    vn = (vg - mu) * lax.rsqrt(var + EPS)
    vn = vn * ln_g.reshape(N_S_GROUPS, S_GROUP_DIM).astype(jnp.float32) + ln_b.reshape(N_S_GROUPS, S_GROUP_DIM).astype(jnp.float32)
    vc = vn.astype(u.dtype).reshape(b, s // CHUNK, CHUNK, N_S_GROUPS, S_GROUP_DIM)
    mixed = jnp.einsum("hpq,bnqhc->bnphc", w_s, vc) + b_s.T[None, None, :, :, None]
    return u * mixed.reshape(b, s, S_WIDTH)


def expert_choice_moe(h, w_router, w_gate_e, w_up_e, w_down_e):
    b, s, _ = h.shape
    cap = CAPACITY_FACTOR * s // N_EXPERTS
    logits = jnp.einsum("bsd,de->bse", h, w_router).astype(jnp.float32)
    affinity = jax.nn.softmax(logits, axis=-1)
    gate_val, tok_idx = lax.top_k(jnp.transpose(affinity, (0, 2, 1)), cap)
    bidx = jnp.arange(b)[:, None, None]
    xe = h[bidx, tok_idx]
    a = jnp.einsum("becd,edf->becf", xe, w_gate_e)
    g = jnp.einsum("becd,edf->becf", xe, w_up_e)
    ye = jnp.einsum("becf,efd->becd", jax.nn.silu(a) * g, w_down_e)
    ye = ye * gate_val[..., None].astype(ye.dtype)
    return jnp.zeros_like(h).at[bidx, tok_idx].add(ye)


def setup_inputs(seed: int = 0) -> dict:
    key = jax.random.key(seed)
    ks = jax.random.split(key, 20)
    nrm = lambda k, shape, scale: jax.random.normal(k, shape, jnp.float32) * scale
    L, D = DEPTH, D_MODEL
    return {
        "x": nrm(ks[0], (BATCH, SEQ, D), 1.0),
        "norm1_g": 1.0 + nrm(ks[1], (L, D), 0.1),
        "w_in": nrm(ks[2], (L, D, IN_WIDTH), D ** -0.5),
        "sgu_ln_g": 1.0 + nrm(ks[3], (L, S_WIDTH), 0.1),
        "sgu_ln_b": nrm(ks[4], (L, S_WIDTH), 0.1),
        "w_spatial": nrm(ks[5], (L, N_S_GROUPS, CHUNK, CHUNK), CHUNK ** -0.5),
        "b_spatial": 1.0 + nrm(ks[6], (L, N_S_GROUPS, CHUNK), 0.1),
        "w_fourier_out": nrm(ks[7], (L, F_WIDTH, D), F_WIDTH ** -0.5),
        "w_sgu_out": nrm(ks[8], (L, S_WIDTH, D), S_WIDTH ** -0.5),
        "w_out": nrm(ks[9], (L, D, D), D ** -0.5),
        "norm2_g": 1.0 + nrm(ks[10], (L, D), 0.1),
        "w_router": nrm(ks[11], (L, D, N_EXPERTS), D ** -0.5),
        "w_gate_e": nrm(ks[12], (L, N_EXPERTS, D, D_FF_EXPERT), D ** -0.5),
        "w_up_e": nrm(ks[13], (L, N_EXPERTS, D, D_FF_EXPERT), D ** -0.5),
        "w_down_e": nrm(ks[14], (L, N_EXPERTS, D_FF_EXPERT, D), D_FF_EXPERT ** -0.5),
        "final_g": 1.0 + nrm(ks[15], (D,), 0.1),
    }


def reference(x, norm1_g, w_in, sgu_ln_g, sgu_ln_b, w_spatial, b_spatial, w_fourier_out, w_sgu_out, w_out,
              norm2_g, w_router, w_gate_e, w_up_e, w_down_e, final_g):
    cuts = [F_WIDTH, F_WIDTH + S_WIDTH, F_WIDTH + 2 * S_WIDTH, F_WIDTH + 2 * S_WIDTH + D_MODEL]
    for l in range(DEPTH):
        h = rms_norm(x, norm1_g[l])
        p = jnp.einsum("bsd,dk->bsk", h, w_in[l])
        z_f, u, v, g_f, g_s = jnp.split(p, cuts, axis=-1)
        y_f = jnp.einsum("bsk,kd->bsd", fourier_mixer(z_f), w_fourier_out[l])
        y_s = jnp.einsum("bsk,kd->bsd",
                         spatial_gating_mixer(u, v, sgu_ln_g[l], sgu_ln_b[l], w_spatial[l], b_spatial[l]),
                         w_sgu_out[l])
        merged = jax.nn.sigmoid(g_f) * y_f + jax.nn.sigmoid(g_s) * y_s
        x = x + jnp.einsum("bsd,de->bse", merged, w_out[l])
        h2 = rms_norm(x, norm2_g[l])
        x = x + expert_choice_moe(h2, w_router[l], w_gate_e[l], w_up_e[l], w_down_e[l])
    return rms_norm(x, final_g)
```

```cpp
#include <hip/hip_runtime.h>
#include <hip/hip_cooperative_groups.h>
#include <cstdio>
#include <cstdint>
namespace cg = cooperative_groups;

#ifndef MK_N_LAUNCHES
#define MK_N_LAUNCHES 1
#endif

#define LAS __attribute__((address_space(3)))
typedef unsigned short bf16_t;
typedef short bf16x8 __attribute__((ext_vector_type(8)));
typedef float f32x4 __attribute__((ext_vector_type(4)));
typedef float f32x2 __attribute__((ext_vector_type(2)));
typedef unsigned u32x4 __attribute__((ext_vector_type(4)));
typedef unsigned u32x2 __attribute__((ext_vector_type(2)));

constexpr int D = 1024, NB = 8, SEQ = 4096, MTOK = NB * SEQ;
constexpr int FW = 512, SWD = 512, NE = 16, CAP = 512, DFF = 2048;
constexpr int N1 = 4096;
constexpr int INW = 3584;
constexpr float EPS = 1e-6f;
constexpr int NPHASE = 10;

constexpr size_t MiB = 1u << 20;
constexpr size_t WS_RA = 0;
constexpr size_t WS_WD = 128 * MiB;
constexpr size_t WS_RH = 192 * MiB;
constexpr size_t WS_ZCS = WS_RH;
constexpr size_t WS_GU = WS_RH + 64 * MiB;
constexpr size_t WS_GV = WS_RH + 96 * MiB;
constexpr size_t WS_SGF = WS_RH + 128 * MiB;
constexpr size_t WS_SGS = WS_RH + 192 * MiB;
constexpr size_t WS_MRG = WS_RH;
constexpr size_t WS_H = WS_RH;
constexpr size_t WS_RS = 448 * MiB;
constexpr size_t WS_HN = WS_RS;
constexpr size_t WS_SG = WS_RS;
constexpr size_t WS_FM = WS_RS + 32 * MiB;
constexpr size_t WS_H2 = WS_RS;
constexpr size_t WS_WIN = 512 * MiB;
constexpr size_t WS_WFO = 520 * MiB;
constexpr size_t WS_WSO = 521 * MiB;
constexpr size_t WS_WOUT = 522 * MiB;
constexpr size_t WS_AFF = 524 * MiB;
constexpr size_t WS_INV = 526 * MiB;
constexpr size_t WS_IDX = 527 * MiB;
constexpr size_t WS_GATE = WS_IDX + 256 * 1024;
constexpr size_t WS_END = 528 * MiB;

constexpr int LDS_STAGE = 131072;
constexpr int LDS_X_OFF = LDS_STAGE;
constexpr int LDS_BYTES = 155648;

__device__ __forceinline__ unsigned f2bf(float f) { unsigned u = __builtin_bit_cast(unsigned, f); return (u + 0x7fffu + ((u >> 16) & 1u)) >> 16; }
__device__ __forceinline__ unsigned pk2(float lo, float hi) { return f2bf(lo) | (f2bf(hi) << 16); }
__device__ __forceinline__ unsigned cvt_pk_bf16(float lo, float hi) { unsigned r; asm volatile("v_cvt_pk_bf16_f32 %0, %1, %2" : "=v"(r) : "v"(lo), "v"(hi)); return r; }
__device__ __forceinline__ float bf_lo(unsigned w) { return __builtin_bit_cast(float, w << 16); }
__device__ __forceinline__ float bf_hi(unsigned w) { return __builtin_bit_cast(float, w & 0xffff0000u); }
__device__ __forceinline__ float wave_sum(float v) {
#pragma unroll
    for (int o = 1; o < 64; o <<= 1) v += __shfl_xor(v, o);
    return v;
}
__device__ __forceinline__ float fast_sigmoid(float x) { return __builtin_amdgcn_rcpf(1.0f + __builtin_amdgcn_exp2f(-1.44269504089f * x)); }
__device__ __forceinline__ float gelu_tanh(float x) {
    const float u = 1.5957691216f * (x + 0.044715f * x * x * x);
    return x * fast_sigmoid(u);
}
#define LDS_WAIT() asm volatile("s_waitcnt lgkmcnt(0)" ::: "memory")

namespace pg8 {
constexpr int BM = 256, BK = 64, HALF = 128, HTB = HALF * BK * 2, NXCD = 8, WGM = 8;
__device__ __forceinline__ int lds_byte(int r, int c) { const int st = (r >> 4) * 2 + (c >> 5), rr = r & 15, cc = c & 31, ob = rr * 64 + cc * 2; return st * 1024 + (ob ^ (((ob >> 9) & 1) << 5)); }
__device__ __forceinline__ void stage_rc(int b, int& R, int& C) { const int st = b / 1024, sb = b % 1024, swz = sb ^ (((sb >> 9) & 1) << 5); R = (st >> 1) * 16 + swz / 64; C = (st & 1) * 32 + (swz % 64) / 2; }
__device__ __forceinline__ int perm32(int rho) { const int n = rho >> 4, i = rho & 15; return 8 * (i >> 2) + 4 * n + (i & 3); }

struct Unit { const char* A; const char* B; const int* ridx; int pm, pn, kind; };

__device__ __forceinline__ bool static_tile(int nM, int nN, int G, int c, int i, int& pm, int& pn) {
    const int nwg = nM * nN; const long L = (long)i * G + c; if (L >= nwg) return false;
    int wgid = (int)L; { const int q = nwg / NXCD, r = nwg % NXCD, xcd = wgid % NXCD, off = wgid / NXCD; wgid = (xcd < r ? xcd * (q + 1) : r * (q + 1) + (xcd - r) * q) + off; }
    const int nig = WGM * nN, gid = wgid / nig, fm = gid * WGM, gsz = (nM - fm) < WGM ? (nM - fm) : WGM;
    pm = fm + ((wgid % nig) % gsz); pn = (wgid % nig) / gsz; return true;
}

template <class Epi, class Sched, bool GATHER>
__device__ __forceinline__ void gemm_phase(LAS unsigned char* lds, const int K, const Sched& S, const Epi& E) {
    const int tid = threadIdx.x, wid = __builtin_amdgcn_readfirstlane(tid >> 6), lane = tid & 63, wr = wid >> 2, wc = wid & 3, fr = lane & 15, fq = lane >> 4;
    const int nt = K / BK;
    unsigned voffA[2], voffB[2]; int RA[2], CA2[2];
#pragma unroll
    for (int i = 0; i < 2; ++i) { int R, C; stage_rc(tid * 16 + i * 8192, R, C); const int Rb = Epi::PERM ? ((R & ~31) + perm32(R & 31)) : R;
        voffA[i] = (unsigned)(R * K + C) * 2u; voffB[i] = (unsigned)(Rb * K + C) * 2u; RA[i] = R; CA2[i] = C * 2; }
    const size_t kstep = (size_t)(BK * 2);
    const size_t hstep = (size_t)HALF * K * 2;
    const unsigned ldsw = (unsigned)wid * 1024u;
    const int aoff = lds_byte(wr * 64 + fr, fq * 8), boff = lds_byte(wc * 32 + fr, fq * 8);
#define PG8_SA(b, h) (((b) * 2 + (h)) * HTB)
#define PG8_SB(b, h) ((4 + (b) * 2 + (h)) * HTB)
#define PG8_GLDS(bufoff, gptr, _i) __builtin_amdgcn_global_load_lds((const unsigned*)(gptr), (LAS unsigned*)(lds + (bufoff) + ldsw + (_i) * 8192), 16, 0, 0)
#define PG8_STAGE_B(bufoff, gbase) do { _Pragma("unroll") for (int _i = 0; _i < 2; ++_i) PG8_GLDS(bufoff, (const char*)(gbase) + voffB[_i], _i); } while (0)
#define PG8_STAGE_A(bufoff, gbase, h, go) do { _Pragma("unroll") for (int _i = 0; _i < 2; ++_i) { \
        if constexpr (GATHER) PG8_GLDS(bufoff, (const char*)(gbase) + go[h][_i], _i); else PG8_GLDS(bufoff, (const char*)(gbase) + (h) * hstep + voffA[_i], _i); } } while (0)
#define PG8_LDA(dst, b, h) do { _Pragma("unroll") for (int m = 0; m < 4; ++m) _Pragma("unroll") for (int k = 0; k < 2; ++k) dst[m][k] = *(const LAS bf16x8*)(lds + PG8_SA(b, h) + aoff + m * 2048 + k * 1024); } while (0)
#define PG8_LDB(dst, b, h) do { _Pragma("unroll") for (int n = 0; n < 2; ++n) _Pragma("unroll") for (int k = 0; k < 2; ++k) dst[n][k] = *(const LAS bf16x8*)(lds + PG8_SB(b, h) + boff + n * 2048 + k * 1024); } while (0)
#define PG8_MMA(ai, bj, At, Bt) do { __builtin_amdgcn_s_setprio(1); _Pragma("unroll") for (int m = 0; m < 4; ++m) _Pragma("unroll") for (int n = 0; n < 2; ++n) _Pragma("unroll") for (int k = 0; k < 2; ++k) \
        acc[ai][bj][m][n] = __builtin_amdgcn_mfma_f32_16x16x32_bf16(Bt[n][k], At[m][k], acc[ai][bj][m][n], 0, 0, 0); __builtin_amdgcn_s_setprio(0); } while (0)
#define PG8_WAIT_V(n) asm volatile("s_waitcnt vmcnt(" #n ")" ::: "memory")
#define PG8_WAIT_L(n) asm volatile("s_waitcnt lgkmcnt(" #n ")" ::: "memory")
#define PG8_BAR __builtin_amdgcn_s_barrier()
#define PG8_SCHED __builtin_amdgcn_sched_barrier(0)
#define PG8_GOFS(dst, u) do { if constexpr (GATHER) { _Pragma("unroll") for (int _h = 0; _h < 2; ++_h) _Pragma("unroll") for (int _i = 0; _i < 2; ++_i) \
        dst[_h][_i] = (unsigned)(u).ridx[_h * HALF + RA[_i]] * (unsigned)(K * 2) + (unsigned)CA2[_i]; } } while (0)
    Unit cur, nxt; int ui = 0;
    if (!S.next(0, cur)) return;
    f32x4 acc[2][2][4][2];
#pragma unroll
    for (int a = 0; a < 2; ++a)
#pragma unroll
        for (int b = 0; b < 2; ++b)
#pragma unroll
            for (int m = 0; m < 4; ++m)
#pragma unroll
                for (int n = 0; n < 2; ++n) acc[a][b][m][n] = (f32x4){0.f, 0.f, 0.f, 0.f};
    bf16x8 At[4][2], B0[2][2], B1[2][2];
    unsigned gA[2][2] = {{0u, 0u}, {0u, 0u}}, gN[2][2] = {{0u, 0u}, {0u, 0u}};
    PG8_GOFS(gA, cur);
    const char* cA = cur.A; const char* cB = cur.B;
    PG8_STAGE_B(PG8_SB(0, 0), cB); PG8_STAGE_B(PG8_SB(0, 1), cB + hstep); PG8_STAGE_A(PG8_SA(0, 0), cA, 0, gA); PG8_STAGE_A(PG8_SA(0, 1), cA, 1, gA);
    if (wr == 1) PG8_BAR;
    PG8_WAIT_V(2); PG8_BAR;
    PG8_STAGE_B(PG8_SB(1, 0), cB + kstep); PG8_STAGE_A(PG8_SA(1, 0), cA + kstep, 0, gA); PG8_STAGE_B(PG8_SB(1, 1), cB + hstep + kstep);
    PG8_WAIT_V(6); PG8_BAR;
    for (;;) {
        const bool has_next = S.next(ui + 1, nxt);
        if (!has_next) nxt = cur;
        PG8_GOFS(gN, nxt);
        const char* nA = nxt.A; const char* nB = nxt.B;
        for (int t = 0; t < nt; t += 2) {
            const bool last = (t == nt - 2);
            const char* a1 = cA + (size_t)(t + 1) * kstep;
            const char* a2 = last ? nA : cA + (size_t)(t + 2) * kstep; const char* b2 = last ? nB : cB + (size_t)(t + 2) * kstep;
            const char* a3 = a2 + kstep; const char* b3 = b2 + kstep;
            unsigned g2[2][2];
#pragma unroll
            for (int _h = 0; _h < 2; ++_h)
#pragma unroll
                for (int _i = 0; _i < 2; ++_i) g2[_h][_i] = last ? gN[_h][_i] : gA[_h][_i];
            PG8_LDB(B0, 0, 0); PG8_LDB(B1, 0, 1); PG8_SCHED; PG8_LDA(At, 0, 0); PG8_STAGE_A(PG8_SA(1, 1), a1, 1, gA);
            PG8_WAIT_V(8); PG8_WAIT_L(0); PG8_BAR; PG8_MMA(0, 0, At, B0); PG8_MMA(0, 1, At, B1); PG8_BAR; PG8_SCHED;
            PG8_LDA(At, 0, 1); PG8_STAGE_B(PG8_SB(0, 0), b2); PG8_STAGE_B(PG8_SB(0, 1), b2 + hstep); PG8_STAGE_A(PG8_SA(0, 0), a2, 0, g2);
            PG8_WAIT_V(8); PG8_WAIT_L(0); PG8_BAR; PG8_MMA(1, 0, At, B0); PG8_MMA(1, 1, At, B1); PG8_BAR; PG8_SCHED;
            PG8_LDB(B0, 1, 0); PG8_LDB(B1, 1, 1); PG8_SCHED; PG8_LDA(At, 1, 0); PG8_STAGE_A(PG8_SA(0, 1), a2, 1, g2);
            PG8_WAIT_V(8); PG8_WAIT_L(0); PG8_BAR; PG8_MMA(0, 0, At, B0); PG8_MMA(0, 1, At, B1); PG8_BAR; PG8_SCHED;
            PG8_LDA(At, 1, 1); PG8_STAGE_B(PG8_SB(1, 0), b3); PG8_STAGE_B(PG8_SB(1, 1), b3 + hstep); PG8_STAGE_A(PG8_SA(1, 0), a3, 0, g2);
            PG8_WAIT_V(8); PG8_WAIT_L(0); PG8_BAR; PG8_MMA(1, 0, At, B0); PG8_MMA(1, 1, At, B1); PG8_BAR; PG8_SCHED;
        }
        if (wr == 0) PG8_BAR;
        const bool keep = E(acc, cur, wr, wc, fr, fq);
        if (!has_next) break;
        if (!keep) {
#pragma unroll
            for (int a = 0; a < 2; ++a)
#pragma unroll
                for (int b = 0; b < 2; ++b)
#pragma unroll
                    for (int m = 0; m < 4; ++m)
#pragma unroll
                        for (int n = 0; n < 2; ++n) acc[a][b][m][n] = (f32x4){0.f, 0.f, 0.f, 0.f};
        }
        cur = nxt; cA = nA; cB = nB; ++ui;
#pragma unroll
        for (int _h = 0; _h < 2; ++_h)
#pragma unroll
            for (int _i = 0; _i < 2; ++_i) gA[_h][_i] = gN[_h][_i];
        if (wr == 1) PG8_BAR;
    }
    PG8_WAIT_V(0);
    PG8_BAR;
#undef PG8_SA
#undef PG8_SB
#undef PG8_GLDS
#undef PG8_STAGE_A
#undef PG8_STAGE_B
#undef PG8_LDA
#undef PG8_LDB
#undef PG8_MMA
#undef PG8_WAIT_V
#undef PG8_WAIT_L
#undef PG8_BAR
#undef PG8_SCHED
#undef PG8_GOFS
}
}
using pg8::Unit;

struct Args {
    const float* in[16];
    float* out;
    unsigned char* ws;
    int ph_lo, ph_hi;
};

struct Ctx {
    LAS unsigned char* lds;
    int tid, lane, wave, G, bid;
    const float *x, *norm1_g, *w_in, *ln_g, *ln_b, *w_sp, *b_sp, *w_fo, *w_so, *w_out, *norm2_g, *w_router, *w_gate, *w_up, *w_down, *final_g;
    float* out;
    unsigned char* ws;
};

__device__ __forceinline__ void transpose_item(const float* W, int N, int k0, int n0, bf16_t* WT, size_t dst_row0, int Kd, LAS float* scr, int lane) {
#pragma unroll 8
    for (int i = 0; i < 32; ++i) { const int kk = 2 * i + (lane >> 5); scr[kk * 33 + (lane & 31)] = W[(size_t)(k0 + kk) * N + n0 + (lane & 31)]; }
    LDS_WAIT(); asm volatile("" ::: "memory");
    const int c = lane & 7;
#pragma unroll
    for (int j = 0; j < 4; ++j) { const int n = (lane >> 3) + 8 * j; const LAS float* s = scr + (8 * c) * 33 + n;
        u32x4 o; o.x = pk2(s[0 * 33], s[1 * 33]); o.y = pk2(s[2 * 33], s[3 * 33]); o.z = pk2(s[4 * 33], s[5 * 33]); o.w = pk2(s[6 * 33], s[7 * 33]);
        *(u32x4*)(WT + (dst_row0 + n) * (size_t)Kd + k0 + 8 * c) = o; }
    LDS_WAIT(); asm volatile("" ::: "memory");
}

__device__ __forceinline__ void rms_row_to_bf16(const float* xrow, const float* g, bf16_t* orow, int lane) {
    const f32x4* xr = (const f32x4*)xrow + lane; const f32x4* gr = (const f32x4*)g + lane;
    f32x4 v[4]; float s = 0.f;
#pragma unroll
    for (int j = 0; j < 4; ++j) { v[j] = xr[64 * j]; s += (v[j].x * v[j].x + v[j].y * v[j].y) + (v[j].z * v[j].z + v[j].w * v[j].w); }
    const float rstd = 1.0f / sqrtf(wave_sum(s) * (1.f / D) + EPS);
    u32x2* o8 = (u32x2*)orow + lane;
#pragma unroll
    for (int j = 0; j < 4; ++j) { const f32x4 gg = gr[64 * j]; u32x2 w; w.x = pk2(v[j].x * rstd * gg.x, v[j].y * rstd * gg.y); w.y = pk2(v[j].z * rstd * gg.z, v[j].w * rstd * gg.w); o8[64 * j] = w; }
}

__device__ __forceinline__ void p0_prep(const Ctx& F) {
    LAS float* scr = (LAS float*)(F.lds + F.wave * 16384);
    LAS float* tab4096 = (LAS float*)(F.lds + LDS_X_OFF);
    LAS float* tab128 = (LAS float*)(F.lds + LDS_X_OFF + 16384);
    for (int m = F.tid; m < 4096; m += 512) tab4096[m] = cospif((float)m * (1.0f / 2048.0f));
    if (F.tid < 128) tab128[F.tid] = cospif((float)F.tid * (1.0f / 64.0f));
    __syncthreads();
    const int gw = F.bid * 8 + F.wave, NGW = F.G * 8;
    bf16_t* WinT = (bf16_t*)(F.ws + WS_WIN);
    {
        constexpr int I1 = 16 * 96, I2 = 8 * 32, I3 = 8 * 32, I4 = 16 * 32, I5 = 16 * 32 * 32;
        constexpr int NIT = I1 + I2 + I3 + I4 + I5;
        for (int it = gw; it < NIT; it += NGW) {
            int r = it;
            if (r < I1) { const int kb = r / 96, nb = r % 96; transpose_item(F.w_in, INW, 64 * kb, 512 + 32 * nb, WinT, (size_t)(1024 + 32 * nb), D, scr, F.lane); continue; } r -= I1;
            if (r < I2) { const int kb = r / 32, nb = r % 32; transpose_item(F.w_fo, D, 64 * kb, 32 * nb, (bf16_t*)(F.ws + WS_WFO), (size_t)(32 * nb), FW, scr, F.lane); continue; } r -= I2;
            if (r < I3) { const int kb = r / 32, nb = r % 32; transpose_item(F.w_so, D, 64 * kb, 32 * nb, (bf16_t*)(F.ws + WS_WSO), (size_t)(32 * nb), SWD, scr, F.lane); continue; } r -= I3;
            if (r < I4) { const int kb = r / 32, nb = r % 32; transpose_item(F.w_out, D, 64 * kb, 32 * nb, (bf16_t*)(F.ws + WS_WOUT), (size_t)(32 * nb), D, scr, F.lane); continue; } r -= I4;
            { const int e = r >> 10, q = r & 1023, kb = q >> 5, nb = q & 31;
              transpose_item(F.w_down + (size_t)e * DFF * D, D, 64 * kb, 32 * nb, (bf16_t*)(F.ws + WS_WD) + (size_t)e * D * DFF, (size_t)(32 * nb), DFF, scr, F.lane); }
        }
    }
    {
        const float sc = 0.08838834764831845f;
        for (int it = gw; it < 4096; it += NGW) {
            const int g = it >> 10, dt = (it >> 4) & 63, jt = it & 15;
            const int d0 = dt * 16, j0 = jt * 16;
            const int jj = (j0 + (F.lane & 15)) & 127; const int shift = (j0 >= 128) ? 96 : 0;
            const float* ap = F.w_in + (size_t)(d0 + (F.lane & 15)) * INW + g * 128 + (F.lane >> 4);
            f32x4 acc = (f32x4){0.f, 0.f, 0.f, 0.f};
#pragma unroll 8
            for (int ks = 0; ks < 32; ++ks) {
                const int c = ks * 4 + (F.lane >> 4);
                const float a = ap[ks * 4];
                const float b = tab128[(jj * c + shift) & 127] * sc;
                acc = __builtin_amdgcn_mfma_f32_16x16x4f32(a, b, acc, 0, 0, 0);
            }
            u32x2 w; w.x = pk2(acc[0], acc[1]); w.y = pk2(acc[2], acc[3]);
            *(u32x2*)(WinT + (size_t)(g * 256 + j0 + (F.lane & 15)) * D + d0 + 4 * (F.lane >> 4)) = w;
        }
    }
    {
        bf16_t* HN = (bf16_t*)(F.ws + WS_HN);
        for (int m = gw; m < MTOK; m += NGW) rms_row_to_bf16(F.x + (size_t)m * D, F.norm1_g, HN + (size_t)m * D, F.lane);
    }
    {
        bf16_t* DM = (bf16_t*)(F.ws + WS_RA);
        const int gt = F.bid * 512 + F.tid, NT = F.G * 512;
        for (int q = gt; q < 4096 * 1024; q += NT) {
            const int k = q >> 10, cc = q & 1023, s0 = 8 * (cc & 511), add = (cc >> 9) ? 1024 : 0;
            float v[8];
#pragma unroll
            for (int j = 0; j < 8; ++j) v[j] = tab4096[(k * (s0 + j) + add) & 4095] * (1.0f / 64.0f);
            u32x4 o; o.x = pk2(v[0], v[1]); o.y = pk2(v[2], v[3]); o.z = pk2(v[4], v[5]); o.w = pk2(v[6], v[7]);
            *(u32x4*)(DM + (size_t)k * 8192 + (cc >> 9) * 4096 + s0) = o;
        }
    }
}

struct Sched1 {
    const char* A; const char* B; int G, c;
    __device__ __forceinline__ bool next(int i, Unit& u) const {
        int pm, pn; if (!pg8::static_tile(MTOK / 256, N1 / 256, G, c, i, pm, pn)) return false;
        u.A = A + (size_t)pm * 256 * D * 2; u.B = B + (size_t)pn * 256 * D * 2; u.ridx = nullptr; u.pm = pm; u.pn = pn; u.kind = 0; return true;
    }
};
struct Epi1 {
    static constexpr bool PERM = true;
    unsigned char* ws;
    __device__ __forceinline__ bool operator()(f32x4 (&acc)[2][2][4][2], const Unit& u, int wr, int wc, int fr, int fq) const {
        const int pn = u.pn;
        if (pn < 4) {
            bf16_t* Z = (bf16_t*)(ws + WS_ZCS);
            const int b = u.pm >> 4, s0 = (u.pm & 15) * 256 + wr * 64 + fr;
#pragma unroll
            for (int bj = 0; bj < 2; ++bj)
#pragma unroll
                for (int n = 0; n < 2; ++n)
#pragma unroll
                    for (int j = 0; j < 4; ++j) {
                        const int jcol = 32 * wc + 8 * fq + 4 * n + j;
                        bf16_t* zr = Z + (size_t)((b * 4 + pn) * 128 + jcol) * 8192 + bj * 4096 + s0;
#pragma unroll
                        for (int ai = 0; ai < 2; ++ai)
#pragma unroll
                            for (int m = 0; m < 4; ++m) zr[ai * 128 + m * 16] = (bf16_t)f2bf(acc[ai][bj][m][n][j]);
                    }
            return false;
        }
        bf16_t* base; int ldc, colt; int act;
        if (pn < 6) { base = (bf16_t*)(ws + WS_GU); ldc = 512; colt = (pn - 4) * 256; act = 0; }
        else if (pn < 8) { base = (bf16_t*)(ws + WS_GV); ldc = 512; colt = (pn - 6) * 256; act = 0; }
        else if (pn < 12) { base = (bf16_t*)(ws + WS_SGF); ldc = 1024; colt = (pn - 8) * 256; act = 1; }
        else { base = (bf16_t*)(ws + WS_SGS); ldc = 1024; colt = (pn - 12) * 256; act = 1; }
        const int row0 = u.pm * 256 + wr * 64 + fr, col0 = colt + wc * 32 + 8 * fq;
#pragma unroll
        for (int ai = 0; ai < 2; ++ai)
#pragma unroll
            for (int m = 0; m < 4; ++m) { bf16_t* rowp = base + (size_t)(row0 + ai * 128 + m * 16) * ldc + col0;
#pragma unroll
                for (int bj = 0; bj < 2; ++bj) { f32x4 v0 = acc[ai][bj][m][0], v1 = acc[ai][bj][m][1];
                    if (act == 0) {
#pragma unroll
                        for (int j = 0; j < 4; ++j) { v0[j] = gelu_tanh(v0[j]); v1[j] = gelu_tanh(v1[j]); }
                    } else {
#pragma unroll
                        for (int j = 0; j < 4; ++j) { v0[j] = fast_sigmoid(v0[j]); v1[j] = fast_sigmoid(v1[j]); }
                    }
                    u32x4 w; w.x = cvt_pk_bf16(v0[0], v0[1]); w.y = cvt_pk_bf16(v0[2], v0[3]); w.z = cvt_pk_bf16(v1[0], v1[1]); w.w = cvt_pk_bf16(v1[2], v1[3]);
                    *(u32x4*)(rowp + bj * 128) = w; } }
        return false;
    }
};

__device__ __forceinline__ void p2_sgu(const Ctx& F) {
    constexpr int PITCH = 136;
    LAS bf16_t* Ws = (LAS bf16_t*)(F.lds);
    LAS bf16_t* Vt = (LAS bf16_t*)(F.lds + 128 * PITCH * 2);
    const bf16_t* GU = (const bf16_t*)(F.ws + WS_GU); const bf16_t* GV = (const bf16_t*)(F.ws + WS_GV); bf16_t* SG = (bf16_t*)(F.ws + WS_SG);
    const int lane = F.lane, wave = F.wave;
    for (int tt = F.bid; tt < 1024; tt += F.G) {
        const int h = tt & 3, bn = tt >> 2; const size_t r0 = (size_t)bn * 128;
        __syncthreads();
        { const float* wsrc = F.w_sp + (size_t)h * 128 * 128;
#pragma unroll
          for (int i = 0; i < 8; ++i) { const int idx = F.tid * 4 + i * 2048; const int p = idx >> 7, q = idx & 127; const f32x4 v = *(const f32x4*)(wsrc + idx);
              u32x2 w; w.x = pk2(v.x, v.y); w.y = pk2(v.z, v.w); *(LAS u32x2*)(Ws + p * PITCH + q) = w; } }
        { const float g0 = F.ln_g[h * 128 + 2 * lane], g1 = F.ln_g[h * 128 + 2 * lane + 1], b0 = F.ln_b[h * 128 + 2 * lane], b1 = F.ln_b[h * 128 + 2 * lane + 1];
#pragma unroll 4
          for (int i = 0; i < 16; ++i) { const int q = wave * 16 + i;
              const unsigned w = *(const unsigned*)(GV + (r0 + q) * 512 + h * 128 + 2 * lane);
              const float a = bf_lo(w), b = bf_hi(w);
              const float mu = wave_sum(a + b) * (1.0f / 128.0f); const float da = a - mu, db = b - mu;
              const float var = wave_sum(da * da + db * db) * (1.0f / 128.0f); const float rs = 1.0f / sqrtf(var + EPS);
              Vt[(2 * lane) * PITCH + q] = (bf16_t)f2bf(da * rs * g0 + b0); Vt[(2 * lane + 1) * PITCH + q] = (bf16_t)f2bf(db * rs * g1 + b1); } }
        __syncthreads();
        f32x4 acc[8];
#pragma unroll
        for (int ct = 0; ct < 8; ++ct) acc[ct] = (f32x4){0.f, 0.f, 0.f, 0.f};
#pragma unroll
        for (int ks = 0; ks < 4; ++ks) {
            const bf16x8 bw = *(const LAS bf16x8*)(Ws + (wave * 16 + (lane & 15)) * PITCH + ks * 32 + 8 * (lane >> 4));
#pragma unroll
            for (int ct = 0; ct < 8; ++ct) { const bf16x8 av = *(const LAS bf16x8*)(Vt + (ct * 16 + (lane & 15)) * PITCH + ks * 32 + 8 * (lane >> 4));
                acc[ct] = __builtin_amdgcn_mfma_f32_16x16x32_bf16(av, bw, acc[ct], 0, 0, 0); }
        }
        const int p = wave * 16 + (lane & 15); const float bs = F.b_sp[h * 128 + p];
#pragma unroll
        for (int ct = 0; ct < 8; ++ct) { const int c = ct * 16 + 4 * (lane >> 4); const size_t off = (r0 + p) * 512 + h * 128 + c;
            const u32x2 uu = *(const u32x2*)(GU + off);
            u32x2 o; o.x = pk2(bf_lo(uu.x) * (acc[ct][0] + bs), bf_hi(uu.x) * (acc[ct][1] + bs)); o.y = pk2(bf_lo(uu.y) * (acc[ct][2] + bs), bf_hi(uu.y) * (acc[ct][3] + bs));
            *(u32x2*)(SG + off) = o; }
    }
    __syncthreads();
}

struct Sched2 {
    const char* A; const char* B; int G, c;
    __device__ __forceinline__ bool next(int i, Unit& u) const {
        int pm, pn; if (!pg8::static_tile(16, 16, G, c, i, pm, pn)) return false;
        u.A = A + (size_t)pm * 256 * 8192 * 2; u.B = B + (size_t)pn * 256 * 8192 * 2; u.ridx = nullptr; u.pm = pm; u.pn = pn; u.kind = 0; return true;
    }
};
struct EpiFm {
    static constexpr bool PERM = true;
    bf16_t* FM;
    __device__ __forceinline__ bool operator()(f32x4 (&acc)[2][2][4][2], const Unit& u, int wr, int wc, int fr, int fq) const {
        bf16_t* base = FM + (size_t)(u.pn >> 1) * SEQ * FW + (u.pn & 1) * 256;
        const int row0 = u.pm * 256 + wr * 64 + fr, col0 = wc * 32 + 8 * fq;
#pragma unroll
        for (int ai = 0; ai < 2; ++ai)
#pragma unroll
            for (int m = 0; m < 4; ++m) { bf16_t* rowp = base + (size_t)(row0 + ai * 128 + m * 16) * FW + col0;
#pragma unroll
                for (int bj = 0; bj < 2; ++bj) { const f32x4 v0 = acc[ai][bj][m][0], v1 = acc[ai][bj][m][1];
                    u32x4 w; w.x = cvt_pk_bf16(v0[0], v0[1]); w.y = cvt_pk_bf16(v0[2], v0[3]); w.z = cvt_pk_bf16(v1[0], v1[1]); w.w = cvt_pk_bf16(v1[2], v1[3]);
                    *(u32x4*)(rowp + bj * 128) = w; } }
        return false;
    }
};

struct Sched3 {
    const char* A0; const char* A1; const char* B0; const char* B1; int G, c;
    __device__ __forceinline__ bool next(int i, Unit& u) const {
        int pm, pn; if (!pg8::static_tile(MTOK / 256, D / 256, G, c, i >> 1, pm, pn)) return false;
        const int sub = i & 1;
        u.A = (sub ? A1 : A0) + (size_t)pm * 256 * 512 * 2; u.B = (sub ? B1 : B0) + (size_t)pn * 256 * 512 * 2; u.ridx = nullptr; u.pm = pm; u.pn = pn; u.kind = sub; return true;
    }
};
struct Epi3 {
    static constexpr bool PERM = true;
    const bf16_t* SGF; const bf16_t* SGS; bf16_t* MRG;
    __device__ __forceinline__ bool operator()(f32x4 (&acc)[2][2][4][2], const Unit& u, int wr, int wc, int fr, int fq) const {
        const int row0 = u.pm * 256 + wr * 64 + fr, col0 = u.pn * 256 + wc * 32 + 8 * fq;
        if (u.kind == 0) {
#pragma unroll
            for (int ai = 0; ai < 2; ++ai)
#pragma unroll
                for (int m = 0; m < 4; ++m) { const size_t off = (size_t)(row0 + ai * 128 + m * 16) * D + col0;
#pragma unroll
                    for (int bj = 0; bj < 2; ++bj) { const u32x4 f = *(const u32x4*)(SGF + off + bj * 128); const u32x4 s = *(const u32x4*)(SGS + off + bj * 128);
                        f32x4& v0 = acc[ai][bj][m][0]; f32x4& v1 = acc[ai][bj][m][1];
                        v0[0] *= bf_lo(f.x) * __builtin_amdgcn_rcpf(bf_lo(s.x)); v0[1] *= bf_hi(f.x) * __builtin_amdgcn_rcpf(bf_hi(s.x));
                        v0[2] *= bf_lo(f.y) * __builtin_amdgcn_rcpf(bf_lo(s.y)); v0[3] *= bf_hi(f.y) * __builtin_amdgcn_rcpf(bf_hi(s.y));
                        v1[0] *= bf_lo(f.z) * __builtin_amdgcn_rcpf(bf_lo(s.z)); v1[1] *= bf_hi(f.z) * __builtin_amdgcn_rcpf(bf_hi(s.z));
                        v1[2] *= bf_lo(f.w) * __builtin_amdgcn_rcpf(bf_lo(s.w)); v1[3] *= bf_hi(f.w) * __builtin_amdgcn_rcpf(bf_hi(s.w)); } }
            return true;
        }
#pragma unroll
        for (int ai = 0; ai < 2; ++ai)
#pragma unroll
            for (int m = 0; m < 4; ++m) { const size_t off = (size_t)(row0 + ai * 128 + m * 16) * D + col0;
#pragma unroll
                for (int bj = 0; bj < 2; ++bj) { const u32x4 s = *(const u32x4*)(SGS + off + bj * 128);
                    const f32x4 v0 = acc[ai][bj][m][0], v1 = acc[ai][bj][m][1];
                    u32x4 w; w.x = cvt_pk_bf16(v0[0] * bf_lo(s.x), v0[1] * bf_hi(s.x)); w.y = cvt_pk_bf16(v0[2] * bf_lo(s.y), v0[3] * bf_hi(s.y));
                    w.z = cvt_pk_bf16(v1[0] * bf_lo(s.z), v1[1] * bf_hi(s.z)); w.w = cvt_pk_bf16(v1[2] * bf_lo(s.w), v1[3] * bf_hi(s.w));
                    *(u32x4*)(MRG + off + bj * 128) = w; } }
        return false;
    }
};

struct Sched4 {
    const char* A; const char* B; int G, c;
    __device__ __forceinline__ bool next(int i, Unit& u) const {
        int pm, pn; if (!pg8::static_tile(MTOK / 256, D / 256, G, c, i, pm, pn)) return false;
        u.A = A + (size_t)pm * 256 * D * 2; u.B = B + (size_t)pn * 256 * D * 2; u.ridx = nullptr; u.pm = pm; u.pn = pn; u.kind = 0; return true;
    }
};
struct Epi4 {
    static constexpr bool PERM = false;
    const float* X; float* O;
    __device__ __forceinline__ bool operator()(f32x4 (&acc)[2][2][4][2], const Unit& u, int wr, int wc, int fr, int fq) const {
        const int row0 = u.pm * 256 + wr * 64 + fr, col0 = u.pn * 256 + wc * 32 + 4 * fq;
#pragma unroll
        for (int ai = 0; ai < 2; ++ai)
#pragma unroll
            for (int m = 0; m < 4; ++m) { const size_t off = (size_t)(row0 + ai * 128 + m * 16) * D + col0;
#pragma unroll
                for (int bj = 0; bj < 2; ++bj)
#pragma unroll
                    for (int n = 0; n < 2; ++n) { const f32x4 xv = *(const f32x4*)(X + off + bj * 128 + n * 16); *(f32x4*)(O + off + bj * 128 + n * 16) = xv + acc[ai][bj][m][n]; }
                asm volatile("" ::: "memory"); }
        return false;
    }
};

__device__ __forceinline__ void p5_rows(const Ctx& F) {
    LAS float* scr = (LAS float*)(F.lds + F.wave * 16384);
    const int gw = F.bid * 8 + F.wave, NGW = F.G * 8;
    {
        bf16_t* WG = (bf16_t*)(F.ws + WS_RA);
        for (int it = gw; it < 32768; it += NGW) {
            const int e = it >> 11, src = (it >> 10) & 1, q = it & 1023, kb = q >> 6, nb = q & 63;
            const int f0 = 32 * nb; const size_t dst_row0 = (size_t)e * 4096 + (size_t)(f0 >> 7) * 256 + (src ? 128 : 0) + (f0 & 127);
            transpose_item((src ? F.w_up : F.w_gate) + (size_t)e * D * DFF, DFF, 64 * kb, f0, WG, dst_row0, D, scr, F.lane);
        }
    }
    __syncthreads();
    LAS f32x4* WR = (LAS f32x4*)F.lds;
    for (int i = F.tid; i < 1024 * 4; i += 512) { const int d = i >> 2, e4 = i & 3; WR[(((d >> 8) * 4 + (d & 3)) * 4 + e4) * 64 + ((d >> 2) & 63)] = ((const f32x4*)F.w_router)[i]; }
    __syncthreads();
    const float* X1 = F.out; bf16_t* H2 = (bf16_t*)(F.ws + WS_H2); float* AFF = (float*)(F.ws + WS_AFF);
    const int lane = F.lane;
    f32x4 gg[4];
#pragma unroll
    for (int j = 0; j < 4; ++j) gg[j] = ((const f32x4*)F.norm2_g)[64 * j + lane];
    for (int m = gw; m < MTOK; m += NGW) {
        const f32x4* xr = (const f32x4*)(X1 + (size_t)m * D) + lane;
        f32x4 v[4]; float s = 0.f;
#pragma unroll
        for (int j = 0; j < 4; ++j) { v[j] = xr[64 * j]; s += (v[j].x * v[j].x + v[j].y * v[j].y) + (v[j].z * v[j].z + v[j].w * v[j].w); }
        const float rstd = 1.0f / sqrtf(wave_sum(s) * (1.f / D) + EPS);
        u32x2* o8 = (u32x2*)(H2 + (size_t)m * D) + lane;
        float lg[16];
#pragma unroll
        for (int e = 0; e < 16; ++e) lg[e] = 0.f;
        asm volatile("" ::: "memory");
#pragma unroll
        for (int j = 0; j < 4; ++j) {
            v[j] = v[j] * rstd * gg[j];
            u32x2 w; w.x = pk2(v[j].x, v[j].y); w.y = pk2(v[j].z, v[j].w); o8[64 * j] = w;
#pragma unroll
            for (int t = 0; t < 4; ++t) { const float hv = v[j][t];
#pragma unroll
                for (int e4 = 0; e4 < 4; ++e4) { const f32x4 wv = WR[((j * 4 + t) * 4 + e4) * 64 + lane];
                    lg[e4 * 4 + 0] += hv * wv.x; lg[e4 * 4 + 1] += hv * wv.y; lg[e4 * 4 + 2] += hv * wv.z; lg[e4 * 4 + 3] += hv * wv.w; } }
            asm volatile("" ::: "memory");
        }
        float mx = -1e30f;
#pragma unroll
        for (int e = 0; e < 16; ++e) { lg[e] = wave_sum(lg[e]); mx = fmaxf(mx, lg[e]); }
        float den = 0.f, mine = 0.f;
#pragma unroll
        for (int e = 0; e < 16; ++e) { const float p = __expf(lg[e] - mx); den += p; mine = (lane == e) ? p : mine; }
        if (lane < 16) AFF[(size_t)m * 16 + lane] = mine / den;
    }
    __syncthreads();
}

__device__ __forceinline__ void p6_topk(const Ctx& F) {
    LAS unsigned* cnt = (LAS unsigned*)F.lds;
    const float* AFF = (const float*)(F.ws + WS_AFF);
    int* IDX = (int*)(F.ws + WS_IDX); float* GATE = (float*)(F.ws + WS_GATE); unsigned short* INV = (unsigned short*)(F.ws + WS_INV);
    const int lane = F.lane, wave = F.wave, tid = F.tid;
    for (int item = F.bid; item < NB * NE; item += F.G) {
        const int b = item >> 4, e = item & 15;
        unsigned key[8];
#pragma unroll
        for (int i = 0; i < 8; ++i) key[i] = __builtin_bit_cast(unsigned, AFF[((size_t)b * SEQ + 8 * tid + i) * 16 + e]);
        __syncthreads();
        unsigned T = 0u;
        for (int bit = 30; bit >= 0; --bit) {
            const unsigned cand = T | (1u << bit);
            unsigned c = 0;
#pragma unroll
            for (int i = 0; i < 8; ++i) c += (unsigned)__popcll(__ballot(key[i] >= cand));
            LAS unsigned* cb = cnt + (bit & 1) * 8;
            if (lane == 0) cb[wave] = c;
            __syncthreads();
            unsigned tot = 0;
#pragma unroll
            for (int w = 0; w < 8; ++w) tot += cb[w];
            if (tot >= (unsigned)CAP) T = cand;
        }
        __syncthreads();
        unsigned ngt_w = 0;
        int neq_t = 0;
#pragma unroll
        for (int i = 0; i < 8; ++i) { ngt_w += (unsigned)__popcll(__ballot(key[i] > T)); neq_t += (key[i] == T) ? 1 : 0; }
        LAS unsigned* sc = cnt + 16;
        int incl = neq_t;
#pragma unroll
        for (int o = 1; o < 64; o <<= 1) { const int t = __shfl_up(incl, o); if (lane >= o) incl += t; }
        if (lane == 63) sc[wave] = (unsigned)incl;
        if (lane == 0) sc[16 + wave] = ngt_w;
        __syncthreads();
        unsigned eq_base = 0, ngt = 0;
#pragma unroll
        for (int w = 0; w < 8; ++w) { eq_base += (w < wave) ? sc[w] : 0u; ngt += sc[16 + w]; }
        const int need = CAP - (int)ngt;
        int eq_rank = (int)eq_base + incl - neq_t;
        unsigned selm = 0; int nsel = 0;
#pragma unroll
        for (int i = 0; i < 8; ++i) { bool s = key[i] > T; if (key[i] == T) { s = eq_rank < need; ++eq_rank; } if (s) { selm |= 1u << i; ++nsel; } }
        int incl2 = nsel;
#pragma unroll
        for (int o = 1; o < 64; o <<= 1) { const int t = __shfl_up(incl2, o); if (lane >= o) incl2 += t; }
        if (lane == 63) sc[8 + wave] = (unsigned)incl2;
        __syncthreads();
        unsigned sbase = 0;
#pragma unroll
        for (int w = 0; w < 8; ++w) sbase += (w < wave) ? sc[8 + w] : 0u;
        int slot = (int)sbase + incl2 - nsel;
#pragma unroll
        for (int i = 0; i < 8; ++i) { const int tok = 8 * tid + i; unsigned short iv = 0xFFFFu;
            if (selm & (1u << i)) { IDX[(size_t)item * CAP + slot] = tok; GATE[(size_t)item * CAP + slot] = __builtin_bit_cast(float, key[i]); iv = (unsigned short)slot; ++slot; }
            INV[((size_t)b * SEQ + tok) * 16 + e] = iv; }
        __syncthreads();
    }
}

struct Sched7 {
    const char* H2; const char* WG; const int* IDX; int G, c;
    __device__ __forceinline__ bool next(int i, Unit& u) const {
        if (i >= 16) return false;
        const int e = i, x = c & 7, j = c >> 3;
        const int mt = (x >> 1) * 4 + (j & 3), nt = (x & 1) * 8 + (j >> 2);
        const int b = mt >> 1;
        u.A = H2 + (size_t)b * SEQ * D * 2; u.B = WG + ((size_t)e * 4096 + (size_t)nt * 256) * D * 2;
        u.ridx = IDX + ((size_t)(b * NE + e) * CAP + (mt & 1) * 256); u.pm = e * 16 + mt; u.pn = nt; u.kind = 0; return true;
    }
};
struct Epi7 {
    static constexpr bool PERM = true;
    bf16_t* H;
    __device__ __forceinline__ bool operator()(f32x4 (&acc)[2][2][4][2], const Unit& u, int wr, int wc, int fr, int fq) const {
        const int row0 = u.pm * 256 + wr * 64 + fr, col0 = u.pn * 128 + wc * 32 + 8 * fq;
#pragma unroll
        for (int ai = 0; ai < 2; ++ai)
#pragma unroll
            for (int m = 0; m < 4; ++m) {
                const f32x4 a0 = acc[ai][0][m][0], a1 = acc[ai][0][m][1], g0 = acc[ai][1][m][0], g1 = acc[ai][1][m][1];
                float r[8];
#pragma unroll
                for (int j = 0; j < 4; ++j) { r[j] = a0[j] * fast_sigmoid(a0[j]) * g0[j]; r[4 + j] = a1[j] * fast_sigmoid(a1[j]) * g1[j]; }
                u32x4 w; w.x = cvt_pk_bf16(r[0], r[1]); w.y = cvt_pk_bf16(r[2], r[3]); w.z = cvt_pk_bf16(r[4], r[5]); w.w = cvt_pk_bf16(r[6], r[7]);
                *(u32x4*)(H + (size_t)(row0 + ai * 128 + m * 16) * DFF + col0) = w; }
        return false;
    }
};

struct Sched8 {
    const char* H; const char* WD; int G, c;
    __device__ __forceinline__ bool next(int i, Unit& u) const {
        if (i >= 4) return false;
        const int x = c & 7, j = c >> 3;
        const int e = i * 4 + (x >> 1), mt = (x & 1) * 8 + (j & 7), nt = j >> 3;
        u.A = H + ((size_t)e * 4096 + (size_t)mt * 256) * DFF * 2; u.B = WD + ((size_t)e * D + (size_t)nt * 256) * DFF * 2; u.ridx = nullptr; u.pm = e * 16 + mt; u.pn = nt; u.kind = 0; return true;
    }
};
struct Epi8 {
    static constexpr bool PERM = true;
    bf16_t* Y; const float* GATE;
    __device__ __forceinline__ bool operator()(f32x4 (&acc)[2][2][4][2], const Unit& u, int wr, int wc, int fr, int fq) const {
        const int e = u.pm >> 4, mt = u.pm & 15, b = mt >> 1;
        const int rl0 = (mt & 1) * 256 + wr * 64 + fr;
        const int col0 = u.pn * 256 + wc * 32 + 8 * fq;
#pragma unroll
        for (int ai = 0; ai < 2; ++ai)
#pragma unroll
            for (int m = 0; m < 4; ++m) { const int sl = rl0 + ai * 128 + m * 16; const float gv = GATE[(size_t)(b * NE + e) * CAP + sl];
                bf16_t* rowp = Y + ((size_t)e * 4096 + (size_t)b * CAP + sl) * D + col0;
#pragma unroll
                for (int bj = 0; bj < 2; ++bj) { const f32x4 v0 = acc[ai][bj][m][0] * gv, v1 = acc[ai][bj][m][1] * gv;
                    u32x4 w; w.x = cvt_pk_bf16(v0[0], v0[1]); w.y = cvt_pk_bf16(v0[2], v0[3]); w.z = cvt_pk_bf16(v1[0], v1[1]); w.w = cvt_pk_bf16(v1[2], v1[3]);
                    *(u32x4*)(rowp + bj * 128) = w; } }
        return false;
    }
};

__device__ __forceinline__ void p9_final(const Ctx& F) {
    const int gw = F.bid * 8 + F.wave, NGW = F.G * 8, lane = F.lane;
    const unsigned short* INV = (const unsigned short*)(F.ws + WS_INV); const bf16_t* Y = (const bf16_t*)(F.ws + WS_RA);
    f32x4 gg[4];
#pragma unroll
    for (int j = 0; j < 4; ++j) gg[j] = ((const f32x4*)F.final_g)[64 * j + lane];
    for (int m = gw; m < MTOK; m += NGW) {
        f32x4* xr = (f32x4*)(F.out + (size_t)m * D) + lane;
        f32x4 v[4];
#pragma unroll
        for (int j = 0; j < 4; ++j) v[j] = xr[64 * j];
        const int b = m >> 12;
        const unsigned myinv = INV[(size_t)m * 16 + (lane & 15)];
#pragma unroll 1
        for (int e = 0; e < 16; ++e) {
            const unsigned sl = (unsigned)__builtin_amdgcn_readlane((int)myinv, e);
            if (sl != 0xFFFFu) {
                const u32x2* yr = (const u32x2*)(Y + ((size_t)e * 4096 + (size_t)b * CAP + sl) * D) + lane;
#pragma unroll
                for (int j = 0; j < 4; ++j) { const u32x2 w = yr[64 * j]; v[j].x += bf_lo(w.x); v[j].y += bf_hi(w.x); v[j].z += bf_lo(w.y); v[j].w += bf_hi(w.y); }
            }
        }
        float s = 0.f;
#pragma unroll
        for (int j = 0; j < 4; ++j) s += (v[j].x * v[j].x + v[j].y * v[j].y) + (v[j].z * v[j].z + v[j].w * v[j].w);
        const float rstd = 1.0f / sqrtf(wave_sum(s) * (1.f / D) + EPS);
#pragma unroll
        for (int j = 0; j < 4; ++j) xr[64 * j] = v[j] * rstd * gg[j];
    }
}

__global__ void __launch_bounds__(512, 2) mk_fwd(Args args) {
    extern __shared__ __attribute__((aligned(16))) unsigned char lds_raw[];
    cg::grid_group grid = cg::this_grid();
    Ctx F;
    F.lds = (LAS unsigned char*)lds_raw;
    F.tid = threadIdx.x; F.lane = F.tid & 63; F.wave = __builtin_amdgcn_readfirstlane(F.tid >> 6); F.G = gridDim.x; F.bid = blockIdx.x;
    F.x = args.in[0]; F.norm1_g = args.in[1]; F.w_in = args.in[2]; F.ln_g = args.in[3]; F.ln_b = args.in[4]; F.w_sp = args.in[5]; F.b_sp = args.in[6];
    F.w_fo = args.in[7]; F.w_so = args.in[8]; F.w_out = args.in[9]; F.norm2_g = args.in[10]; F.w_router = args.in[11]; F.w_gate = args.in[12]; F.w_up = args.in[13];
    F.w_down = args.in[14]; F.final_g = args.in[15]; F.out = args.out; F.ws = args.ws;
    const int lo = args.ph_lo, hi = args.ph_hi;
    unsigned char* ws = args.ws;
#ifndef PH_MASK
#define PH_MASK 0x3ff
#endif
#define IN(k) (((PH_MASK >> (k)) & 1) && lo <= (k) && (k) < hi)
#define SEAM(k) do { if (IN(k) && IN((k) + 1)) grid.sync(); } while (0)

    if (IN(0)) p0_prep(F);
    SEAM(0);
    if (IN(1)) {
        Sched1 S{(const char*)(ws + WS_HN), (const char*)(ws + WS_WIN), F.G, F.bid}; Epi1 E{ws};
        pg8::gemm_phase<Epi1, Sched1, false>(F.lds, D, S, E);
    }
    SEAM(1);
    if (IN(2)) {
        p2_sgu(F);
        Sched2 S{(const char*)(ws + WS_RA), (const char*)(ws + WS_ZCS), F.G, F.bid}; EpiFm E{(bf16_t*)(ws + WS_FM)};
        pg8::gemm_phase<EpiFm, Sched2, false>(F.lds, 8192, S, E);
    }
    SEAM(2);
    if (IN(3)) {
        Sched3 S{(const char*)(ws + WS_FM), (const char*)(ws + WS_SG), (const char*)(ws + WS_WFO), (const char*)(ws + WS_WSO), F.G, F.bid};
        Epi3 E{(const bf16_t*)(ws + WS_SGF), (const bf16_t*)(ws + WS_SGS), (bf16_t*)(ws + WS_MRG)};
        pg8::gemm_phase<Epi3, Sched3, false>(F.lds, 512, S, E);
    }
    SEAM(3);
    if (IN(4)) {
        Sched4 S{(const char*)(ws + WS_MRG), (const char*)(ws + WS_WOUT), F.G, F.bid}; Epi4 E{F.x, F.out};
        pg8::gemm_phase<Epi4, Sched4, false>(F.lds, D, S, E);
    }
    SEAM(4);
    if (IN(5)) p5_rows(F);
    SEAM(5);
    if (IN(6)) p6_topk(F);
    SEAM(6);
    if (IN(7)) {
        Sched7 S{(const char*)(ws + WS_H2), (const char*)(ws + WS_RA), (const int*)(ws + WS_IDX), F.G, F.bid}; Epi7 E{(bf16_t*)(ws + WS_H)};
        pg8::gemm_phase<Epi7, Sched7, true>(F.lds, D, S, E);
    }
    SEAM(7);
    if (IN(8)) {
        Sched8 S{(const char*)(ws + WS_H), (const char*)(ws + WS_WD), F.G, F.bid}; Epi8 E{(bf16_t*)(ws + WS_RA), (const float*)(ws + WS_GATE)};
        pg8::gemm_phase<Epi8, Sched8, false>(F.lds, DFF, S, E);
    }
    SEAM(8);
    if (IN(9)) p9_final(F);
#undef IN
#undef SEAM
}

extern "C" void kernel_launch(void* const* d_in, const int* in_sizes, int n_in, void* d_out, int out_size, void* d_ws, size_t ws_size, hipStream_t stream) {
    static int grid = 0;
    if (grid == 0) {
        if (n_in != 16 || out_size != MTOK * D || ws_size < WS_END) { fprintf(stderr, "kernel_launch: unexpected shapes (n_in %d, out %d, ws %zu < %zu)\n", n_in, out_size, ws_size, (size_t)WS_END); grid = -1; return; }
        int dev = 0, cus = 0, per_cu = 0;
        if (hipGetDevice(&dev) != hipSuccess || hipDeviceGetAttribute(&cus, hipDeviceAttributeMultiprocessorCount, dev) != hipSuccess) { grid = -1; return; }
        if (hipFuncSetAttribute((const void*)mk_fwd, hipFuncAttributeMaxDynamicSharedMemorySize, LDS_BYTES) != hipSuccess) { fprintf(stderr, "kernel_launch: hipFuncSetAttribute failed\n"); grid = -1; return; }
        if (hipOccupancyMaxActiveBlocksPerMultiprocessor(&per_cu, (const void*)mk_fwd, 512, LDS_BYTES) != hipSuccess || per_cu < 1) { fprintf(stderr, "kernel_launch: occupancy query failed (%d)\n", per_cu); grid = -1; return; }
        if (per_cu > 1) per_cu = 1;
        grid = cus * per_cu;
        if (grid != 256) fprintf(stderr, "kernel_launch: note: grid %d (tile orders are tuned for 256)\n", grid);
    }
    if (grid < 0) return;
    Args a{};
    for (int i = 0; i < 16; ++i) a.in[i] = (const float*)d_in[i];
    a.out = (float*)d_out; a.ws = (unsigned char*)d_ws;
#if MK_N_LAUNCHES == 1
    a.ph_lo = 0; a.ph_hi = NPHASE;
    void* kargs[] = {&a};
    hipError_t e = hipLaunchCooperativeKernel((const void*)mk_fwd, dim3(grid), dim3(512), kargs, LDS_BYTES, stream);
    if (e != hipSuccess) fprintf(stderr, "kernel_launch: cooperative launch failed: %s (grid %d)\n", hipGetErrorString(e), grid);
#else
    for (int p = 0; p < NPHASE; ++p) {
        a.ph_lo = p; a.ph_hi = p + 1;
        hipLaunchKernelGGL(mk_fwd, dim3(grid), dim3(512), LDS_BYTES, stream, a);
    }
#endif
}
```

```cpp
#include <hip/hip_runtime.h>
#include <hip/hip_cooperative_groups.h>
#include <cstdio>
#include <cstdint>
namespace cg = cooperative_groups;

#ifndef MK_N_LAUNCHES
#define MK_N_LAUNCHES 1
#endif

#define LAS __attribute__((address_space(3)))
typedef unsigned short bf16_t;
typedef short bf16x8 __attribute__((ext_vector_type(8)));
typedef float f32x4 __attribute__((ext_vector_type(4)));
typedef float f32x2 __attribute__((ext_vector_type(2)));
typedef unsigned u32x4 __attribute__((ext_vector_type(4)));
typedef unsigned u32x2 __attribute__((ext_vector_type(2)));

constexpr int D = 1024, NB = 8, SEQ = 4096, MTOK = NB * SEQ;
constexpr int FW = 512, SWD = 512, NE = 16, CAP = 512, DFF = 2048;
constexpr int N1 = 4096;
constexpr int INW = 3584;
constexpr float EPS = 1e-6f;

constexpr size_t MiB = 1u << 20;
constexpr size_t WS_RA = 0;
constexpr size_t WS_WD = 128 * MiB;
constexpr size_t WS_RH = 192 * MiB;
constexpr size_t WS_YF = WS_RH;
constexpr size_t WS_GU = WS_RH + 64 * MiB;
constexpr size_t WS_GV = WS_RH + 96 * MiB;
constexpr size_t WS_SGF = WS_RH + 128 * MiB;
constexpr size_t WS_SGS = WS_RH + 192 * MiB;
constexpr size_t WS_FM = WS_GU;
constexpr size_t WS_MRG = WS_RH;
constexpr size_t WS_H = WS_RH;
constexpr size_t WS_RS = 448 * MiB;
constexpr size_t WS_HN = WS_RS;
constexpr size_t WS_AP = WS_RS;
constexpr size_t WS_SG = WS_RA;
constexpr size_t WS_H2 = WS_RS;
constexpr size_t WS_WIN = 512 * MiB;
constexpr size_t WS_WFO = 520 * MiB;
constexpr size_t WS_WSO = 521 * MiB;
constexpr size_t WS_WOUT = 522 * MiB;
constexpr size_t WS_AFF = 524 * MiB;
constexpr size_t WS_INV = 526 * MiB;
constexpr size_t WS_IDX = 527 * MiB;
constexpr size_t WS_GATE = WS_IDX + 256 * 1024;
constexpr size_t WS_MA = WS_IDX + 512 * 1024;
constexpr size_t WS_MB = WS_MA + 32 * 1024;
constexpr size_t WS_CTL = WS_IDX + 768 * 1024;
constexpr size_t CTL_BYTES = 16384;
constexpr size_t WS_END = 528 * MiB;

constexpr int LDS_STAGE = 131072;
constexpr int LDS_X_OFF = LDS_STAGE;
constexpr int LDS_BYTES = 155648;
constexpr int LDS_MISC = LDS_BYTES - 64;

__device__ __forceinline__ unsigned f2bf(float f) { unsigned u = __builtin_bit_cast(unsigned, f); return (u + 0x7fffu + ((u >> 16) & 1u)) >> 16; }
__device__ __forceinline__ unsigned pk2(float lo, float hi) { return f2bf(lo) | (f2bf(hi) << 16); }
__device__ __forceinline__ unsigned cvt_pk_bf16(float lo, float hi) { unsigned r; asm volatile("v_cvt_pk_bf16_f32 %0, %1, %2" : "=v"(r) : "v"(lo), "v"(hi)); return r; }
__device__ __forceinline__ float bf_lo(unsigned w) { return __builtin_bit_cast(float, w << 16); }
__device__ __forceinline__ float bf_hi(unsigned w) { return __builtin_bit_cast(float, w & 0xffff0000u); }
__device__ __forceinline__ float wave_sum(float v) {
#pragma unroll
    for (int o = 1; o < 64; o <<= 1) v += __shfl_xor(v, o);
    return v;
}
__device__ __forceinline__ float fast_sigmoid(float x) { return __builtin_amdgcn_rcpf(1.0f + __builtin_amdgcn_exp2f(-1.44269504089f * x)); }
__device__ __forceinline__ float gelu_tanh(float x) {
    const float u = 1.5957691216f * (x + 0.044715f * x * x * x);
    return x * fast_sigmoid(u);
}
#define LDS_WAIT() asm volatile("s_waitcnt lgkmcnt(0)" ::: "memory")

namespace pg8 {
constexpr int BM = 256, BK = 64, HALF = 128, HTB = HALF * BK * 2, NXCD = 8, WGM = 8;
__device__ __forceinline__ int lds_byte(int r, int c) { const int st = (r >> 4) * 2 + (c >> 5), rr = r & 15, cc = c & 31, ob = rr * 64 + cc * 2; return st * 1024 + (ob ^ (((ob >> 9) & 1) << 5)); }
__device__ __forceinline__ void stage_rc(int b, int& R, int& C) { const int st = b / 1024, sb = b % 1024, swz = sb ^ (((sb >> 9) & 1) << 5); R = (st >> 1) * 16 + swz / 64; C = (st & 1) * 32 + (swz % 64) / 2; }
__device__ __forceinline__ int perm32(int rho) { const int n = rho >> 4, i = rho & 15; return 8 * (i >> 2) + 4 * n + (i & 3); }

struct Unit { const char* A; const char* B; const int* ridx; int pm, pn, kind; };

__device__ __forceinline__ bool static_tile(int nM, int nN, int G, int c, int i, int& pm, int& pn) {
    const int nwg = nM * nN; const long L = (long)i * G + c; if (L >= nwg) return false;
    int wgid = (int)L; { const int q = nwg / NXCD, r = nwg % NXCD, xcd = wgid % NXCD, off = wgid / NXCD; wgid = (xcd < r ? xcd * (q + 1) : r * (q + 1) + (xcd - r) * q) + off; }
    const int nig = WGM * nN, gid = wgid / nig, fm = gid * WGM, gsz = (nM - fm) < WGM ? (nM - fm) : WGM;
    pm = fm + ((wgid % nig) % gsz); pn = (wgid % nig) / gsz; return true;
}

template <class Epi, class Sched, bool GATHER>
__device__ __forceinline__ void gemm_phase(LAS unsigned char* lds, const int K, const Sched& S, const Epi& E) {
    const int tid = threadIdx.x, wid = __builtin_amdgcn_readfirstlane(tid >> 6), lane = tid & 63, wr = wid >> 2, wc = wid & 3, fr = lane & 15, fq = lane >> 4;
    const int nt = K / BK;
    unsigned voffA[2], voffB[2]; int RA[2], CA2[2];
#pragma unroll
    for (int i = 0; i < 2; ++i) { int R, C; stage_rc(tid * 16 + i * 8192, R, C); const int Rb = Epi::PERM ? ((R & ~31) + perm32(R & 31)) : R;
        voffA[i] = (unsigned)(R * K + C) * 2u; voffB[i] = (unsigned)(Rb * K + C) * 2u; RA[i] = R; CA2[i] = C * 2; }
    const size_t kstep = (size_t)(BK * 2);
    const size_t hstep = (size_t)HALF * K * 2;
    const unsigned ldsw = (unsigned)wid * 1024u;
    const int aoff = lds_byte(wr * 64 + fr, fq * 8), boff = lds_byte(wc * 32 + fr, fq * 8);
#define PG8_SA(b, h) (((b) * 2 + (h)) * HTB)
#define PG8_SB(b, h) ((4 + (b) * 2 + (h)) * HTB)
#define PG8_GLDS(bufoff, gptr, _i) __builtin_amdgcn_global_load_lds((const unsigned*)(gptr), (LAS unsigned*)(lds + (bufoff) + ldsw + (_i) * 8192), 16, 0, 0)
#define PG8_STAGE_B(bufoff, gbase) do { _Pragma("unroll") for (int _i = 0; _i < 2; ++_i) PG8_GLDS(bufoff, (const char*)(gbase) + voffB[_i], _i); } while (0)
#define PG8_STAGE_A(bufoff, gbase, h, go) do { _Pragma("unroll") for (int _i = 0; _i < 2; ++_i) { \
        if constexpr (GATHER) PG8_GLDS(bufoff, (const char*)(gbase) + go[h][_i], _i); else PG8_GLDS(bufoff, (const char*)(gbase) + (h) * hstep + voffA[_i], _i); } } while (0)
#define PG8_LDA(dst, b, h) do { _Pragma("unroll") for (int m = 0; m < 4; ++m) _Pragma("unroll") for (int k = 0; k < 2; ++k) dst[m][k] = *(const LAS bf16x8*)(lds + PG8_SA(b, h) + aoff + m * 2048 + k * 1024); } while (0)
#define PG8_LDB(dst, b, h) do { _Pragma("unroll") for (int n = 0; n < 2; ++n) _Pragma("unroll") for (int k = 0; k < 2; ++k) dst[n][k] = *(const LAS bf16x8*)(lds + PG8_SB(b, h) + boff + n * 2048 + k * 1024); } while (0)
#define PG8_MMA(ai, bj, At, Bt) do { __builtin_amdgcn_s_setprio(1); _Pragma("unroll") for (int m = 0; m < 4; ++m) _Pragma("unroll") for (int n = 0; n < 2; ++n) _Pragma("unroll") for (int k = 0; k < 2; ++k) \
        acc[ai][bj][m][n] = __builtin_amdgcn_mfma_f32_16x16x32_bf16(Bt[n][k], At[m][k], acc[ai][bj][m][n], 0, 0, 0); __builtin_amdgcn_s_setprio(0); } while (0)
#define PG8_WAIT_V(n) asm volatile("s_waitcnt vmcnt(" #n ")" ::: "memory")
#define PG8_WAIT_L(n) asm volatile("s_waitcnt lgkmcnt(" #n ")" ::: "memory")
#define PG8_BAR __builtin_amdgcn_s_barrier()
#define PG8_SCHED __builtin_amdgcn_sched_barrier(0)
#define PG8_GOFS(dst, u) do { if constexpr (GATHER) { _Pragma("unroll") for (int _h = 0; _h < 2; ++_h) _Pragma("unroll") for (int _i = 0; _i < 2; ++_i) \
        dst[_h][_i] = (unsigned)(u).ridx[_h * HALF + RA[_i]] * (unsigned)(K * 2) + (unsigned)CA2[_i]; } } while (0)
    Unit cur, nxt; int ui = 0;
    if (!S.next(0, cur)) return;
    f32x4 acc[2][2][4][2];
#pragma unroll
    for (int a = 0; a < 2; ++a)
#pragma unroll
        for (int b = 0; b < 2; ++b)
#pragma unroll
            for (int m = 0; m < 4; ++m)
#pragma unroll
                for (int n = 0; n < 2; ++n) acc[a][b][m][n] = (f32x4){0.f, 0.f, 0.f, 0.f};
    bf16x8 At[4][2], B0[2][2], B1[2][2];
    unsigned gA[2][2] = {{0u, 0u}, {0u, 0u}}, gN[2][2] = {{0u, 0u}, {0u, 0u}};
    PG8_GOFS(gA, cur);
    const char* cA = cur.A; const char* cB = cur.B;
    PG8_STAGE_B(PG8_SB(0, 0), cB); PG8_STAGE_B(PG8_SB(0, 1), cB + hstep); PG8_STAGE_A(PG8_SA(0, 0), cA, 0, gA); PG8_STAGE_A(PG8_SA(0, 1), cA, 1, gA);
    if (wr == 1) PG8_BAR;
    PG8_WAIT_V(2); PG8_BAR;
    PG8_STAGE_B(PG8_SB(1, 0), cB + kstep); PG8_STAGE_A(PG8_SA(1, 0), cA + kstep, 0, gA); PG8_STAGE_B(PG8_SB(1, 1), cB + hstep + kstep);
    PG8_WAIT_V(6); PG8_BAR;
    for (;;) {
        const bool has_next = S.next(ui + 1, nxt);
        if (!has_next) nxt = cur;
        PG8_GOFS(gN, nxt);
        const char* nA = nxt.A; const char* nB = nxt.B;
        for (int t = 0; t < nt; t += 2) {
            const bool last = (t == nt - 2);
            const char* a1 = cA + (size_t)(t + 1) * kstep;
            const char* a2 = last ? nA : cA + (size_t)(t + 2) * kstep; const char* b2 = last ? nB : cB + (size_t)(t + 2) * kstep;
            const char* a3 = a2 + kstep; const char* b3 = b2 + kstep;
            unsigned g2[2][2];
#pragma unroll
            for (int _h = 0; _h < 2; ++_h)
#pragma unroll
                for (int _i = 0; _i < 2; ++_i) g2[_h][_i] = last ? gN[_h][_i] : gA[_h][_i];
            PG8_LDB(B0, 0, 0); PG8_LDB(B1, 0, 1); PG8_SCHED; PG8_LDA(At, 0, 0); PG8_STAGE_A(PG8_SA(1, 1), a1, 1, gA);
            PG8_WAIT_V(8); PG8_WAIT_L(0); PG8_BAR; PG8_MMA(0, 0, At, B0); PG8_MMA(0, 1, At, B1); PG8_BAR; PG8_SCHED;
            PG8_LDA(At, 0, 1); PG8_STAGE_B(PG8_SB(0, 0), b2); PG8_STAGE_B(PG8_SB(0, 1), b2 + hstep); PG8_STAGE_A(PG8_SA(0, 0), a2, 0, g2);
            PG8_WAIT_V(8); PG8_WAIT_L(0); PG8_BAR; PG8_MMA(1, 0, At, B0); PG8_MMA(1, 1, At, B1); PG8_BAR; PG8_SCHED;
            PG8_LDB(B0, 1, 0); PG8_LDB(B1, 1, 1); PG8_SCHED; PG8_LDA(At, 1, 0); PG8_STAGE_A(PG8_SA(0, 1), a2, 1, g2);
            PG8_WAIT_V(8); PG8_WAIT_L(0); PG8_BAR; PG8_MMA(0, 0, At, B0); PG8_MMA(0, 1, At, B1); PG8_BAR; PG8_SCHED;
            PG8_LDA(At, 1, 1); PG8_STAGE_B(PG8_SB(1, 0), b3); PG8_STAGE_B(PG8_SB(1, 1), b3 + hstep); PG8_STAGE_A(PG8_SA(1, 0), a3, 0, g2);
            PG8_WAIT_V(8); PG8_WAIT_L(0); PG8_BAR; PG8_MMA(1, 0, At, B0); PG8_MMA(1, 1, At, B1); PG8_BAR; PG8_SCHED;
        }
        if (wr == 0) PG8_BAR;
        const bool keep = E(acc, cur, wr, wc, fr, fq);
        if (!has_next) break;
        if (!keep) {
#pragma unroll
            for (int a = 0; a < 2; ++a)
#pragma unroll
                for (int b = 0; b < 2; ++b)
#pragma unroll
                    for (int m = 0; m < 4; ++m)
#pragma unroll
                        for (int n = 0; n < 2; ++n) acc[a][b][m][n] = (f32x4){0.f, 0.f, 0.f, 0.f};
        }
        cur = nxt; cA = nA; cB = nB; ++ui;
#pragma unroll
        for (int _h = 0; _h < 2; ++_h)
#pragma unroll
            for (int _i = 0; _i < 2; ++_i) gA[_h][_i] = gN[_h][_i];
        if (wr == 1) PG8_BAR;
    }
    PG8_WAIT_V(0);
    PG8_BAR;
#undef PG8_SA
#undef PG8_SB
#undef PG8_GLDS
#undef PG8_STAGE_A
#undef PG8_STAGE_B
#undef PG8_LDA
#undef PG8_LDB
#undef PG8_MMA
#undef PG8_WAIT_V
#undef PG8_WAIT_L
#undef PG8_BAR
#undef PG8_SCHED
#undef PG8_GOFS
}
}
using pg8::Unit;

#define XB_TMO      128
#define XB_XCNT(j)  (256  + 64 * (j))
#define XB_XSUB(j)  (1280 + 64 * (j))
#define XB_XGEN(j)  (2304 + 64 * (j))
#define XB_TOP      3328
#define XB_TOPGEN   3392
#define XB_SPIN_CAP (1u << 22)
__device__ __forceinline__ unsigned xb_ld(unsigned* p)              { return __hip_atomic_load(p, __ATOMIC_RELAXED, __HIP_MEMORY_SCOPE_AGENT); }
__device__ __forceinline__ unsigned xb_add(unsigned* p, unsigned v) { return __hip_atomic_fetch_add(p, v, __ATOMIC_RELAXED, __HIP_MEMORY_SCOPE_AGENT); }
__device__ __forceinline__ unsigned xb_xcc_id() { return (unsigned)__builtin_amdgcn_s_getreg((3 << 11) | 20) & 0xFu; }
#define XB_SPIN(cond, bar) do { unsigned _sp = 0; while (cond) { __builtin_amdgcn_s_sleep(1); \
    if ((++_sp & 255u) == 0u) { if (xb_ld(&(bar)[XB_TMO])) break; if (_sp > XB_SPIN_CAP) { atomicAdd(&(bar)[XB_TMO], 1u); break; } } } } while (0)
struct XcdBarrier { unsigned* bar; unsigned x; volatile LAS unsigned* st; };
__device__ __forceinline__ XcdBarrier xcd_barrier_post(unsigned* bar, volatile LAS unsigned* st) {
    XcdBarrier b; b.bar = bar; b.x = xb_xcc_id(); b.st = st;
    if (threadIdx.x == 0) (void)xb_add(&bar[XB_XCNT(b.x)], 1u);
    return b;
}
__device__ __forceinline__ void xcd_barrier_complete(unsigned* bar, unsigned x, unsigned& nloc, unsigned& nx) {
    const unsigned G = gridDim.x * gridDim.y * gridDim.z;
    unsigned sum, cnt, mine, sp = 0u;
    for (;;) {
        sum = 0u; cnt = 0u; mine = 0u;
#pragma unroll
        for (unsigned j = 0; j < 16; ++j) { const unsigned c = xb_ld(&bar[XB_XCNT(j)]); sum += c; cnt += (c > 0u) ? 1u : 0u; mine = (j == x) ? c : mine; }
        if (sum == G) break;
        __builtin_amdgcn_s_sleep(1);
        if ((++sp & 255u) == 0u) { if (xb_ld(&bar[XB_TMO])) break; if (sp > XB_SPIN_CAP) { atomicAdd(&bar[XB_TMO], 1u); break; } }
    }
    nloc = mine > 0u ? mine : 1u; nx = cnt > 0u ? cnt : 1u;
}
__device__ __forceinline__ void xcd_barrier(const XcdBarrier& b) {
    asm volatile("s_waitcnt vmcnt(0)" ::: "memory");
    __syncthreads();
    if (threadIdx.x == 0) {
        unsigned* bar = b.bar;
        __builtin_amdgcn_s_waitcnt(0);
        unsigned nloc = b.st[0], nx = b.st[1];
        if (nloc == 0u) { xcd_barrier_complete(bar, b.x, nloc, nx); b.st[0] = nloc; b.st[1] = nx; }
        const unsigned old = xb_add(&bar[XB_XSUB(b.x)], 1u);
        const unsigned gen = old / nloc;
        if (old + 1u == (gen + 1u) * nloc) {
            __builtin_amdgcn_fence(__ATOMIC_RELEASE, "agent");
            asm volatile("s_waitcnt vmcnt(0)" ::: "memory");
            const unsigned og = xb_add(&bar[XB_TOP], 1u);
            const unsigned tg = og / nx;
            if (og + 1u == (tg + 1u) * nx) xb_add(&bar[XB_TOPGEN], 1u);
            else XB_SPIN(xb_ld(&bar[XB_TOPGEN]) == tg, bar);
            __builtin_amdgcn_fence(__ATOMIC_ACQUIRE, "agent");
            xb_add(&bar[XB_XGEN(b.x)], 1u);
            asm volatile("s_waitcnt vmcnt(0)" ::: "memory");
        } else {
            XB_SPIN(xb_ld(&bar[XB_XGEN(b.x)]) == gen, bar);
            __builtin_amdgcn_fence(__ATOMIC_ACQUIRE, "agent");
            asm volatile("s_waitcnt vmcnt(0)" ::: "memory");
        }
    }
    __syncthreads();
}

struct Args {
    const float* in[16];
    float* out;
    unsigned char* ws;
    unsigned ph_mask, pad;
};

struct Ctx {
    LAS unsigned char* lds;
    int tid, lane, wave, G, bid;
    const float *x, *norm1_g, *w_in, *ln_g, *ln_b, *w_sp, *b_sp, *w_fo, *w_so, *w_out, *norm2_g, *w_router, *w_gate, *w_up, *w_down, *final_g;
    float* out;
    unsigned char* ws;
};

__device__ __forceinline__ void transpose_item(const float* W, int N, int k0, int n0, bf16_t* WT, size_t dst_row0, int Kd, LAS float* scr, int lane) {
    const float* src = W + (size_t)(k0 + (lane >> 4)) * N + n0;
#pragma unroll
    for (int i = 0; i < 16; ++i) {
        const int n4 = (lane & 15) ^ ((i >> 1) & 7);
        __builtin_amdgcn_global_load_lds((const unsigned*)(src + (size_t)(4 * i) * N + 4 * n4), (LAS unsigned*)(scr + i * 256), 16, 0, 0);
    }
    asm volatile("s_waitcnt vmcnt(0)" ::: "memory");
    const int hh = lane >> 5, c = (lane >> 2) & 7, sub = lane & 3;
#pragma unroll
    for (int j = 0; j < 8; ++j) {
        const int n4 = 2 * j + hh;
        const LAS float* p = scr + (16 * (8 * c) + (n4 ^ c)) * 4 + sub;
        float v[8];
#pragma unroll
        for (int i = 0; i < 8; ++i) v[i] = p[i * 64];
        u32x4 o; o.x = pk2(v[0], v[1]); o.y = pk2(v[2], v[3]); o.z = pk2(v[4], v[5]); o.w = pk2(v[6], v[7]);
        *(u32x4*)(WT + (dst_row0 + 4 * n4 + sub) * (size_t)Kd + k0 + 8 * c) = o;
    }
    LDS_WAIT(); asm volatile("" ::: "memory");
}

__device__ __forceinline__ void rms_rows4_to_bf16(const float* x0, const f32x4 (&gg)[4], bf16_t* o0, int lane) {
    f32x4 v[4][4];
#pragma unroll
    for (int r = 0; r < 4; ++r)
#pragma unroll
        for (int j = 0; j < 4; ++j) v[r][j] = ((const f32x4*)(x0 + (size_t)r * D))[64 * j + lane];
#pragma unroll
    for (int r = 0; r < 4; ++r) {
        float s = 0.f;
#pragma unroll
        for (int j = 0; j < 4; ++j) s += (v[r][j].x * v[r][j].x + v[r][j].y * v[r][j].y) + (v[r][j].z * v[r][j].z + v[r][j].w * v[r][j].w);
        const float rstd = 1.0f / sqrtf(wave_sum(s) * (1.f / D) + EPS);
        u32x2* o8 = (u32x2*)(o0 + (size_t)r * D) + lane;
#pragma unroll
        for (int j = 0; j < 4; ++j) { u32x2 w; w.x = pk2(v[r][j].x * rstd * gg[j].x, v[r][j].y * rstd * gg[j].y); w.y = pk2(v[r][j].z * rstd * gg[j].z, v[r][j].w * rstd * gg[j].w); o8[64 * j] = w; }
    }
}

__device__ __forceinline__ void p0_prep(const Ctx& F, const int parts) {
    LAS float* scr = (LAS float*)(F.lds + F.wave * 16384);
    LAS float* tab128 = (LAS float*)(F.lds + LDS_X_OFF);
    if (F.tid < 128) tab128[F.tid] = cospif((float)F.tid * (1.0f / 64.0f));
    __syncthreads();
    const int gw = F.bid * 8 + F.wave, NGW = F.G * 8;
    bf16_t* WinT = (bf16_t*)(F.ws + WS_WIN);
    if (parts & 1) {
        constexpr int I1 = 16 * 48, I2 = 8 * 16, I3 = 8 * 16, I4 = 16 * 16, I5 = 16 * 32 * 16;
        constexpr int NIT = I1 + I2 + I3 + I4 + I5;
        for (int it = gw; it < NIT; it += NGW) {
            int r = it;
            if (r < I1) { const int kb = r / 48, nb = r % 48; transpose_item(F.w_in, INW, 64 * kb, 512 + 64 * nb, WinT, (size_t)(1024 + 64 * nb), D, scr, F.lane); continue; } r -= I1;
            if (r < I2) { const int kb = r / 16, nb = r % 16; transpose_item(F.w_fo, D, 64 * kb, 64 * nb, (bf16_t*)(F.ws + WS_WFO), (size_t)(64 * nb), FW, scr, F.lane); continue; } r -= I2;
            if (r < I3) { const int kb = r / 16, nb = r % 16; transpose_item(F.w_so, D, 64 * kb, 64 * nb, (bf16_t*)(F.ws + WS_WSO), (size_t)(64 * nb), SWD, scr, F.lane); continue; } r -= I3;
            if (r < I4) { const int kb = r / 16, nb = r % 16; transpose_item(F.w_out, D, 64 * kb, 64 * nb, (bf16_t*)(F.ws + WS_WOUT), (size_t)(64 * nb), D, scr, F.lane); continue; } r -= I4;
            { const int e = r >> 9, q = r & 511, kb = q >> 4, nb = q & 15;
              transpose_item(F.w_down + (size_t)e * DFF * D, D, 64 * kb, 64 * nb, (bf16_t*)(F.ws + WS_WD) + (size_t)e * D * DFF, (size_t)(64 * nb), DFF, scr, F.lane); }
        }
    }
    if (parts & 2) {
        const float sc = 0.08838834764831845f;
        for (int it = gw; it < 4096; it += NGW) {
            const int g = it >> 10, dt = (it >> 4) & 63, jt = it & 15;
            const int d0 = dt * 16, j0 = jt * 16, kk = F.lane >> 4;
            const int jj = (j0 + (F.lane & 15)) & 127; const int shift = (j0 >= 128) ? 96 : 0;
            const float* ap = F.w_in + (size_t)(d0 + (F.lane & 15)) * INW + g * 128 + 4 * kk;
            f32x4 av[8];
#pragma unroll
            for (int q = 0; q < 8; ++q) av[q] = *(const f32x4*)(ap + 16 * q);
            f32x4 acc = (f32x4){0.f, 0.f, 0.f, 0.f};
#pragma unroll
            for (int q = 0; q < 8; ++q)
#pragma unroll
                for (int t = 0; t < 4; ++t) {
                    const int c = 16 * q + 4 * kk + t;
                    const float b = tab128[(jj * c + shift) & 127] * sc;
                    acc = __builtin_amdgcn_mfma_f32_16x16x4f32(av[q][t], b, acc, 0, 0, 0);
                }
            u32x2 w; w.x = pk2(acc[0], acc[1]); w.y = pk2(acc[2], acc[3]);
            *(u32x2*)(WinT + (size_t)(g * 256 + j0 + (F.lane & 15)) * D + d0 + 4 * (F.lane >> 4)) = w;
        }
    }
    if (parts & 4) {
        bf16_t* HN = (bf16_t*)(F.ws + WS_HN);
        f32x4 gg[4];
#pragma unroll
        for (int j = 0; j < 4; ++j) gg[j] = ((const f32x4*)F.norm1_g)[64 * j + F.lane];
        for (int m4 = gw; m4 < MTOK / 4; m4 += NGW) rms_rows4_to_bf16(F.x + (size_t)m4 * 4 * D, gg, HN + (size_t)m4 * 4 * D, F.lane);
    }
    if (parts & 8) {
        bf16_t* MA = (bf16_t*)(F.ws + WS_MA); bf16_t* MB = (bf16_t*)(F.ws + WS_MB);
        const int gt = F.bid * 512 + F.tid, NT = F.G * 512;
        for (int q = gt; q < 128 * 128 + 64 * 128; q += NT) {
            if (q < 128 * 128) { const int o = q >> 7, k = q & 127, kl = o >> 1, ri = o & 1, sh = k >> 1, half = k & 1; const float a = (float)((kl * sh) & 63) * (1.0f / 32.0f);
                const float C = cospif(a), S = sinpif(a); const float v = (ri == 0) ? (half == 0 ? C : -S) : (half == 0 ? -S : -C); MA[q] = (bf16_t)f2bf(v * 0.125f); }
            else { const int qq = q - 128 * 128, kh = qq >> 7, k = qq & 127, sl = k >> 1, ri = k & 1; const float a = (float)((kh * sl) & 63) * (1.0f / 32.0f);
                MB[qq] = (bf16_t)f2bf((ri == 0 ? cospif(a) : sinpif(a)) * 0.125f); }
        }
    }
}

struct Sched1 {
    const char* A; const char* B; int G, c;
    __device__ __forceinline__ bool next(int i, Unit& u) const {
        int pm, pn; if (!pg8::static_tile(MTOK / 256, N1 / 256, G, c, i, pm, pn)) return false;
        u.A = A + (size_t)pm * 256 * D * 2; u.B = B + (size_t)pn * 256 * D * 2; u.ridx = nullptr; u.pm = pm; u.pn = pn; u.kind = 0; return true;
    }
};
struct Epi1 {
    static constexpr bool PERM = true;
    unsigned char* ws;
    __device__ __forceinline__ bool operator()(f32x4 (&acc)[2][2][4][2], const Unit& u, int wr, int wc, int fr, int fq) const {
        const int pn = u.pn;
        if (pn < 4) {
            bf16_t* Y = (bf16_t*)(ws + WS_YF);
            const int b = u.pm >> 4;
#pragma unroll
            for (int ai = 0; ai < 2; ++ai)
#pragma unroll
                for (int m = 0; m < 4; ++m) { const int s_lo = m * 16 + fr, s_hi = (u.pm & 15) * 4 + ai * 2 + wr;
                    bf16_t* rowp = Y + ((size_t)((b * 4 + pn) * 64 + s_lo) * 64 + s_hi) * 256 + wc * 32 + 8 * fq;
#pragma unroll
                    for (int bj = 0; bj < 2; ++bj) { const f32x4 v0 = acc[ai][bj][m][0], v1 = acc[ai][bj][m][1];
                        u32x4 w; w.x = cvt_pk_bf16(v0[0], v0[1]); w.y = cvt_pk_bf16(v0[2], v0[3]); w.z = cvt_pk_bf16(v1[0], v1[1]); w.w = cvt_pk_bf16(v1[2], v1[3]);
                        *(u32x4*)(rowp + bj * 128) = w; } }
            return false;
        }
        bf16_t* base; int ldc, colt; int act;
        if (pn < 6) { base = (bf16_t*)(ws + WS_GU); ldc = 512; colt = (pn - 4) * 256; act = 0; }
        else if (pn < 8) { base = (bf16_t*)(ws + WS_GV); ldc = 512; colt = (pn - 6) * 256; act = 0; }
        else if (pn < 12) { base = (bf16_t*)(ws + WS_SGF); ldc = 1024; colt = (pn - 8) * 256; act = 1; }
        else { base = (bf16_t*)(ws + WS_SGS); ldc = 1024; colt = (pn - 12) * 256; act = 1; }
        const int row0 = u.pm * 256 + wr * 64 + fr, col0 = colt + wc * 32 + 8 * fq;
#pragma unroll
        for (int ai = 0; ai < 2; ++ai)
#pragma unroll
            for (int m = 0; m < 4; ++m) { bf16_t* rowp = base + (size_t)(row0 + ai * 128 + m * 16) * ldc + col0;
#pragma unroll
                for (int bj = 0; bj < 2; ++bj) { f32x4 v0 = acc[ai][bj][m][0], v1 = acc[ai][bj][m][1];
                    if (act == 0) {
#pragma unroll
                        for (int j = 0; j < 4; ++j) { v0[j] = gelu_tanh(v0[j]); v1[j] = gelu_tanh(v1[j]); }
                    } else {
#pragma unroll
                        for (int j = 0; j < 4; ++j) { v0[j] = fast_sigmoid(v0[j]); v1[j] = fast_sigmoid(v1[j]); }
                    }
                    u32x4 w; w.x = cvt_pk_bf16(v0[0], v0[1]); w.y = cvt_pk_bf16(v0[2], v0[3]); w.z = cvt_pk_bf16(v1[0], v1[1]); w.w = cvt_pk_bf16(v1[2], v1[3]);
                    *(u32x4*)(rowp + bj * 128) = w; } }
        return false;
    }
};

__device__ __forceinline__ void p2_sgu(const Ctx& F) {
    constexpr int PITCH = 136;
    LAS bf16_t* Ws = (LAS bf16_t*)(F.lds);
    LAS bf16_t* Vt = (LAS bf16_t*)(F.lds + 128 * PITCH * 2);
    const bf16_t* GU = (const bf16_t*)(F.ws + WS_GU); const bf16_t* GV = (const bf16_t*)(F.ws + WS_GV); bf16_t* SG = (bf16_t*)(F.ws + WS_SG);
    const int lane = F.lane, wave = F.wave;
    for (int tt = F.bid; tt < 1024; tt += F.G) {
        const int h = tt & 3, bn = tt >> 2; const size_t r0 = (size_t)bn * 128;
        __syncthreads();
        { const float* wsrc = F.w_sp + (size_t)h * 128 * 128;
#pragma unroll
          for (int i = 0; i < 8; ++i) { const int idx = F.tid * 4 + i * 2048; const int p = idx >> 7, q = idx & 127; const f32x4 v = *(const f32x4*)(wsrc + idx);
              u32x2 w; w.x = pk2(v.x, v.y); w.y = pk2(v.z, v.w); *(LAS u32x2*)(Ws + p * PITCH + q) = w; } }
        { const float g0 = F.ln_g[h * 128 + 2 * lane], g1 = F.ln_g[h * 128 + 2 * lane + 1], b0 = F.ln_b[h * 128 + 2 * lane], b1 = F.ln_b[h * 128 + 2 * lane + 1];
#pragma unroll 4
          for (int i = 0; i < 16; ++i) { const int q = wave * 16 + i;
              const unsigned w = *(const unsigned*)(GV + (r0 + q) * 512 + h * 128 + 2 * lane);
              const float a = bf_lo(w), b = bf_hi(w);
              const float mu = wave_sum(a + b) * (1.0f / 128.0f); const float da = a - mu, db = b - mu;
              const float var = wave_sum(da * da + db * db) * (1.0f / 128.0f); const float rs = 1.0f / sqrtf(var + EPS);
              Vt[(2 * lane) * PITCH + q] = (bf16_t)f2bf(da * rs * g0 + b0); Vt[(2 * lane + 1) * PITCH + q] = (bf16_t)f2bf(db * rs * g1 + b1); } }
        __syncthreads();
        f32x4 acc[8];
#pragma unroll
        for (int ct = 0; ct < 8; ++ct) acc[ct] = (f32x4){0.f, 0.f, 0.f, 0.f};
#pragma unroll
        for (int ks = 0; ks < 4; ++ks) {
            const bf16x8 bw = *(const LAS bf16x8*)(Ws + (wave * 16 + (lane & 15)) * PITCH + ks * 32 + 8 * (lane >> 4));
#pragma unroll
            for (int ct = 0; ct < 8; ++ct) { const bf16x8 av = *(const LAS bf16x8*)(Vt + (ct * 16 + (lane & 15)) * PITCH + ks * 32 + 8 * (lane >> 4));
                acc[ct] = __builtin_amdgcn_mfma_f32_16x16x32_bf16(av, bw, acc[ct], 0, 0, 0); }
        }
        const int p = wave * 16 + (lane & 15); const float bs = F.b_sp[h * 128 + p];
#pragma unroll
        for (int ct = 0; ct < 8; ++ct) { const int c = ct * 16 + 4 * (lane >> 4); const size_t off = (r0 + p) * 512 + h * 128 + c;
            const u32x2 uu = *(const u32x2*)(GU + off);
            u32x2 o; o.x = pk2(bf_lo(uu.x) * (acc[ct][0] + bs), bf_hi(uu.x) * (acc[ct][1] + bs)); o.y = pk2(bf_lo(uu.y) * (acc[ct][2] + bs), bf_hi(uu.y) * (acc[ct][3] + bs));
            *(u32x2*)(SG + off) = o; }
    }
    __syncthreads();
}

typedef short s16x4 __attribute__((ext_vector_type(4)));
template <int STAGE>
__device__ __forceinline__ void fft_stage(const Ctx& F) {
    constexpr int OPITCH = 272;
    LAS unsigned char* lds = F.lds;
    const int lane = F.lane, wave = F.wave, tid = F.tid;
    const int G = lane >> 4, q = (lane >> 2) & 3, p = lane & 3, fsw = q | ((G & 1) << 2);
    const bf16_t* MAT = (const bf16_t*)(F.ws + (STAGE == 0 ? WS_MA : WS_MB));
    const bf16_t* SRC = (const bf16_t*)(F.ws + (STAGE == 0 ? WS_YF : WS_AP));
    const int mt = (STAGE == 0) ? wave : (wave & 3);
    constexpr int NJT = (STAGE == 0) ? 8 : 4;
    const int jt0 = (STAGE == 0) ? 0 : 4 * (wave >> 2);
    bf16x8 afr[4];
#pragma unroll
    for (int ks = 0; ks < 4; ++ks) afr[ks] = *(const bf16x8*)(MAT + (size_t)(mt * 16 + (lane & 15)) * 128 + ks * 32 + 8 * G);
    unsigned soff[4];
#pragma unroll
    for (int i = 0; i < 4; ++i) { const int pos = i * 512 + tid, row = pos >> 4, cp = pos & 15; const int f = (row & 3) | (((row >> 3) & 1) << 2); soff[i] = (unsigned)(row * 256 + ((cp ^ (f << 1)) << 4)); }
    const unsigned rbase = (unsigned)((8 * G + q) * 256 + p * 8);
#define FFT_DMA(buf, t) do { const char* src_ = (const char*)SRC + (size_t)(t) * 32768; _Pragma("unroll") for (int i_ = 0; i_ < 4; ++i_) \
        __builtin_amdgcn_global_load_lds((const unsigned*)(src_ + soff[i_]), (LAS unsigned*)(lds + (buf) * 32768 + i_ * 8192 + wave * 1024), 16, 0, 0); } while (0)
    int t = F.bid, buf = 0;
    if (t < 2048) FFT_DMA(0, t);
    for (; t < 2048; t += F.G, buf ^= 1) {
        asm volatile("s_waitcnt vmcnt(0)" ::: "memory");
        __builtin_amdgcn_s_barrier();
        asm volatile("" ::: "memory");
        if (t + F.G < 2048) FFT_DMA(buf ^ 1, t + F.G);
        f32x4 acc[NJT];
#pragma unroll
        for (int jt = 0; jt < NJT; ++jt) acc[jt] = (f32x4){0.f, 0.f, 0.f, 0.f};
        const LAS unsigned char* xb = lds + buf * 32768 + rbase;
#pragma unroll
        for (int ks = 0; ks < 4; ++ks)
#pragma unroll
            for (int jt = 0; jt < NJT; ++jt) {
                const unsigned o = (unsigned)(ks * 32 * 256) + ((unsigned)(((jt0 + jt) ^ fsw)) << 5);
                const s16x4 lo = __builtin_amdgcn_ds_read_tr16_b64_v4i16((LAS s16x4*)(xb + o));
                const s16x4 hi = __builtin_amdgcn_ds_read_tr16_b64_v4i16((LAS s16x4*)(xb + o + 4 * 256));
                bf16x8 bfr; bfr[0] = lo[0]; bfr[1] = lo[1]; bfr[2] = lo[2]; bfr[3] = lo[3]; bfr[4] = hi[0]; bfr[5] = hi[1]; bfr[6] = hi[2]; bfr[7] = hi[3];
                acc[jt] = __builtin_amdgcn_mfma_f32_16x16x32_bf16(afr[ks], bfr, acc[jt], 0, 0, 0);
            }
        LAS unsigned char* ob = lds + 65536;
        if constexpr (STAGE == 0) {
            const int s_lo = t & 63, kl0 = 8 * wave + 2 * G;
            float c0, s0, c1, s1;
            sincospif((float)((kl0 * s_lo) & 4095) * (1.0f / 2048.0f), &s0, &c0);
            sincospif((float)(((kl0 + 1) * s_lo) & 4095) * (1.0f / 2048.0f), &s1, &c1);
#pragma unroll
            for (int jt = 0; jt < NJT; ++jt) { const f32x4 a = acc[jt]; const int col = 16 * jt + (lane & 15);
                LAS bf16_t* o0 = (LAS bf16_t*)(ob + (mt * 16 + 4 * G) * OPITCH) + col;
                o0[0 * (OPITCH / 2)] = (bf16_t)f2bf(a[0] * c0 + a[1] * s0); o0[1 * (OPITCH / 2)] = (bf16_t)f2bf(a[1] * c0 - a[0] * s0);
                o0[2 * (OPITCH / 2)] = (bf16_t)f2bf(a[2] * c1 + a[3] * s1); o0[3 * (OPITCH / 2)] = (bf16_t)f2bf(a[3] * c1 - a[2] * s1); }
        } else {
#pragma unroll
            for (int jt = 0; jt < NJT; ++jt) { const f32x4 a = acc[jt]; const int col = 16 * (jt0 + jt) + (lane & 15);
                LAS bf16_t* o0 = (LAS bf16_t*)(ob + (mt * 16 + 4 * G) * OPITCH) + col;
#pragma unroll
                for (int r = 0; r < 4; ++r) o0[r * (OPITCH / 2)] = (bf16_t)f2bf(a[r]); }
        }
        asm volatile("s_waitcnt lgkmcnt(0)" ::: "memory");
        __builtin_amdgcn_s_barrier();
        asm volatile("" ::: "memory");
        const int bg = t >> 6, lo6 = t & 63;
        if constexpr (STAGE == 0) {
            bf16_t* AP = (bf16_t*)(F.ws + WS_AP);
#pragma unroll
            for (int i = 0; i < 4; ++i) { const int id = tid + 512 * i, row = id >> 4, c = id & 15;
                const u32x4 v = *(const LAS u32x4*)(ob + row * OPITCH + c * 16);
                *(u32x4*)(AP + ((size_t)(bg * 64 + (row >> 1)) * 64 + lo6) * 256 + (row & 1) * 128 + c * 8) = v; }
        } else {
            bf16_t* FM = (bf16_t*)(F.ws + WS_FM);
#pragma unroll
            for (int i = 0; i < 2; ++i) { const int id = tid + 512 * i, row = id >> 4, c = id & 15;
                const u32x4 v = *(const LAS u32x4*)(ob + row * OPITCH + c * 16);
                *(u32x4*)(FM + ((size_t)(bg >> 2) * SEQ + lo6 + 64 * row) * FW + (bg & 3) * 128 + c * 8) = v; }
        }
    }
    asm volatile("s_waitcnt vmcnt(0) lgkmcnt(0)" ::: "memory");
    __builtin_amdgcn_s_barrier();
#undef FFT_DMA
}

struct Sched3 {
    const char* A0; const char* A1; const char* B0; const char* B1; int G, c;
    __device__ __forceinline__ bool next(int i, Unit& u) const {
        int pm, pn; if (!pg8::static_tile(MTOK / 256, D / 256, G, c, i >> 1, pm, pn)) return false;
        const int sub = i & 1;
        u.A = (sub ? A1 : A0) + (size_t)pm * 256 * 512 * 2; u.B = (sub ? B1 : B0) + (size_t)pn * 256 * 512 * 2; u.ridx = nullptr; u.pm = pm; u.pn = pn; u.kind = sub; return true;
    }
};
struct Epi3 {
    static constexpr bool PERM = true;
    const bf16_t* SGF; const bf16_t* SGS; bf16_t* MRG;
    __device__ __forceinline__ bool operator()(f32x4 (&acc)[2][2][4][2], const Unit& u, int wr, int wc, int fr, int fq) const {
        const int row0 = u.pm * 256 + wr * 64 + fr, col0 = u.pn * 256 + wc * 32 + 8 * fq;
        if (u.kind == 0) {
#pragma unroll
            for (int ai = 0; ai < 2; ++ai)
#pragma unroll
                for (int m = 0; m < 4; ++m) { const size_t off = (size_t)(row0 + ai * 128 + m * 16) * D + col0;
#pragma unroll
                    for (int bj = 0; bj < 2; ++bj) { const u32x4 f = *(const u32x4*)(SGF + off + bj * 128); const u32x4 s = *(const u32x4*)(SGS + off + bj * 128);
                        f32x4& v0 = acc[ai][bj][m][0]; f32x4& v1 = acc[ai][bj][m][1];
                        v0[0] *= bf_lo(f.x) * __builtin_amdgcn_rcpf(bf_lo(s.x)); v0[1] *= bf_hi(f.x) * __builtin_amdgcn_rcpf(bf_hi(s.x));
                        v0[2] *= bf_lo(f.y) * __builtin_amdgcn_rcpf(bf_lo(s.y)); v0[3] *= bf_hi(f.y) * __builtin_amdgcn_rcpf(bf_hi(s.y));
                        v1[0] *= bf_lo(f.z) * __builtin_amdgcn_rcpf(bf_lo(s.z)); v1[1] *= bf_hi(f.z) * __builtin_amdgcn_rcpf(bf_hi(s.z));
                        v1[2] *= bf_lo(f.w) * __builtin_amdgcn_rcpf(bf_lo(s.w)); v1[3] *= bf_hi(f.w) * __builtin_amdgcn_rcpf(bf_hi(s.w)); } }
            return true;
        }
#pragma unroll
        for (int ai = 0; ai < 2; ++ai)
#pragma unroll
            for (int m = 0; m < 4; ++m) { const size_t off = (size_t)(row0 + ai * 128 + m * 16) * D + col0;
#pragma unroll
                for (int bj = 0; bj < 2; ++bj) { const u32x4 s = *(const u32x4*)(SGS + off + bj * 128);
                    const f32x4 v0 = acc[ai][bj][m][0], v1 = acc[ai][bj][m][1];
                    u32x4 w; w.x = cvt_pk_bf16(v0[0] * bf_lo(s.x), v0[1] * bf_hi(s.x)); w.y = cvt_pk_bf16(v0[2] * bf_lo(s.y), v0[3] * bf_hi(s.y));
                    w.z = cvt_pk_bf16(v1[0] * bf_lo(s.z), v1[1] * bf_hi(s.z)); w.w = cvt_pk_bf16(v1[2] * bf_lo(s.w), v1[3] * bf_hi(s.w));
                    *(u32x4*)(MRG + off + bj * 128) = w; } }
        return false;
    }
};

struct Sched4 {
    const char* A; const char* B; int G, c;
    __device__ __forceinline__ bool next(int i, Unit& u) const {
        int pm, pn; if (!pg8::static_tile(MTOK / 256, D / 256, G, c, i, pm, pn)) return false;
        u.A = A + (size_t)pm * 256 * D * 2; u.B = B + (size_t)pn * 256 * D * 2; u.ridx = nullptr; u.pm = pm; u.pn = pn; u.kind = 0; return true;
    }
};
struct Epi4 {
    static constexpr bool PERM = false;
    const float* X; float* O;
    __device__ __forceinline__ bool operator()(f32x4 (&acc)[2][2][4][2], const Unit& u, int wr, int wc, int fr, int fq) const {
        const int row0 = u.pm * 256 + wr * 64 + fr, col0 = u.pn * 256 + wc * 32 + 4 * fq;
#pragma unroll
        for (int ai = 0; ai < 2; ++ai)
#pragma unroll
            for (int m = 0; m < 4; ++m) { const size_t off = (size_t)(row0 + ai * 128 + m * 16) * D + col0;
#pragma unroll
                for (int bj = 0; bj < 2; ++bj)
#pragma unroll
                    for (int n = 0; n < 2; ++n) { const f32x4 xv = *(const f32x4*)(X + off + bj * 128 + n * 16); *(f32x4*)(O + off + bj * 128 + n * 16) = xv + acc[ai][bj][m][n]; }
                asm volatile("" ::: "memory"); }
        return false;
    }
};

__device__ __forceinline__ void p5_rows(const Ctx& F, const int parts) {
    LAS float* scr = (LAS float*)(F.lds + F.wave * 16384);
    const int gw = F.bid * 8 + F.wave, NGW = F.G * 8;
    if (parts & 1) {
        bf16_t* WG = (bf16_t*)(F.ws + WS_RA);
        for (int it = gw; it < 16384; it += NGW) {
            const int e = it >> 10, src = (it >> 9) & 1, q = it & 511, kb = q >> 5, nb = q & 31;
            const int f0 = 64 * nb; const size_t dst_row0 = (size_t)e * 4096 + (size_t)(f0 >> 7) * 256 + (src ? 128 : 0) + (f0 & 127);
            transpose_item((src ? F.w_up : F.w_gate) + (size_t)e * D * DFF, DFF, 64 * kb, f0, WG, dst_row0, D, scr, F.lane);
        }
    }
    __syncthreads();
    if (!(parts & 2)) return;
    LAS f32x4* WR = (LAS f32x4*)F.lds;
    for (int i = F.tid; i < 1024 * 4; i += 512) { const int d = i >> 2, e4 = i & 3; WR[(((d >> 8) * 4 + (d & 3)) * 4 + e4) * 64 + ((d >> 2) & 63)] = ((const f32x4*)F.w_router)[i]; }
    __syncthreads();
    const float* X1 = F.out; bf16_t* H2 = (bf16_t*)(F.ws + WS_H2); float* AFF = (float*)(F.ws + WS_AFF);
    const int lane = F.lane;
    f32x4 gg[4];
#pragma unroll
    for (int j = 0; j < 4; ++j) gg[j] = ((const f32x4*)F.norm2_g)[64 * j + lane];
    for (int m = gw; m < MTOK; m += NGW) {
        const f32x4* xr = (const f32x4*)(X1 + (size_t)m * D) + lane;
        f32x4 v[4]; float s = 0.f;
#pragma unroll
        for (int j = 0; j < 4; ++j) { v[j] = xr[64 * j]; s += (v[j].x * v[j].x + v[j].y * v[j].y) + (v[j].z * v[j].z + v[j].w * v[j].w); }
        const float rstd = 1.0f / sqrtf(wave_sum(s) * (1.f / D) + EPS);
        u32x2* o8 = (u32x2*)(H2 + (size_t)m * D) + lane;
        float lg[16];
#pragma unroll
        for (int e = 0; e < 16; ++e) lg[e] = 0.f;
        asm volatile("" ::: "memory");
#pragma unroll
        for (int j = 0; j < 4; ++j) {
            v[j] = v[j] * rstd * gg[j];
            u32x2 w; w.x = pk2(v[j].x, v[j].y); w.y = pk2(v[j].z, v[j].w); o8[64 * j] = w;
#pragma unroll
            for (int t = 0; t < 4; ++t) { const float hv = v[j][t];
#pragma unroll
                for (int e4 = 0; e4 < 4; ++e4) { const f32x4 wv = WR[((j * 4 + t) * 4 + e4) * 64 + lane];
                    lg[e4 * 4 + 0] += hv * wv.x; lg[e4 * 4 + 1] += hv * wv.y; lg[e4 * 4 + 2] += hv * wv.z; lg[e4 * 4 + 3] += hv * wv.w; } }
            asm volatile("" ::: "memory");
        }
        float mx = -1e30f;
#pragma unroll
        for (int e = 0; e < 16; ++e) { lg[e] = wave_sum(lg[e]); mx = fmaxf(mx, lg[e]); }
        float den = 0.f, mine = 0.f;
#pragma unroll
        for (int e = 0; e < 16; ++e) { const float p = __expf(lg[e] - mx); den += p; mine = (lane == e) ? p : mine; }
        if (lane < 16) AFF[(size_t)m * 16 + lane] = mine / den;
    }
    __syncthreads();
}

__device__ __forceinline__ void p6_topk(const Ctx& F) {
    LAS unsigned* cnt = (LAS unsigned*)F.lds;
    const float* AFF = (const float*)(F.ws + WS_AFF);
    int* IDX = (int*)(F.ws + WS_IDX); float* GATE = (float*)(F.ws + WS_GATE); unsigned short* INV = (unsigned short*)(F.ws + WS_INV);
    const int lane = F.lane, wave = F.wave, tid = F.tid;
    for (int item = F.bid; item < NB * NE; item += F.G) {
        const int b = item >> 4, e = item & 15;
        unsigned key[8];
#pragma unroll
        for (int i = 0; i < 8; ++i) key[i] = __builtin_bit_cast(unsigned, AFF[((size_t)b * SEQ + 8 * tid + i) * 16 + e]);
        __syncthreads();
        unsigned T = 0u;
        for (int bit = 30; bit >= 0; --bit) {
            const unsigned cand = T | (1u << bit);
            unsigned c = 0;
#pragma unroll
            for (int i = 0; i < 8; ++i) c += (unsigned)__popcll(__ballot(key[i] >= cand));
            LAS unsigned* cb = cnt + (bit & 1) * 8;
            if (lane == 0) cb[wave] = c;
            __syncthreads();
            unsigned tot = 0;
#pragma unroll
            for (int w = 0; w < 8; ++w) tot += cb[w];
            if (tot >= (unsigned)CAP) T = cand;
        }
        __syncthreads();
        unsigned ngt_w = 0;
        int neq_t = 0;
#pragma unroll
        for (int i = 0; i < 8; ++i) { ngt_w += (unsigned)__popcll(__ballot(key[i] > T)); neq_t += (key[i] == T) ? 1 : 0; }
        LAS unsigned* sc = cnt + 16;
        int incl = neq_t;
#pragma unroll
        for (int o = 1; o < 64; o <<= 1) { const int t = __shfl_up(incl, o); if (lane >= o) incl += t; }
        if (lane == 63) sc[wave] = (unsigned)incl;
        if (lane == 0) sc[16 + wave] = ngt_w;
        __syncthreads();
        unsigned eq_base = 0, ngt = 0;
#pragma unroll
        for (int w = 0; w < 8; ++w) { eq_base += (w < wave) ? sc[w] : 0u; ngt += sc[16 + w]; }
        const int need = CAP - (int)ngt;
        int eq_rank = (int)eq_base + incl - neq_t;
        unsigned selm = 0; int nsel = 0;
#pragma unroll
        for (int i = 0; i < 8; ++i) { bool s = key[i] > T; if (key[i] == T) { s = eq_rank < need; ++eq_rank; } if (s) { selm |= 1u << i; ++nsel; } }
        int incl2 = nsel;
#pragma unroll
        for (int o = 1; o < 64; o <<= 1) { const int t = __shfl_up(incl2, o); if (lane >= o) incl2 += t; }
        if (lane == 63) sc[8 + wave] = (unsigned)incl2;
        __syncthreads();
        unsigned sbase = 0;
#pragma unroll
        for (int w = 0; w < 8; ++w) sbase += (w < wave) ? sc[8 + w] : 0u;
        int slot = (int)sbase + incl2 - nsel;
#pragma unroll
        for (int i = 0; i < 8; ++i) { const int tok = 8 * tid + i; unsigned short iv = 0xFFFFu;
            if (selm & (1u << i)) { IDX[(size_t)item * CAP + slot] = tok; GATE[(size_t)item * CAP + slot] = __builtin_bit_cast(float, key[i]); iv = (unsigned short)slot; ++slot; }
            INV[((size_t)b * SEQ + tok) * 16 + e] = iv; }
        __syncthreads();
    }
}

struct Sched7 {
    const char* H2; const char* WG; const int* IDX; int G, c;
    __device__ __forceinline__ bool next(int i, Unit& u) const {
        if (i >= 16) return false;
        const int e = i, x = c & 7, j = c >> 3;
        const int mt = (x >> 1) * 4 + (j & 3), nt = (x & 1) * 8 + (j >> 2);
        const int b = mt >> 1;
        u.A = H2 + (size_t)b * SEQ * D * 2; u.B = WG + ((size_t)e * 4096 + (size_t)nt * 256) * D * 2;
        u.ridx = IDX + ((size_t)(b * NE + e) * CAP + (mt & 1) * 256); u.pm = e * 16 + mt; u.pn = nt; u.kind = 0; return true;
    }
};
struct Epi7 {
    static constexpr bool PERM = true;
    bf16_t* H;
    __device__ __forceinline__ bool operator()(f32x4 (&acc)[2][2][4][2], const Unit& u, int wr, int wc, int fr, int fq) const {
        const int row0 = u.pm * 256 + wr * 64 + fr, col0 = u.pn * 128 + wc * 32 + 8 * fq;
#pragma unroll
        for (int ai = 0; ai < 2; ++ai)
#pragma unroll
            for (int m = 0; m < 4; ++m) {
                const f32x4 a0 = acc[ai][0][m][0], a1 = acc[ai][0][m][1], g0 = acc[ai][1][m][0], g1 = acc[ai][1][m][1];
                float r[8];
#pragma unroll
                for (int j = 0; j < 4; ++j) { r[j] = a0[j] * fast_sigmoid(a0[j]) * g0[j]; r[4 + j] = a1[j] * fast_sigmoid(a1[j]) * g1[j]; }
                u32x4 w; w.x = cvt_pk_bf16(r[0], r[1]); w.y = cvt_pk_bf16(r[2], r[3]); w.z = cvt_pk_bf16(r[4], r[5]); w.w = cvt_pk_bf16(r[6], r[7]);
                *(u32x4*)(H + (size_t)(row0 + ai * 128 + m * 16) * DFF + col0) = w; }
        return false;
    }
};

struct Sched8 {
    const char* H; const char* WD; int G, c;
    __device__ __forceinline__ bool next(int i, Unit& u) const {
        if (i >= 4) return false;
        const int x = c & 7, j = c >> 3;
        const int e = i * 4 + (x >> 1), mt = (x & 1) * 8 + (j & 7), nt = j >> 3;
        u.A = H + ((size_t)e * 4096 + (size_t)mt * 256) * DFF * 2; u.B = WD + ((size_t)e * D + (size_t)nt * 256) * DFF * 2; u.ridx = nullptr; u.pm = e * 16 + mt; u.pn = nt; u.kind = 0; return true;
    }
};
struct Epi8 {
    static constexpr bool PERM = true;
    bf16_t* Y; const float* GATE;
    __device__ __forceinline__ bool operator()(f32x4 (&acc)[2][2][4][2], const Unit& u, int wr, int wc, int fr, int fq) const {
        const int e = u.pm >> 4, mt = u.pm & 15, b = mt >> 1;
        const int rl0 = (mt & 1) * 256 + wr * 64 + fr;
        const int col0 = u.pn * 256 + wc * 32 + 8 * fq;
#pragma unroll
        for (int ai = 0; ai < 2; ++ai)
#pragma unroll
            for (int m = 0; m < 4; ++m) { const int sl = rl0 + ai * 128 + m * 16; const float gv = GATE[(size_t)(b * NE + e) * CAP + sl];
                bf16_t* rowp = Y + ((size_t)e * 4096 + (size_t)b * CAP + sl) * D + col0;
#pragma unroll
                for (int bj = 0; bj < 2; ++bj) { const f32x4 v0 = acc[ai][bj][m][0] * gv, v1 = acc[ai][bj][m][1] * gv;
                    u32x4 w; w.x = cvt_pk_bf16(v0[0], v0[1]); w.y = cvt_pk_bf16(v0[2], v0[3]); w.z = cvt_pk_bf16(v1[0], v1[1]); w.w = cvt_pk_bf16(v1[2], v1[3]);
                    *(u32x4*)(rowp + bj * 128) = w; } }
        return false;
    }
};

__device__ __forceinline__ void p9_final(const Ctx& F) {
    const int gw = F.bid * 8 + F.wave, NGW = F.G * 8, lane = F.lane;
    const unsigned short* INV = (const unsigned short*)(F.ws + WS_INV); const bf16_t* Y = (const bf16_t*)(F.ws + WS_RA);
    f32x4 gg[4];
#pragma unroll
    for (int j = 0; j < 4; ++j) gg[j] = ((const f32x4*)F.final_g)[64 * j + lane];
    for (int m = gw; m < MTOK; m += NGW) {
        f32x4* xr = (f32x4*)(F.out + (size_t)m * D) + lane;
        f32x4 v[4];
#pragma unroll
        for (int j = 0; j < 4; ++j) v[j] = xr[64 * j];
        const int b = m >> 12;
        const unsigned myinv = INV[(size_t)m * 16 + (lane & 15)];
#pragma unroll 1
        for (int e = 0; e < 16; ++e) {
            const unsigned sl = (unsigned)__builtin_amdgcn_readlane((int)myinv, e);
            if (sl != 0xFFFFu) {
                const u32x2* yr = (const u32x2*)(Y + ((size_t)e * 4096 + (size_t)b * CAP + sl) * D) + lane;
#pragma unroll
                for (int j = 0; j < 4; ++j) { const u32x2 w = yr[64 * j]; v[j].x += bf_lo(w.x); v[j].y += bf_hi(w.x); v[j].z += bf_lo(w.y); v[j].w += bf_hi(w.y); }
            }
        }
        float s = 0.f;
#pragma unroll
        for (int j = 0; j < 4; ++j) s += (v[j].x * v[j].x + v[j].y * v[j].y) + (v[j].z * v[j].z + v[j].w * v[j].w);
        const float rstd = 1.0f / sqrtf(wave_sum(s) * (1.f / D) + EPS);
#pragma unroll
        for (int j = 0; j < 4; ++j) xr[64 * j] = v[j] * rstd * gg[j];
    }
}

__global__ void __launch_bounds__(512, 2) mk_fwd(Args args) {
    extern __shared__ __attribute__((aligned(16))) unsigned char lds_raw[];
    cg::grid_group grid = cg::this_grid();
    Ctx F;
    F.lds = (LAS unsigned char*)lds_raw;
    F.tid = threadIdx.x; F.lane = F.tid & 63; F.wave = __builtin_amdgcn_readfirstlane(F.tid >> 6); F.G = gridDim.x; F.bid = blockIdx.x;
    F.x = args.in[0]; F.norm1_g = args.in[1]; F.w_in = args.in[2]; F.ln_g = args.in[3]; F.ln_b = args.in[4]; F.w_sp = args.in[5]; F.b_sp = args.in[6];
    F.w_fo = args.in[7]; F.w_so = args.in[8]; F.w_out = args.in[9]; F.norm2_g = args.in[10]; F.w_router = args.in[11]; F.w_gate = args.in[12]; F.w_up = args.in[13];
    F.w_down = args.in[14]; F.final_g = args.in[15]; F.out = args.out; F.ws = args.ws;
    const unsigned pm_ = args.ph_mask;
    unsigned char* ws = args.ws;
    if (F.tid < 2) ((LAS unsigned*)(F.lds + LDS_MISC))[F.tid] = 0u;
    __syncthreads();
    const XcdBarrier xbar = xcd_barrier_post((unsigned*)(ws + WS_CTL), (volatile LAS unsigned*)(F.lds + LDS_MISC));
#ifndef PH_CT_MASK
#define PH_CT_MASK 0xffffu
#endif
#define RUN(k) ((((PH_CT_MASK) >> (k)) & 1u) && ((pm_ >> (k)) & 1u))
#define SEAM(k) do { if ((pm_ & ((2u << (k)) - 1u)) && (pm_ >> ((k) + 1))) { if ((k) == 3) grid.sync(); else xcd_barrier(xbar); } } while (0)
    if (RUN(0) | RUN(1) | RUN(2) | RUN(3)) p0_prep(F, (int)(pm_ & 15u));
    SEAM(3);
    if (RUN(4)) {
        Sched1 S{(const char*)(ws + WS_HN), (const char*)(ws + WS_WIN), F.G, F.bid}; Epi1 E{ws};
        pg8::gemm_phase<Epi1, Sched1, false>(F.lds, D, S, E);
    }
    SEAM(4);
    if (RUN(5)) p2_sgu(F);
    if (RUN(6)) fft_stage<0>(F);
    SEAM(6);
    if (RUN(7)) fft_stage<1>(F);
    SEAM(7);
    if (RUN(8)) {
        Sched3 S{(const char*)(ws + WS_FM), (const char*)(ws + WS_SG), (const char*)(ws + WS_WFO), (const char*)(ws + WS_WSO), F.G, F.bid};
        Epi3 E{(const bf16_t*)(ws + WS_SGF), (const bf16_t*)(ws + WS_SGS), (bf16_t*)(ws + WS_MRG)};
        pg8::gemm_phase<Epi3, Sched3, false>(F.lds, 512, S, E);
    }
    SEAM(8);
    if (RUN(9)) {
        Sched4 S{(const char*)(ws + WS_MRG), (const char*)(ws + WS_WOUT), F.G, F.bid}; Epi4 E{F.x, F.out};
        pg8::gemm_phase<Epi4, Sched4, false>(F.lds, D, S, E);
    }
    SEAM(9);
    if (RUN(10) | RUN(11)) p5_rows(F, (int)((pm_ >> 10) & 3u));
    SEAM(11);
    if (RUN(12)) p6_topk(F);
    SEAM(12);
    if (RUN(13)) {
        Sched7 S{(const char*)(ws + WS_H2), (const char*)(ws + WS_RA), (const int*)(ws + WS_IDX), F.G, F.bid}; Epi7 E{(bf16_t*)(ws + WS_H)};
        pg8::gemm_phase<Epi7, Sched7, true>(F.lds, D, S, E);
    }
    SEAM(13);
    if (RUN(14)) {
        Sched8 S{(const char*)(ws + WS_H), (const char*)(ws + WS_WD), F.G, F.bid}; Epi8 E{(bf16_t*)(ws + WS_RA), (const float*)(ws + WS_GATE)};
        pg8::gemm_phase<Epi8, Sched8, false>(F.lds, DFF, S, E);
    }
    SEAM(14);
    if (RUN(15)) p9_final(F);
#undef RUN
#undef SEAM
}

extern "C" void kernel_launch(void* const* d_in, const int* in_sizes, int n_in, void* d_out, int out_size, void* d_ws, size_t ws_size, hipStream_t stream) {
    static int grid = 0;
    if (grid == 0) {
        if (n_in != 16 || out_size != MTOK * D || ws_size < WS_END) { fprintf(stderr, "kernel_launch: unexpected shapes (n_in %d, out %d, ws %zu < %zu)\n", n_in, out_size, ws_size, (size_t)WS_END); grid = -1; return; }
        int dev = 0, cus = 0, per_cu = 0;
        if (hipGetDevice(&dev) != hipSuccess || hipDeviceGetAttribute(&cus, hipDeviceAttributeMultiprocessorCount, dev) != hipSuccess) { grid = -1; return; }
        if (hipFuncSetAttribute((const void*)mk_fwd, hipFuncAttributeMaxDynamicSharedMemorySize, LDS_BYTES) != hipSuccess) { fprintf(stderr, "kernel_launch: hipFuncSetAttribute failed\n"); grid = -1; return; }
        if (hipOccupancyMaxActiveBlocksPerMultiprocessor(&per_cu, (const void*)mk_fwd, 512, LDS_BYTES) != hipSuccess || per_cu < 1) { fprintf(stderr, "kernel_launch: occupancy query failed (%d)\n", per_cu); grid = -1; return; }
        if (per_cu > 1) per_cu = 1;
        grid = cus * per_cu;
        if (grid != 256) fprintf(stderr, "kernel_launch: note: grid %d (tile orders are tuned for 256)\n", grid);
    }
    if (grid < 0) return;
    if (hipMemsetAsync((char*)d_ws + WS_CTL, 0, CTL_BYTES, stream) != hipSuccess) { fprintf(stderr, "kernel_launch: hipMemsetAsync failed\n"); return; }
    Args a{};
    for (int i = 0; i < 16; ++i) a.in[i] = (const float*)d_in[i];
    a.out = (float*)d_out; a.ws = (unsigned char*)d_ws;
#if MK_N_LAUNCHES == 1
    a.ph_mask = 0xffffu;
    void* kargs[] = {&a};
    hipError_t e = hipLaunchCooperativeKernel((const void*)mk_fwd, dim3(grid), dim3(512), kargs, LDS_BYTES, stream);
    if (e != hipSuccess) fprintf(stderr, "kernel_launch: cooperative launch failed: %s (grid %d)\n", hipGetErrorString(e), grid);
#else
#ifndef PROBE_DUP
#define PROBE_DUP 0
#endif
    for (int p = 0; p < 16; ++p) {
        const int reps = ((PROBE_DUP >> p) & 1) ? 2 : 1;
        for (int r = 0; r < reps; ++r) { a.ph_mask = 1u << p; hipLaunchKernelGGL(mk_fwd, dim3(grid), dim3(512), LDS_BYTES, stream, a); }
    }
#endif
}
```

```cpp
#include <hip/hip_runtime.h>
#include <hip/hip_cooperative_groups.h>
#include <cstdio>
#include <cstdint>
namespace cg = cooperative_groups;

#ifndef MK_N_LAUNCHES
#define MK_N_LAUNCHES 1
#endif

#define LAS __attribute__((address_space(3)))
typedef unsigned short bf16_t;
typedef short bf16x8 __attribute__((ext_vector_type(8)));
typedef float f32x4 __attribute__((ext_vector_type(4)));
typedef float f32x2 __attribute__((ext_vector_type(2)));
typedef unsigned u32x4 __attribute__((ext_vector_type(4)));
typedef unsigned u32x2 __attribute__((ext_vector_type(2)));
typedef int i32x4 __attribute__((ext_vector_type(4)));
typedef int i32x8 __attribute__((ext_vector_type(8)));

constexpr int D = 1024, NB = 8, SEQ = 4096, MTOK = NB * SEQ;
constexpr int FW = 512, SWD = 512, NE = 16, CAP = 512, DFF = 2048;
constexpr int N1 = 4096;
constexpr int INW = 3584;
constexpr float EPS = 1e-6f;

constexpr size_t MiB = 1u << 20;
constexpr size_t WS_RA = 0;
constexpr size_t WS_WD = 128 * MiB;
constexpr size_t WS_RH = 192 * MiB;
constexpr size_t WS_YF = WS_RH;
constexpr size_t WS_GU = WS_RH + 64 * MiB;
constexpr size_t WS_GV = WS_RH + 96 * MiB;
constexpr size_t WS_SGF = WS_RH + 128 * MiB;
constexpr size_t WS_SGS = WS_RH + 192 * MiB;
constexpr size_t WS_FM = WS_GU;
constexpr size_t WS_MRG = WS_RH;
constexpr size_t WS_H = WS_RH;
constexpr size_t WS_RS = 448 * MiB;
constexpr size_t WS_HN = WS_RS;
constexpr size_t WS_AP = WS_RS;
constexpr size_t WS_SG = WS_RA;
constexpr size_t WS_H2 = WS_RS;
constexpr size_t WS_WIN = 512 * MiB;
constexpr size_t WS_WFO = 520 * MiB;
constexpr size_t WS_WSO = 521 * MiB;
constexpr size_t WS_WOUT = 522 * MiB;
constexpr size_t WS_AFF = 524 * MiB;
constexpr size_t WS_INV = 526 * MiB;
constexpr size_t WS_IDX = 527 * MiB;
constexpr size_t WS_GATE = WS_IDX + 256 * 1024;
constexpr size_t WS_MA = WS_IDX + 512 * 1024;
constexpr size_t WS_MB = WS_MA + 32 * 1024;
constexpr size_t WS_CTL = WS_IDX + 768 * 1024;
constexpr size_t CTL_BYTES = 16384;
constexpr size_t WS_END = 528 * MiB;

constexpr int LDS_STAGE = 131072;
constexpr int LDS_X_OFF = LDS_STAGE;
constexpr int LDS_BYTES = 155648;
constexpr int LDS_MISC = LDS_BYTES - 64;

__device__ __forceinline__ unsigned f2bf(float f) { unsigned u = __builtin_bit_cast(unsigned, f); return (u + 0x7fffu + ((u >> 16) & 1u)) >> 16; }
__device__ __forceinline__ unsigned pk2(float lo, float hi) { return f2bf(lo) | (f2bf(hi) << 16); }
__device__ __forceinline__ unsigned cvt_pk_bf16(float lo, float hi) { unsigned r; asm volatile("v_cvt_pk_bf16_f32 %0, %1, %2" : "=v"(r) : "v"(lo), "v"(hi)); return r; }
__device__ __forceinline__ float bf_lo(unsigned w) { return __builtin_bit_cast(float, w << 16); }
__device__ __forceinline__ float bf_hi(unsigned w) { return __builtin_bit_cast(float, w & 0xffff0000u); }
__device__ __forceinline__ float wave_sum(float v) {
#pragma unroll
    for (int o = 1; o < 64; o <<= 1) v += __shfl_xor(v, o);
    return v;
}
__device__ __forceinline__ float fast_sigmoid(float x) { return __builtin_amdgcn_rcpf(1.0f + __builtin_amdgcn_exp2f(-1.44269504089f * x)); }
__device__ __forceinline__ float gelu_tanh(float x) {
    const float u = 1.5957691216f * (x + 0.044715f * x * x * x);
    return x * fast_sigmoid(u);
}
#define LDS_WAIT() asm volatile("s_waitcnt lgkmcnt(0)" ::: "memory")
__device__ __forceinline__ unsigned pk4_fp8(float a, float b, float c, float d) {
    a = fminf(fmaxf(a, -448.f), 448.f); b = fminf(fmaxf(b, -448.f), 448.f); c = fminf(fmaxf(c, -448.f), 448.f); d = fminf(fmaxf(d, -448.f), 448.f);
    int r = 0; r = __builtin_amdgcn_cvt_pk_fp8_f32(a, b, r, false); r = __builtin_amdgcn_cvt_pk_fp8_f32(c, d, r, true); return (unsigned)r;
}
constexpr float W8_SCALE = 32.0f;
constexpr float H8_SCALE = 8.0f;

namespace pg8 {
constexpr int BM = 256, BK = 64, HALF = 128, HTB = HALF * BK * 2, NXCD = 8, WGM = 8;
__device__ __forceinline__ int lds_byte(int r, int c) { const int st = (r >> 4) * 2 + (c >> 5), rr = r & 15, cc = c & 31, ob = rr * 64 + cc * 2; return st * 1024 + (ob ^ (((ob >> 9) & 1) << 5)); }
__device__ __forceinline__ void stage_rc(int b, int& R, int& C) { const int st = b / 1024, sb = b % 1024, swz = sb ^ (((sb >> 9) & 1) << 5); R = (st >> 1) * 16 + swz / 64; C = (st & 1) * 32 + (swz % 64) / 2; }
__device__ __forceinline__ int perm32(int rho) { const int n = rho >> 4, i = rho & 15; return 8 * (i >> 2) + 4 * n + (i & 3); }

struct Unit { const char* A; const char* B; const int* ridx; int pm, pn, kind; };

__device__ __forceinline__ bool static_tile(int nM, int nN, int G, int c, int i, int& pm, int& pn) {
    const int nwg = nM * nN; const long L = (long)i * G + c; if (L >= nwg) return false;
    int wgid = (int)L; { const int q = nwg / NXCD, r = nwg % NXCD, xcd = wgid % NXCD, off = wgid / NXCD; wgid = (xcd < r ? xcd * (q + 1) : r * (q + 1) + (xcd - r) * q) + off; }
    const int nig = WGM * nN, gid = wgid / nig, fm = gid * WGM, gsz = (nM - fm) < WGM ? (nM - fm) : WGM;
    pm = fm + ((wgid % nig) % gsz); pn = (wgid % nig) / gsz; return true;
}

template <class Epi, class Sched, bool GATHER, bool FP8 = false>
__device__ __forceinline__ void gemm_phase(LAS unsigned char* lds, const int K, const Sched& S, const Epi& E) {
    const int tid = threadIdx.x, wid = __builtin_amdgcn_readfirstlane(tid >> 6), lane = tid & 63, wr = wid >> 2, wc = wid & 3, fr = lane & 15, fq = lane >> 4;
    const int nt = K / BK;
    unsigned voffA[2], voffB[2]; int RA[2], CA2[2];
#pragma unroll
    for (int i = 0; i < 2; ++i) { int R, C; stage_rc(tid * 16 + i * 8192, R, C); const int Rb = Epi::PERM ? ((R & ~31) + perm32(R & 31)) : R;
        voffA[i] = (unsigned)(R * K + C) * 2u; voffB[i] = (unsigned)(Rb * K + C) * 2u; RA[i] = R; CA2[i] = C * 2; }
    const size_t kstep = (size_t)(BK * 2);
    const size_t hstep = (size_t)HALF * K * 2;
    const unsigned ldsw = (unsigned)wid * 1024u;
    const int aoff = lds_byte(wr * 64 + fr, fq * 8), boff = lds_byte(wc * 32 + fr, fq * 8);
#define PG8_SA(b, h) (((b) * 2 + (h)) * HTB)
#define PG8_SB(b, h) ((4 + (b) * 2 + (h)) * HTB)
#define PG8_GLDS(bufoff, gptr, _i) __builtin_amdgcn_global_load_lds((const unsigned*)(gptr), (LAS unsigned*)(lds + (bufoff) + ldsw + (_i) * 8192), 16, 0, 0)
#define PG8_STAGE_B(bufoff, gbase) do { _Pragma("unroll") for (int _i = 0; _i < 2; ++_i) PG8_GLDS(bufoff, (const char*)(gbase) + voffB[_i], _i); } while (0)
#define PG8_STAGE_A(bufoff, gbase, h, go) do { _Pragma("unroll") for (int _i = 0; _i < 2; ++_i) { \
        if constexpr (GATHER) PG8_GLDS(bufoff, (const char*)(gbase) + go[h][_i], _i); else PG8_GLDS(bufoff, (const char*)(gbase) + (h) * hstep + voffA[_i], _i); } } while (0)
#define PG8_LD2(d2, d8, base) do { const LAS i32x4* p_ = (const LAS i32x4*)(base); const i32x4 lo_ = p_[0], hi_ = p_[64]; \
        if constexpr (FP8) d8 = __builtin_shufflevector(lo_, hi_, 0, 1, 2, 3, 4, 5, 6, 7); else { d2[0] = __builtin_bit_cast(bf16x8, lo_); d2[1] = __builtin_bit_cast(bf16x8, hi_); } } while (0)
#define PG8_LDA(dst, b, h) do { _Pragma("unroll") for (int m = 0; m < 4; ++m) PG8_LD2(dst[m], dst##8[m], lds + PG8_SA(b, h) + aoff + m * 2048); } while (0)
#define PG8_LDB(dst, b, h) do { _Pragma("unroll") for (int n = 0; n < 2; ++n) PG8_LD2(dst[n], dst##8[n], lds + PG8_SB(b, h) + boff + n * 2048); } while (0)
#define PG8_MMA(ai, bj, At, Bt) do { __builtin_amdgcn_s_setprio(1); _Pragma("unroll") for (int m = 0; m < 4; ++m) _Pragma("unroll") for (int n = 0; n < 2; ++n) { \
        if constexpr (FP8) asm volatile("v_mfma_f32_16x16x128_f8f6f4 %0, %1, %2, %0" : "+v"(acc[ai][bj][m][n]) : "v"(Bt##8[n]), "v"(At##8[m])); \
        else { _Pragma("unroll") for (int k = 0; k < 2; ++k) acc[ai][bj][m][n] = __builtin_amdgcn_mfma_f32_16x16x32_bf16(Bt[n][k], At[m][k], acc[ai][bj][m][n], 0, 0, 0); } } \
        __builtin_amdgcn_s_setprio(0); } while (0)
#define PG8_WAIT_V(n) asm volatile("s_waitcnt vmcnt(" #n ")" ::: "memory")
#define PG8_WAIT_L(n) asm volatile("s_waitcnt lgkmcnt(" #n ")" ::: "memory")
#define PG8_BAR __builtin_amdgcn_s_barrier()
#define PG8_SCHED __builtin_amdgcn_sched_barrier(0)
#define PG8_GOFS(dst, u) do { if constexpr (GATHER) { _Pragma("unroll") for (int _h = 0; _h < 2; ++_h) _Pragma("unroll") for (int _i = 0; _i < 2; ++_i) \
        dst[_h][_i] = (unsigned)(u).ridx[_h * HALF + RA[_i]] * (unsigned)(K * 2) + (unsigned)CA2[_i]; } } while (0)
    Unit cur, nxt; int ui = 0;
    if (!S.next(0, cur)) return;
    f32x4 acc[2][2][4][2];
#pragma unroll
    for (int a = 0; a < 2; ++a)
#pragma unroll
        for (int b = 0; b < 2; ++b)
#pragma unroll
            for (int m = 0; m < 4; ++m)
#pragma unroll
                for (int n = 0; n < 2; ++n) acc[a][b][m][n] = (f32x4){0.f, 0.f, 0.f, 0.f};
    bf16x8 At[4][2], B0[2][2], B1[2][2]; i32x8 At8[4], B08[2], B18[2];
    unsigned gA[2][2] = {{0u, 0u}, {0u, 0u}}, gN[2][2] = {{0u, 0u}, {0u, 0u}};
    PG8_GOFS(gA, cur);
    const char* cA = cur.A; const char* cB = cur.B;
    PG8_STAGE_B(PG8_SB(0, 0), cB); PG8_STAGE_B(PG8_SB(0, 1), cB + hstep); PG8_STAGE_A(PG8_SA(0, 0), cA, 0, gA); PG8_STAGE_A(PG8_SA(0, 1), cA, 1, gA);
    if (wr == 1) PG8_BAR;
    PG8_WAIT_V(2); PG8_BAR;
    PG8_STAGE_B(PG8_SB(1, 0), cB + kstep); PG8_STAGE_A(PG8_SA(1, 0), cA + kstep, 0, gA); PG8_STAGE_B(PG8_SB(1, 1), cB + hstep + kstep);
    PG8_WAIT_V(6); PG8_BAR;
    for (;;) {
        const bool has_next = S.next(ui + 1, nxt);
        if (!has_next) nxt = cur;
        PG8_GOFS(gN, nxt);
        const char* nA = nxt.A; const char* nB = nxt.B;
#pragma clang loop unroll(disable)
        for (int t = 0; t < nt; t += 2) {
            const bool last = (t == nt - 2);
            const char* a1 = cA + (size_t)(t + 1) * kstep;
            const char* a2 = last ? nA : cA + (size_t)(t + 2) * kstep; const char* b2 = last ? nB : cB + (size_t)(t + 2) * kstep;
            const char* a3 = a2 + kstep; const char* b3 = b2 + kstep;
            unsigned g2[2][2];
#pragma unroll
            for (int _h = 0; _h < 2; ++_h)
#pragma unroll
                for (int _i = 0; _i < 2; ++_i) g2[_h][_i] = last ? gN[_h][_i] : gA[_h][_i];
            PG8_LDB(B0, 0, 0); PG8_LDB(B1, 0, 1); PG8_SCHED; PG8_LDA(At, 0, 0); PG8_STAGE_A(PG8_SA(1, 1), a1, 1, gA);
            PG8_WAIT_V(8); PG8_WAIT_L(0); PG8_BAR; PG8_MMA(0, 0, At, B0); PG8_MMA(0, 1, At, B1); PG8_BAR; PG8_SCHED;
            PG8_LDA(At, 0, 1); PG8_STAGE_B(PG8_SB(0, 0), b2); PG8_STAGE_B(PG8_SB(0, 1), b2 + hstep); PG8_STAGE_A(PG8_SA(0, 0), a2, 0, g2);
            PG8_WAIT_V(8); PG8_WAIT_L(0); PG8_BAR; PG8_MMA(1, 0, At, B0); PG8_MMA(1, 1, At, B1); PG8_BAR; PG8_SCHED;
            PG8_LDB(B0, 1, 0); PG8_LDB(B1, 1, 1); PG8_SCHED; PG8_LDA(At, 1, 0); PG8_STAGE_A(PG8_SA(0, 1), a2, 1, g2);
            PG8_WAIT_V(8); PG8_WAIT_L(0); PG8_BAR; PG8_MMA(0, 0, At, B0); PG8_MMA(0, 1, At, B1); PG8_BAR; PG8_SCHED;
            PG8_LDA(At, 1, 1); PG8_STAGE_B(PG8_SB(1, 0), b3); PG8_STAGE_B(PG8_SB(1, 1), b3 + hstep); PG8_STAGE_A(PG8_SA(1, 0), a3, 0, g2);
            PG8_WAIT_V(8); PG8_WAIT_L(0); PG8_BAR; PG8_MMA(1, 0, At, B0); PG8_MMA(1, 1, At, B1); PG8_BAR; PG8_SCHED;
        }
        if (wr == 0) PG8_BAR;
        if constexpr (FP8) asm volatile("s_nop 15\n\ts_nop 15" ::: "memory");
        const bool keep = E(acc, cur, wr, wc, fr, fq);
        if (!has_next) break;
        if (!keep) {
#pragma unroll
            for (int a = 0; a < 2; ++a)
#pragma unroll
                for (int b = 0; b < 2; ++b)
#pragma unroll
                    for (int m = 0; m < 4; ++m)
#pragma unroll
                        for (int n = 0; n < 2; ++n) acc[a][b][m][n] = (f32x4){0.f, 0.f, 0.f, 0.f};
        }
        cur = nxt; cA = nA; cB = nB; ++ui;
#pragma unroll
        for (int _h = 0; _h < 2; ++_h)
#pragma unroll
            for (int _i = 0; _i < 2; ++_i) gA[_h][_i] = gN[_h][_i];
        if (wr == 1) PG8_BAR;
    }
    PG8_WAIT_V(0);
    PG8_BAR;
#undef PG8_SA
#undef PG8_SB
#undef PG8_GLDS
#undef PG8_STAGE_A
#undef PG8_STAGE_B
#undef PG8_LDA
#undef PG8_LDB
#undef PG8_MMA
#undef PG8_LD2
#undef PG8_WAIT_V
#undef PG8_WAIT_L
#undef PG8_BAR
#undef PG8_SCHED
#undef PG8_GOFS
}
}
using pg8::Unit;

#define XB_TMO      128
#define XB_XCNT(j)  (256  + 64 * (j))
#define XB_XSUB(j)  (1280 + 64 * (j))
#define XB_XGEN(j)  (2304 + 64 * (j))
#define XB_TOP      3328
#define XB_TOPGEN   3392
#define XB_SPIN_CAP (1u << 22)
__device__ __forceinline__ unsigned xb_ld(unsigned* p)              { return __hip_atomic_load(p, __ATOMIC_RELAXED, __HIP_MEMORY_SCOPE_AGENT); }
__device__ __forceinline__ unsigned xb_add(unsigned* p, unsigned v) { return __hip_atomic_fetch_add(p, v, __ATOMIC_RELAXED, __HIP_MEMORY_SCOPE_AGENT); }
__device__ __forceinline__ unsigned xb_xcc_id() { return (unsigned)__builtin_amdgcn_s_getreg((3 << 11) | 20) & 0xFu; }
#define XB_SPIN(cond, bar) do { unsigned _sp = 0; while (cond) { __builtin_amdgcn_s_sleep(1); \
    if ((++_sp & 255u) == 0u) { if (xb_ld(&(bar)[XB_TMO])) break; if (_sp > XB_SPIN_CAP) { atomicAdd(&(bar)[XB_TMO], 1u); break; } } } } while (0)
struct XcdBarrier { unsigned* bar; unsigned x; volatile LAS unsigned* st; };
__device__ __forceinline__ XcdBarrier xcd_barrier_post(unsigned* bar, volatile LAS unsigned* st) {
    XcdBarrier b; b.bar = bar; b.x = xb_xcc_id(); b.st = st;
    if (threadIdx.x == 0) (void)xb_add(&bar[XB_XCNT(b.x)], 1u);
    return b;
}
__device__ __forceinline__ void xcd_barrier_complete(unsigned* bar, unsigned x, unsigned& nloc, unsigned& nx) {
    const unsigned G = gridDim.x * gridDim.y * gridDim.z;
    unsigned sum, cnt, mine, sp = 0u;
    for (;;) {
        sum = 0u; cnt = 0u; mine = 0u;
#pragma unroll
        for (unsigned j = 0; j < 16; ++j) { const unsigned c = xb_ld(&bar[XB_XCNT(j)]); sum += c; cnt += (c > 0u) ? 1u : 0u; mine = (j == x) ? c : mine; }
        if (sum == G) break;
        __builtin_amdgcn_s_sleep(1);
        if ((++sp & 255u) == 0u) { if (xb_ld(&bar[XB_TMO])) break; if (sp > XB_SPIN_CAP) { atomicAdd(&bar[XB_TMO], 1u); break; } }
    }
    nloc = mine > 0u ? mine : 1u; nx = cnt > 0u ? cnt : 1u;
}
__device__ __forceinline__ void xcd_barrier(const XcdBarrier& b) {
    asm volatile("s_waitcnt vmcnt(0)" ::: "memory");
    __syncthreads();
    if (threadIdx.x == 0) {
        unsigned* bar = b.bar;
        __builtin_amdgcn_s_waitcnt(0);
        unsigned nloc = b.st[0], nx = b.st[1];
        if (nloc == 0u) { xcd_barrier_complete(bar, b.x, nloc, nx); b.st[0] = nloc; b.st[1] = nx; }
        const unsigned old = xb_add(&bar[XB_XSUB(b.x)], 1u);
        const unsigned gen = old / nloc;
        if (old + 1u == (gen + 1u) * nloc) {
            __builtin_amdgcn_fence(__ATOMIC_RELEASE, "agent");
            asm volatile("s_waitcnt vmcnt(0)" ::: "memory");
            const unsigned og = xb_add(&bar[XB_TOP], 1u);
            const unsigned tg = og / nx;
            if (og + 1u == (tg + 1u) * nx) xb_add(&bar[XB_TOPGEN], 1u);
            else XB_SPIN(xb_ld(&bar[XB_TOPGEN]) == tg, bar);
            __builtin_amdgcn_fence(__ATOMIC_ACQUIRE, "agent");
            xb_add(&bar[XB_XGEN(b.x)], 1u);
            asm volatile("s_waitcnt vmcnt(0)" ::: "memory");
        } else {
            XB_SPIN(xb_ld(&bar[XB_XGEN(b.x)]) == gen, bar);
            __builtin_amdgcn_fence(__ATOMIC_ACQUIRE, "agent");
            asm volatile("s_waitcnt vmcnt(0)" ::: "memory");
        }
    }
    __syncthreads();
}

struct Args {
    const float* in[16];
    float* out;
    unsigned char* ws;
    unsigned ph_mask, pad;
};

struct Ctx {
    LAS unsigned char* lds;
    int tid, lane, wave, G, bid;
    const float *x, *norm1_g, *w_in, *ln_g, *ln_b, *w_sp, *b_sp, *w_fo, *w_so, *w_out, *norm2_g, *w_router, *w_gate, *w_up, *w_down, *final_g;
    float* out;
    unsigned char* ws;
};

__device__ __forceinline__ void transpose_item(const float* W, int N, int k0, int n0, bf16_t* WT, size_t dst_row0, int Kd, LAS float* scr, int lane) {
    const float* src = W + (size_t)(k0 + (lane >> 4)) * N + n0;
#pragma unroll
    for (int i = 0; i < 16; ++i) {
        const int n4 = (lane & 15) ^ ((i >> 1) & 7);
        __builtin_amdgcn_global_load_lds((const unsigned*)(src + (size_t)(4 * i) * N + 4 * n4), (LAS unsigned*)(scr + i * 256), 16, 0, 0);
    }
    asm volatile("s_waitcnt vmcnt(0)" ::: "memory");
    const int hh = lane >> 5, c = (lane >> 2) & 7, sub = lane & 3;
#pragma unroll
    for (int j = 0; j < 8; ++j) {
        const int n4 = 2 * j + hh;
        const LAS float* p = scr + (16 * (8 * c) + (n4 ^ c)) * 4 + sub;
        float v[8];
#pragma unroll
        for (int i = 0; i < 8; ++i) v[i] = p[i * 64];
        u32x4 o; o.x = pk2(v[0], v[1]); o.y = pk2(v[2], v[3]); o.z = pk2(v[4], v[5]); o.w = pk2(v[6], v[7]);
        *(u32x4*)(WT + (dst_row0 + 4 * n4 + sub) * (size_t)Kd + k0 + 8 * c) = o;
    }
    LDS_WAIT(); asm volatile("" ::: "memory");
}

__device__ __forceinline__ void transpose_item8(const float* W, int N, int k0, int n0, unsigned char* WT8, size_t dst_row0, int Kd, LAS float* scr, int lane) {
    const float* src = W + (size_t)(k0 + (lane >> 4)) * N + n0;
#pragma unroll
    for (int i = 0; i < 16; ++i) {
        const int n4 = (lane & 15) ^ ((i >> 1) & 7);
        __builtin_amdgcn_global_load_lds((const unsigned*)(src + (size_t)(4 * i) * N + 4 * n4), (LAS unsigned*)(scr + i * 256), 16, 0, 0);
    }
    asm volatile("s_waitcnt vmcnt(0)" ::: "memory");
    const int hh = lane >> 5, c = (lane >> 2) & 7, sub = lane & 3;
#pragma unroll
    for (int j = 0; j < 8; ++j) {
        const int n4 = 2 * j + hh;
        const LAS float* p = scr + (16 * (8 * c) + (n4 ^ c)) * 4 + sub;
        float v[8];
#pragma unroll
        for (int i = 0; i < 8; ++i) v[i] = p[i * 64] * W8_SCALE;
        u32x2 o; o.x = pk4_fp8(v[0], v[1], v[2], v[3]); o.y = pk4_fp8(v[4], v[5], v[6], v[7]);
        *(u32x2*)(WT8 + (dst_row0 + 4 * n4 + sub) * (size_t)Kd + k0 + 8 * c) = o;
    }
    LDS_WAIT(); asm volatile("" ::: "memory");
}

__device__ __forceinline__ void rms_rows4_to_bf16(const float* x0, const f32x4 (&gg)[4], bf16_t* o0, int lane) {
    f32x4 v[4][4];
#pragma unroll
    for (int r = 0; r < 4; ++r)
#pragma unroll
        for (int j = 0; j < 4; ++j) v[r][j] = ((const f32x4*)(x0 + (size_t)r * D))[64 * j + lane];
#pragma unroll
    for (int r = 0; r < 4; ++r) {
        float s = 0.f;
#pragma unroll
        for (int j = 0; j < 4; ++j) s += (v[r][j].x * v[r][j].x + v[r][j].y * v[r][j].y) + (v[r][j].z * v[r][j].z + v[r][j].w * v[r][j].w);
        const float rstd = 1.0f / sqrtf(wave_sum(s) * (1.f / D) + EPS);
        u32x2* o8 = (u32x2*)(o0 + (size_t)r * D) + lane;
#pragma unroll
        for (int j = 0; j < 4; ++j) { u32x2 w; w.x = pk2(v[r][j].x * rstd * gg[j].x, v[r][j].y * rstd * gg[j].y); w.y = pk2(v[r][j].z * rstd * gg[j].z, v[r][j].w * rstd * gg[j].w); o8[64 * j] = w; }
    }
}

__device__ __forceinline__ void p0_prep(const Ctx& F, const int parts) {
    LAS float* scr = (LAS float*)(F.lds + F.wave * 16384);
    LAS float* tab128 = (LAS float*)(F.lds + LDS_X_OFF);
    if (F.tid < 128) tab128[F.tid] = cospif((float)F.tid * (1.0f / 64.0f));
    __syncthreads();
    const int gw = F.bid * 8 + F.wave, NGW = F.G * 8;
    bf16_t* WinT = (bf16_t*)(F.ws + WS_WIN);
    if (parts & 1) {
        constexpr int I1 = 16 * 48, I2 = 8 * 16, I3 = 8 * 16, I4 = 16 * 16, I5 = 16 * 32 * 16;
        constexpr int NIT = I1 + I2 + I3 + I4 + I5;
        for (int it = gw; it < NIT; it += NGW) {
            int r = it;
            if (r < I1) { const int kb = r / 48, nb = r % 48; transpose_item(F.w_in, INW, 64 * kb, 512 + 64 * nb, WinT, (size_t)(1024 + 64 * nb), D, scr, F.lane); continue; } r -= I1;
            if (r < I2) { const int kb = r / 16, nb = r % 16; transpose_item(F.w_fo, D, 64 * kb, 64 * nb, (bf16_t*)(F.ws + WS_WFO), (size_t)(64 * nb), FW, scr, F.lane); continue; } r -= I2;
            if (r < I3) { const int kb = r / 16, nb = r % 16; transpose_item(F.w_so, D, 64 * kb, 64 * nb, (bf16_t*)(F.ws + WS_WSO), (size_t)(64 * nb), SWD, scr, F.lane); continue; } r -= I3;
            if (r < I4) { const int kb = r / 16, nb = r % 16; transpose_item(F.w_out, D, 64 * kb, 64 * nb, (bf16_t*)(F.ws + WS_WOUT), (size_t)(64 * nb), D, scr, F.lane); continue; } r -= I4;
            { const int e = r >> 9, q = r & 511, kb = q >> 4, nb = q & 15;
              transpose_item8(F.w_down + (size_t)e * DFF * D, D, 64 * kb, 64 * nb, (unsigned char*)(F.ws + WS_WD) + (size_t)e * D * DFF, (size_t)(64 * nb), DFF, scr, F.lane); }
        }
    }
    if (parts & 2) {
        const float sc = 0.08838834764831845f;
        for (int it = gw; it < 4096; it += NGW) {
            const int g = it >> 10, dt = (it >> 4) & 63, jt = it & 15;
            const int d0 = dt * 16, j0 = jt * 16, kk = F.lane >> 4;
            const int jj = (j0 + (F.lane & 15)) & 127; const int shift = (j0 >= 128) ? 96 : 0;
            const float* ap = F.w_in + (size_t)(d0 + (F.lane & 15)) * INW + g * 128 + 4 * kk;
            f32x4 av[8];
#pragma unroll
            for (int q = 0; q < 8; ++q) av[q] = *(const f32x4*)(ap + 16 * q);
            f32x4 acc = (f32x4){0.f, 0.f, 0.f, 0.f};
#pragma unroll
            for (int q = 0; q < 8; ++q)
#pragma unroll
                for (int t = 0; t < 4; ++t) {
                    const int c = 16 * q + 4 * kk + t;
                    const float b = tab128[(jj * c + shift) & 127] * sc;
                    acc = __builtin_amdgcn_mfma_f32_16x16x4f32(av[q][t], b, acc, 0, 0, 0);
                }
            u32x2 w; w.x = pk2(acc[0], acc[1]); w.y = pk2(acc[2], acc[3]);
            *(u32x2*)(WinT + (size_t)(g * 256 + j0 + (F.lane & 15)) * D + d0 + 4 * (F.lane >> 4)) = w;
        }
    }
    if (parts & 4) {
        bf16_t* HN = (bf16_t*)(F.ws + WS_HN);
        f32x4 gg[4];
#pragma unroll
        for (int j = 0; j < 4; ++j) gg[j] = ((const f32x4*)F.norm1_g)[64 * j + F.lane];
        for (int m4 = gw; m4 < MTOK / 4; m4 += NGW) rms_rows4_to_bf16(F.x + (size_t)m4 * 4 * D, gg, HN + (size_t)m4 * 4 * D, F.lane);
    }
    if (parts & 8) {
        bf16_t* MA = (bf16_t*)(F.ws + WS_MA); bf16_t* MB = (bf16_t*)(F.ws + WS_MB);
        const int gt = F.bid * 512 + F.tid, NT = F.G * 512;
        for (int q = gt; q < 128 * 128 + 64 * 128; q += NT) {
            if (q < 128 * 128) { const int o = q >> 7, k = q & 127, kl = o >> 1, ri = o & 1, sh = k >> 1, half = k & 1; const float a = (float)((kl * sh) & 63) * (1.0f / 32.0f);
                const float C = cospif(a), S = sinpif(a); const float v = (ri == 0) ? (half == 0 ? C : -S) : (half == 0 ? -S : -C); MA[q] = (bf16_t)f2bf(v * 0.125f); }
            else { const int qq = q - 128 * 128, kh = qq >> 7, k = qq & 127, sl = k >> 1, ri = k & 1; const float a = (float)((kh * sl) & 63) * (1.0f / 32.0f);
                MB[qq] = (bf16_t)f2bf((ri == 0 ? cospif(a) : sinpif(a)) * 0.125f); }
        }
    }
}

struct Sched1 {
    const char* A; const char* B; int G, c;
    __device__ __forceinline__ bool next(int i, Unit& u) const {
        int pm, pn; if (!pg8::static_tile(MTOK / 256, N1 / 256, G, c, i, pm, pn)) return false;
        u.A = A + (size_t)pm * 256 * D * 2; u.B = B + (size_t)pn * 256 * D * 2; u.ridx = nullptr; u.pm = pm; u.pn = pn; u.kind = 0; return true;
    }
};
struct Epi1 {
    static constexpr bool PERM = true;
    unsigned char* ws;
    __device__ __forceinline__ bool operator()(f32x4 (&acc)[2][2][4][2], const Unit& u, int wr, int wc, int fr, int fq) const {
        const int pn = u.pn;
        if (pn < 4) {
            bf16_t* Y = (bf16_t*)(ws + WS_YF);
            const int b = u.pm >> 4;
#pragma unroll
            for (int ai = 0; ai < 2; ++ai)
#pragma unroll
                for (int m = 0; m < 4; ++m) { const int s_lo = m * 16 + fr, s_hi = (u.pm & 15) * 4 + ai * 2 + wr;
                    bf16_t* rowp = Y + ((size_t)((b * 4 + pn) * 64 + s_lo) * 64 + s_hi) * 256 + wc * 32 + 8 * fq;
#pragma unroll
                    for (int bj = 0; bj < 2; ++bj) { const f32x4 v0 = acc[ai][bj][m][0], v1 = acc[ai][bj][m][1];
                        u32x4 w; w.x = cvt_pk_bf16(v0[0], v0[1]); w.y = cvt_pk_bf16(v0[2], v0[3]); w.z = cvt_pk_bf16(v1[0], v1[1]); w.w = cvt_pk_bf16(v1[2], v1[3]);
                        *(u32x4*)(rowp + bj * 128) = w; } }
            return false;
        }
        bf16_t* base; int ldc, colt; int act;
        if (pn < 6) { base = (bf16_t*)(ws + WS_GU); ldc = 512; colt = (pn - 4) * 256; act = 0; }
        else if (pn < 8) { base = (bf16_t*)(ws + WS_GV); ldc = 512; colt = (pn - 6) * 256; act = 0; }
        else if (pn < 12) { base = (bf16_t*)(ws + WS_SGF); ldc = 1024; colt = (pn - 8) * 256; act = 1; }
        else { base = (bf16_t*)(ws + WS_SGS); ldc = 1024; colt = (pn - 12) * 256; act = 1; }
        const int row0 = u.pm * 256 + wr * 64 + fr, col0 = colt + wc * 32 + 8 * fq;
#pragma unroll
        for (int ai = 0; ai < 2; ++ai)
#pragma unroll
            for (int m = 0; m < 4; ++m) { bf16_t* rowp = base + (size_t)(row0 + ai * 128 + m * 16) * ldc + col0;
#pragma unroll
                for (int bj = 0; bj < 2; ++bj) { f32x4 v0 = acc[ai][bj][m][0], v1 = acc[ai][bj][m][1];
                    if (act == 0) {
#pragma unroll
                        for (int j = 0; j < 4; ++j) { v0[j] = gelu_tanh(v0[j]); v1[j] = gelu_tanh(v1[j]); }
                    } else {
#pragma unroll
                        for (int j = 0; j < 4; ++j) { v0[j] = fast_sigmoid(v0[j]); v1[j] = fast_sigmoid(v1[j]); }
                    }
                    u32x4 w; w.x = cvt_pk_bf16(v0[0], v0[1]); w.y = cvt_pk_bf16(v0[2], v0[3]); w.z = cvt_pk_bf16(v1[0], v1[1]); w.w = cvt_pk_bf16(v1[2], v1[3]);
                    *(u32x4*)(rowp + bj * 128) = w; } }
        return false;
    }
};

__device__ __forceinline__ void p2_sgu(const Ctx& F) {
    constexpr int PITCH = 136;
    LAS bf16_t* Ws = (LAS bf16_t*)(F.lds);
    LAS bf16_t* Vt = (LAS bf16_t*)(F.lds + 128 * PITCH * 2);
    const bf16_t* GU = (const bf16_t*)(F.ws + WS_GU); const bf16_t* GV = (const bf16_t*)(F.ws + WS_GV); bf16_t* SG = (bf16_t*)(F.ws + WS_SG);
    const int lane = F.lane, wave = F.wave;
    for (int tt = F.bid; tt < 1024; tt += F.G) {
        const int h = tt & 3, bn = tt >> 2; const size_t r0 = (size_t)bn * 128;
        __syncthreads();
        { const float* wsrc = F.w_sp + (size_t)h * 128 * 128;
#pragma unroll
          for (int i = 0; i < 8; ++i) { const int idx = F.tid * 4 + i * 2048; const int p = idx >> 7, q = idx & 127; const f32x4 v = *(const f32x4*)(wsrc + idx);
              u32x2 w; w.x = pk2(v.x, v.y); w.y = pk2(v.z, v.w); *(LAS u32x2*)(Ws + p * PITCH + q) = w; } }
        { const float g0 = F.ln_g[h * 128 + 2 * lane], g1 = F.ln_g[h * 128 + 2 * lane + 1], b0 = F.ln_b[h * 128 + 2 * lane], b1 = F.ln_b[h * 128 + 2 * lane + 1];
#pragma unroll 4
          for (int i = 0; i < 16; ++i) { const int q = wave * 16 + i;
              const unsigned w = *(const unsigned*)(GV + (r0 + q) * 512 + h * 128 + 2 * lane);
              const float a = bf_lo(w), b = bf_hi(w);
              const float mu = wave_sum(a + b) * (1.0f / 128.0f); const float da = a - mu, db = b - mu;
              const float var = wave_sum(da * da + db * db) * (1.0f / 128.0f); const float rs = 1.0f / sqrtf(var + EPS);
              Vt[(2 * lane) * PITCH + q] = (bf16_t)f2bf(da * rs * g0 + b0); Vt[(2 * lane + 1) * PITCH + q] = (bf16_t)f2bf(db * rs * g1 + b1); } }
        __syncthreads();
        f32x4 acc[8];
#pragma unroll
        for (int ct = 0; ct < 8; ++ct) acc[ct] = (f32x4){0.f, 0.f, 0.f, 0.f};
#pragma unroll
        for (int ks = 0; ks < 4; ++ks) {
            const bf16x8 bw = *(const LAS bf16x8*)(Ws + (wave * 16 + (lane & 15)) * PITCH + ks * 32 + 8 * (lane >> 4));
#pragma unroll
            for (int ct = 0; ct < 8; ++ct) { const bf16x8 av = *(const LAS bf16x8*)(Vt + (ct * 16 + (lane & 15)) * PITCH + ks * 32 + 8 * (lane >> 4));
                acc[ct] = __builtin_amdgcn_mfma_f32_16x16x32_bf16(av, bw, acc[ct], 0, 0, 0); }
        }
        const int p = wave * 16 + (lane & 15); const float bs = F.b_sp[h * 128 + p];
#pragma unroll
        for (int ct = 0; ct < 8; ++ct) { const int c = ct * 16 + 4 * (lane >> 4); const size_t off = (r0 + p) * 512 + h * 128 + c;
            const u32x2 uu = *(const u32x2*)(GU + off);
            u32x2 o; o.x = pk2(bf_lo(uu.x) * (acc[ct][0] + bs), bf_hi(uu.x) * (acc[ct][1] + bs)); o.y = pk2(bf_lo(uu.y) * (acc[ct][2] + bs), bf_hi(uu.y) * (acc[ct][3] + bs));
            *(u32x2*)(SG + off) = o; }
    }
    __syncthreads();
}

typedef short s16x4 __attribute__((ext_vector_type(4)));
template <int STAGE>
__device__ __forceinline__ void fft_stage(const Ctx& F) {
    constexpr int OPITCH = 272;
    LAS unsigned char* lds = F.lds;
    const int lane = F.lane, wave = F.wave, tid = F.tid;
    const int G = lane >> 4, q = (lane >> 2) & 3, p = lane & 3, fsw = q | ((G & 1) << 2);
    const bf16_t* MAT = (const bf16_t*)(F.ws + (STAGE == 0 ? WS_MA : WS_MB));
    const bf16_t* SRC = (const bf16_t*)(F.ws + (STAGE == 0 ? WS_YF : WS_AP));
    const int mt = (STAGE == 0) ? wave : (wave & 3);
    constexpr int NJT = (STAGE == 0) ? 8 : 4;
    const int jt0 = (STAGE == 0) ? 0 : 4 * (wave >> 2);
    bf16x8 afr[4];
#pragma unroll
    for (int ks = 0; ks < 4; ++ks) afr[ks] = *(const bf16x8*)(MAT + (size_t)(mt * 16 + (lane & 15)) * 128 + ks * 32 + 8 * G);
    unsigned soff[4];
#pragma unroll
    for (int i = 0; i < 4; ++i) { const int pos = i * 512 + tid, row = pos >> 4, cp = pos & 15; const int f = (row & 3) | (((row >> 3) & 1) << 2); soff[i] = (unsigned)(row * 256 + ((cp ^ (f << 1)) << 4)); }
    const unsigned rbase = (unsigned)((8 * G + q) * 256 + p * 8);
#define FFT_DMA(buf, t) do { const char* src_ = (const char*)SRC + (size_t)(t) * 32768; _Pragma("unroll") for (int i_ = 0; i_ < 4; ++i_) \
        __builtin_amdgcn_global_load_lds((const unsigned*)(src_ + soff[i_]), (LAS unsigned*)(lds + (buf) * 32768 + i_ * 8192 + wave * 1024), 16, 0, 0); } while (0)
    int t = F.bid, buf = 0;
    if (t < 2048) FFT_DMA(0, t);
    for (; t < 2048; t += F.G, buf ^= 1) {
        asm volatile("s_waitcnt vmcnt(0)" ::: "memory");
        __builtin_amdgcn_s_barrier();
        asm volatile("" ::: "memory");
        if (t + F.G < 2048) FFT_DMA(buf ^ 1, t + F.G);
        f32x4 acc[NJT];
#pragma unroll
        for (int jt = 0; jt < NJT; ++jt) acc[jt] = (f32x4){0.f, 0.f, 0.f, 0.f};
        const LAS unsigned char* xb = lds + buf * 32768 + rbase;
#pragma unroll
        for (int ks = 0; ks < 4; ++ks)
#pragma unroll
            for (int jt = 0; jt < NJT; ++jt) {
                const unsigned o = (unsigned)(ks * 32 * 256) + ((unsigned)(((jt0 + jt) ^ fsw)) << 5);
                const s16x4 lo = __builtin_amdgcn_ds_read_tr16_b64_v4i16((LAS s16x4*)(xb + o));
                const s16x4 hi = __builtin_amdgcn_ds_read_tr16_b64_v4i16((LAS s16x4*)(xb + o + 4 * 256));
                bf16x8 bfr; bfr[0] = lo[0]; bfr[1] = lo[1]; bfr[2] = lo[2]; bfr[3] = lo[3]; bfr[4] = hi[0]; bfr[5] = hi[1]; bfr[6] = hi[2]; bfr[7] = hi[3];
                acc[jt] = __builtin_amdgcn_mfma_f32_16x16x32_bf16(afr[ks], bfr, acc[jt], 0, 0, 0);
            }
        LAS unsigned char* ob = lds + 65536;
        if constexpr (STAGE == 0) {
            const int s_lo = t & 63, kl0 = 8 * wave + 2 * G;
            float c0, s0, c1, s1;
            sincospif((float)((kl0 * s_lo) & 4095) * (1.0f / 2048.0f), &s0, &c0);
            sincospif((float)(((kl0 + 1) * s_lo) & 4095) * (1.0f / 2048.0f), &s1, &c1);
#pragma unroll
            for (int jt = 0; jt < NJT; ++jt) { const f32x4 a = acc[jt]; const int col = 16 * jt + (lane & 15);
                LAS bf16_t* o0 = (LAS bf16_t*)(ob + (mt * 16 + 4 * G) * OPITCH) + col;
                o0[0 * (OPITCH / 2)] = (bf16_t)f2bf(a[0] * c0 + a[1] * s0); o0[1 * (OPITCH / 2)] = (bf16_t)f2bf(a[1] * c0 - a[0] * s0);
                o0[2 * (OPITCH / 2)] = (bf16_t)f2bf(a[2] * c1 + a[3] * s1); o0[3 * (OPITCH / 2)] = (bf16_t)f2bf(a[3] * c1 - a[2] * s1); }
        } else {
#pragma unroll
            for (int jt = 0; jt < NJT; ++jt) { const f32x4 a = acc[jt]; const int col = 16 * (jt0 + jt) + (lane & 15);
                LAS bf16_t* o0 = (LAS bf16_t*)(ob + (mt * 16 + 4 * G) * OPITCH) + col;
#pragma unroll
                for (int r = 0; r < 4; ++r) o0[r * (OPITCH / 2)] = (bf16_t)f2bf(a[r]); }
        }
        asm volatile("s_waitcnt lgkmcnt(0)" ::: "memory");
        __builtin_amdgcn_s_barrier();
        asm volatile("" ::: "memory");
        const int bg = t >> 6, lo6 = t & 63;
        if constexpr (STAGE == 0) {
            bf16_t* AP = (bf16_t*)(F.ws + WS_AP);
#pragma unroll
            for (int i = 0; i < 4; ++i) { const int id = tid + 512 * i, row = id >> 4, c = id & 15;
                const u32x4 v = *(const LAS u32x4*)(ob + row * OPITCH + c * 16);
                *(u32x4*)(AP + ((size_t)(bg * 64 + (row >> 1)) * 64 + lo6) * 256 + (row & 1) * 128 + c * 8) = v; }
        } else {
            bf16_t* FM = (bf16_t*)(F.ws + WS_FM);
#pragma unroll
            for (int i = 0; i < 2; ++i) { const int id = tid + 512 * i, row = id >> 4, c = id & 15;
                const u32x4 v = *(const LAS u32x4*)(ob + row * OPITCH + c * 16);
                *(u32x4*)(FM + ((size_t)(bg >> 2) * SEQ + lo6 + 64 * row) * FW + (bg & 3) * 128 + c * 8) = v; }
        }
    }
    asm volatile("s_waitcnt vmcnt(0) lgkmcnt(0)" ::: "memory");
    __builtin_amdgcn_s_barrier();
#undef FFT_DMA
}

struct Sched3 {
    const char* A0; const char* A1; const char* B0; const char* B1; int G, c;
    __device__ __forceinline__ bool next(int i, Unit& u) const {
        int pm, pn; if (!pg8::static_tile(MTOK / 256, D / 256, G, c, i >> 1, pm, pn)) return false;
        const int sub = i & 1;
        u.A = (sub ? A1 : A0) + (size_t)pm * 256 * 512 * 2; u.B = (sub ? B1 : B0) + (size_t)pn * 256 * 512 * 2; u.ridx = nullptr; u.pm = pm; u.pn = pn; u.kind = sub; return true;
    }
};
struct Epi3 {
    static constexpr bool PERM = true;
    const bf16_t* SGF; const bf16_t* SGS; bf16_t* MRG;
    __device__ __forceinline__ bool operator()(f32x4 (&acc)[2][2][4][2], const Unit& u, int wr, int wc, int fr, int fq) const {
        const int row0 = u.pm * 256 + wr * 64 + fr, col0 = u.pn * 256 + wc * 32 + 8 * fq;
        if (u.kind == 0) {
#pragma unroll
            for (int ai = 0; ai < 2; ++ai)
#pragma unroll
                for (int m = 0; m < 4; ++m) { const size_t off = (size_t)(row0 + ai * 128 + m * 16) * D + col0;
#pragma unroll
                    for (int bj = 0; bj < 2; ++bj) { const u32x4 f = *(const u32x4*)(SGF + off + bj * 128); const u32x4 s = *(const u32x4*)(SGS + off + bj * 128);
                        f32x4& v0 = acc[ai][bj][m][0]; f32x4& v1 = acc[ai][bj][m][1];
                        v0[0] *= bf_lo(f.x) * __builtin_amdgcn_rcpf(bf_lo(s.x)); v0[1] *= bf_hi(f.x) * __builtin_amdgcn_rcpf(bf_hi(s.x));
                        v0[2] *= bf_lo(f.y) * __builtin_amdgcn_rcpf(bf_lo(s.y)); v0[3] *= bf_hi(f.y) * __builtin_amdgcn_rcpf(bf_hi(s.y));
                        v1[0] *= bf_lo(f.z) * __builtin_amdgcn_rcpf(bf_lo(s.z)); v1[1] *= bf_hi(f.z) * __builtin_amdgcn_rcpf(bf_hi(s.z));
                        v1[2] *= bf_lo(f.w) * __builtin_amdgcn_rcpf(bf_lo(s.w)); v1[3] *= bf_hi(f.w) * __builtin_amdgcn_rcpf(bf_hi(s.w)); } }
            return true;
        }
#pragma unroll
        for (int ai = 0; ai < 2; ++ai)
#pragma unroll
            for (int m = 0; m < 4; ++m) { const size_t off = (size_t)(row0 + ai * 128 + m * 16) * D + col0;
#pragma unroll
                for (int bj = 0; bj < 2; ++bj) { const u32x4 s = *(const u32x4*)(SGS + off + bj * 128);
                    const f32x4 v0 = acc[ai][bj][m][0], v1 = acc[ai][bj][m][1];
                    u32x4 w; w.x = cvt_pk_bf16(v0[0] * bf_lo(s.x), v0[1] * bf_hi(s.x)); w.y = cvt_pk_bf16(v0[2] * bf_lo(s.y), v0[3] * bf_hi(s.y));
                    w.z = cvt_pk_bf16(v1[0] * bf_lo(s.z), v1[1] * bf_hi(s.z)); w.w = cvt_pk_bf16(v1[2] * bf_lo(s.w), v1[3] * bf_hi(s.w));
                    *(u32x4*)(MRG + off + bj * 128) = w; } }
        return false;
    }
};

struct Sched4 {
    const char* A; const char* B; int G, c;
    __device__ __forceinline__ bool next(int i, Unit& u) const {
        int pm, pn; if (!pg8::static_tile(MTOK / 256, D / 256, G, c, i, pm, pn)) return false;
        u.A = A + (size_t)pm * 256 * D * 2; u.B = B + (size_t)pn * 256 * D * 2; u.ridx = nullptr; u.pm = pm; u.pn = pn; u.kind = 0; return true;
    }
};
struct Epi4 {
    static constexpr bool PERM = false;
    const float* X; float* O;
    __device__ __forceinline__ bool operator()(f32x4 (&acc)[2][2][4][2], const Unit& u, int wr, int wc, int fr, int fq) const {
        const int row0 = u.pm * 256 + wr * 64 + fr, col0 = u.pn * 256 + wc * 32 + 4 * fq;
#pragma unroll
        for (int ai = 0; ai < 2; ++ai)
#pragma unroll
            for (int m = 0; m < 4; ++m) { const size_t off = (size_t)(row0 + ai * 128 + m * 16) * D + col0;
#pragma unroll
                for (int bj = 0; bj < 2; ++bj)
#pragma unroll
                    for (int n = 0; n < 2; ++n) { const f32x4 xv = *(const f32x4*)(X + off + bj * 128 + n * 16); *(f32x4*)(O + off + bj * 128 + n * 16) = xv + acc[ai][bj][m][n]; }
                asm volatile("" ::: "memory"); }
        return false;
    }
};

__device__ __forceinline__ void p5_rows(const Ctx& F, const int parts) {
    LAS float* scr = (LAS float*)(F.lds + F.wave * 16384);
    const int gw = F.bid * 8 + F.wave, NGW = F.G * 8;
    if (parts & 1) {
        unsigned char* WG = (unsigned char*)(F.ws + WS_RA);
        for (int it = gw; it < 16384; it += NGW) {
            const int e = it >> 10, src = (it >> 9) & 1, q = it & 511, kb = q >> 5, nb = q & 31;
            const int f0 = 64 * nb; const size_t dst_row0 = (size_t)e * 4096 + (size_t)(f0 >> 7) * 256 + (src ? 128 : 0) + (f0 & 127);
            transpose_item8((src ? F.w_up : F.w_gate) + (size_t)e * D * DFF, DFF, 64 * kb, f0, WG, dst_row0, D, scr, F.lane);
        }
    }
    __syncthreads();
    if (!(parts & 2)) return;
    LAS f32x4* WR = (LAS f32x4*)F.lds;
    for (int i = F.tid; i < 1024 * 4; i += 512) { const int d = i >> 2, e4 = i & 3; WR[(((d >> 8) * 4 + (d & 3)) * 4 + e4) * 64 + ((d >> 2) & 63)] = ((const f32x4*)F.w_router)[i]; }
    __syncthreads();
    const float* X1 = F.out; unsigned char* H2 = (unsigned char*)(F.ws + WS_H2); float* AFF = (float*)(F.ws + WS_AFF);
    const int lane = F.lane;
    f32x4 gg[4];
#pragma unroll
    for (int j = 0; j < 4; ++j) gg[j] = ((const f32x4*)F.norm2_g)[64 * j + lane];
    for (int m = gw; m < MTOK; m += NGW) {
        const f32x4* xr = (const f32x4*)(X1 + (size_t)m * D) + lane;
        f32x4 v[4]; float s = 0.f;
#pragma unroll
        for (int j = 0; j < 4; ++j) { v[j] = xr[64 * j]; s += (v[j].x * v[j].x + v[j].y * v[j].y) + (v[j].z * v[j].z + v[j].w * v[j].w); }
        const float rstd = 1.0f / sqrtf(wave_sum(s) * (1.f / D) + EPS);
        unsigned* o4 = (unsigned*)(H2 + (size_t)m * D) + lane;
        float lg[16];
#pragma unroll
        for (int e = 0; e < 16; ++e) lg[e] = 0.f;
        asm volatile("" ::: "memory");
#pragma unroll
        for (int j = 0; j < 4; ++j) {
            v[j] = v[j] * rstd * gg[j];
            o4[64 * j] = pk4_fp8(v[j].x, v[j].y, v[j].z, v[j].w);
#pragma unroll
            for (int t = 0; t < 4; ++t) { const float hv = v[j][t];
#pragma unroll
                for (int e4 = 0; e4 < 4; ++e4) { const f32x4 wv = WR[((j * 4 + t) * 4 + e4) * 64 + lane];
                    lg[e4 * 4 + 0] += hv * wv.x; lg[e4 * 4 + 1] += hv * wv.y; lg[e4 * 4 + 2] += hv * wv.z; lg[e4 * 4 + 3] += hv * wv.w; } }
            asm volatile("" ::: "memory");
        }
        float mx = -1e30f;
#pragma unroll
        for (int e = 0; e < 16; ++e) { lg[e] = wave_sum(lg[e]); mx = fmaxf(mx, lg[e]); }
        float den = 0.f, mine = 0.f;
#pragma unroll
        for (int e = 0; e < 16; ++e) { const float p = __expf(lg[e] - mx); den += p; mine = (lane == e) ? p : mine; }
        if (lane < 16) AFF[(size_t)m * 16 + lane] = mine / den;
    }
    __syncthreads();
}

__device__ __forceinline__ void p6_topk(const Ctx& F) {
    LAS unsigned* cnt = (LAS unsigned*)F.lds;
    const float* AFF = (const float*)(F.ws + WS_AFF);
    int* IDX = (int*)(F.ws + WS_IDX); float* GATE = (float*)(F.ws + WS_GATE); unsigned short* INV = (unsigned short*)(F.ws + WS_INV);
    const int lane = F.lane, wave = F.wave, tid = F.tid;
    for (int item = F.bid; item < NB * NE; item += F.G) {
        const int b = item >> 4, e = item & 15;
        unsigned key[8];
#pragma unroll
        for (int i = 0; i < 8; ++i) key[i] = __builtin_bit_cast(unsigned, AFF[((size_t)b * SEQ + 8 * tid + i) * 16 + e]);
        __syncthreads();
        unsigned T = 0u;
        for (int bit = 30; bit >= 0; --bit) {
            const unsigned cand = T | (1u << bit);
            unsigned c = 0;
#pragma unroll
            for (int i = 0; i < 8; ++i) c += (unsigned)__popcll(__ballot(key[i] >= cand));
            LAS unsigned* cb = cnt + (bit & 1) * 8;
            if (lane == 0) cb[wave] = c;
            __syncthreads();
            unsigned tot = 0;
#pragma unroll
            for (int w = 0; w < 8; ++w) tot += cb[w];
            if (tot >= (unsigned)CAP) T = cand;
        }
        __syncthreads();
        unsigned ngt_w = 0;
        int neq_t = 0;
#pragma unroll
        for (int i = 0; i < 8; ++i) { ngt_w += (unsigned)__popcll(__ballot(key[i] > T)); neq_t += (key[i] == T) ? 1 : 0; }
        LAS unsigned* sc = cnt + 16;
        int incl = neq_t;
#pragma unroll
        for (int o = 1; o < 64; o <<= 1) { const int t = __shfl_up(incl, o); if (lane >= o) incl += t; }
        if (lane == 63) sc[wave] = (unsigned)incl;
        if (lane == 0) sc[16 + wave] = ngt_w;
        __syncthreads();
        unsigned eq_base = 0, ngt = 0;
#pragma unroll
        for (int w = 0; w < 8; ++w) { eq_base += (w < wave) ? sc[w] : 0u; ngt += sc[16 + w]; }
        const int need = CAP - (int)ngt;
        int eq_rank = (int)eq_base + incl - neq_t;
        unsigned selm = 0; int nsel = 0;
#pragma unroll
        for (int i = 0; i < 8; ++i) { bool s = key[i] > T; if (key[i] == T) { s = eq_rank < need; ++eq_rank; } if (s) { selm |= 1u << i; ++nsel; } }
        int incl2 = nsel;
#pragma unroll
        for (int o = 1; o < 64; o <<= 1) { const int t = __shfl_up(incl2, o); if (lane >= o) incl2 += t; }
        if (lane == 63) sc[8 + wave] = (unsigned)incl2;
        __syncthreads();
        unsigned sbase = 0;
#pragma unroll
        for (int w = 0; w < 8; ++w) sbase += (w < wave) ? sc[8 + w] : 0u;
        int slot = (int)sbase + incl2 - nsel;
#pragma unroll
        for (int i = 0; i < 8; ++i) { const int tok = 8 * tid + i; unsigned short iv = 0xFFFFu;
            if (selm & (1u << i)) { IDX[(size_t)item * CAP + slot] = tok; GATE[(size_t)item * CAP + slot] = __builtin_bit_cast(float, key[i]); iv = (unsigned short)slot; ++slot; }
            INV[((size_t)b * SEQ + tok) * 16 + e] = iv; }
        __syncthreads();
    }
}

struct Sched7 {
    const char* H2; const char* WG; const int* IDX; int G, c;
    __device__ __forceinline__ bool next(int i, Unit& u) const {
        if (i >= 16) return false;
        const int e = i, x = c & 7, j = c >> 3;
        const int mt = (x >> 1) * 4 + (j & 3), nt = (x & 1) * 8 + (j >> 2);
        const int b = mt >> 1;
        u.A = H2 + (size_t)b * SEQ * D; u.B = WG + ((size_t)e * 4096 + (size_t)nt * 256) * D;
        u.ridx = IDX + ((size_t)(b * NE + e) * CAP + (mt & 1) * 256); u.pm = e * 16 + mt; u.pn = nt; u.kind = 0; return true;
    }
};
struct Epi7 {
    static constexpr bool PERM = true;
    unsigned char* H;
    __device__ __forceinline__ bool operator()(f32x4 (&acc)[2][2][4][2], const Unit& u, int wr, int wc, int fr, int fq) const {
        const int row0 = u.pm * 256 + wr * 64 + fr, col0 = u.pn * 128 + wc * 32 + 8 * fq;
        const float ws = 1.0f / W8_SCALE, os = H8_SCALE / W8_SCALE;
#pragma unroll
        for (int ai = 0; ai < 2; ++ai)
#pragma unroll
            for (int m = 0; m < 4; ++m) {
                const f32x4 a0 = acc[ai][0][m][0], a1 = acc[ai][0][m][1], g0 = acc[ai][1][m][0], g1 = acc[ai][1][m][1];
                float r[8];
#pragma unroll
                for (int j = 0; j < 4; ++j) { const float x0 = a0[j] * ws, x1 = a1[j] * ws; r[j] = x0 * fast_sigmoid(x0) * (g0[j] * os); r[4 + j] = x1 * fast_sigmoid(x1) * (g1[j] * os); }
                u32x2 w; w.x = pk4_fp8(r[0], r[1], r[2], r[3]); w.y = pk4_fp8(r[4], r[5], r[6], r[7]);
                *(u32x2*)(H + (size_t)(row0 + ai * 128 + m * 16) * DFF + col0) = w;
                asm volatile("" ::: "memory"); }
        return false;
    }
};

struct Sched8 {
    const char* H; const char* WD; int G, c;
    __device__ __forceinline__ bool next(int i, Unit& u) const {
        if (i >= 4) return false;
        const int x = c & 7, j = c >> 3;
        const int e = i * 4 + (x >> 1), mt = (x & 1) * 8 + (j & 7), nt = j >> 3;
        u.A = H + ((size_t)e * 4096 + (size_t)mt * 256) * DFF; u.B = WD + ((size_t)e * D + (size_t)nt * 256) * DFF; u.ridx = nullptr; u.pm = e * 16 + mt; u.pn = nt; u.kind = 0; return true;
    }
};
struct Epi8 {
    static constexpr bool PERM = true;
    bf16_t* Y; const float* GATE;
    __device__ __forceinline__ bool operator()(f32x4 (&acc)[2][2][4][2], const Unit& u, int wr, int wc, int fr, int fq) const {
        const int e = u.pm >> 4, mt = u.pm & 15, b = mt >> 1;
        const int rl0 = (mt & 1) * 256 + wr * 64 + fr;
        const int col0 = u.pn * 256 + wc * 32 + 8 * fq;
#pragma unroll
        for (int ai = 0; ai < 2; ++ai)
#pragma unroll
            for (int m = 0; m < 4; ++m) { const int sl = rl0 + ai * 128 + m * 16; const float gv = GATE[(size_t)(b * NE + e) * CAP + sl] * (1.0f / (W8_SCALE * H8_SCALE));
                bf16_t* rowp = Y + ((size_t)e * 4096 + (size_t)b * CAP + sl) * D + col0;
#pragma unroll
                for (int bj = 0; bj < 2; ++bj) { const f32x4 v0 = acc[ai][bj][m][0] * gv, v1 = acc[ai][bj][m][1] * gv;
                    u32x4 w; w.x = cvt_pk_bf16(v0[0], v0[1]); w.y = cvt_pk_bf16(v0[2], v0[3]); w.z = cvt_pk_bf16(v1[0], v1[1]); w.w = cvt_pk_bf16(v1[2], v1[3]);
                    *(u32x4*)(rowp + bj * 128) = w; } }
        return false;
    }
};

__device__ __forceinline__ void p9_final(const Ctx& F) {
    const int gw = F.bid * 8 + F.wave, NGW = F.G * 8, lane = F.lane;
    const unsigned short* INV = (const unsigned short*)(F.ws + WS_INV); const bf16_t* Y = (const bf16_t*)(F.ws + WS_RA);
    f32x4 gg[4];
#pragma unroll
    for (int j = 0; j < 4; ++j) gg[j] = ((const f32x4*)F.final_g)[64 * j + lane];
    for (int m = gw; m < MTOK; m += NGW) {
        f32x4* xr = (f32x4*)(F.out + (size_t)m * D) + lane;
        f32x4 v[4];
#pragma unroll
        for (int j = 0; j < 4; ++j) v[j] = xr[64 * j];
        const int b = m >> 12;
        const unsigned myinv = INV[(size_t)m * 16 + (lane & 15)];
#pragma unroll 1
        for (int e = 0; e < 16; ++e) {
            const unsigned sl = (unsigned)__builtin_amdgcn_readlane((int)myinv, e);
            if (sl != 0xFFFFu) {
                const u32x2* yr = (const u32x2*)(Y + ((size_t)e * 4096 + (size_t)b * CAP + sl) * D) + lane;
#pragma unroll
                for (int j = 0; j < 4; ++j) { const u32x2 w = yr[64 * j]; v[j].x += bf_lo(w.x); v[j].y += bf_hi(w.x); v[j].z += bf_lo(w.y); v[j].w += bf_hi(w.y); }
            }
        }
        float s = 0.f;
#pragma unroll
        for (int j = 0; j < 4; ++j) s += (v[j].x * v[j].x + v[j].y * v[j].y) + (v[j].z * v[j].z + v[j].w * v[j].w);
        const float rstd = 1.0f / sqrtf(wave_sum(s) * (1.f / D) + EPS);
#pragma unroll
        for (int j = 0; j < 4; ++j) xr[64 * j] = v[j] * rstd * gg[j];
    }
}

__global__ void __launch_bounds__(512, 2) mk_fwd(Args args) {
    extern __shared__ __attribute__((aligned(16))) unsigned char lds_raw[];
    cg::grid_group grid = cg::this_grid();
    Ctx F;
    F.lds = (LAS unsigned char*)lds_raw;
    F.tid = threadIdx.x; F.lane = F.tid & 63; F.wave = __builtin_amdgcn_readfirstlane(F.tid >> 6); F.G = gridDim.x; F.bid = blockIdx.x;
    F.x = args.in[0]; F.norm1_g = args.in[1]; F.w_in = args.in[2]; F.ln_g = args.in[3]; F.ln_b = args.in[4]; F.w_sp = args.in[5]; F.b_sp = args.in[6];
    F.w_fo = args.in[7]; F.w_so = args.in[8]; F.w_out = args.in[9]; F.norm2_g = args.in[10]; F.w_router = args.in[11]; F.w_gate = args.in[12]; F.w_up = args.in[13];
    F.w_down = args.in[14]; F.final_g = args.in[15]; F.out = args.out; F.ws = args.ws;
    const unsigned pm_ = args.ph_mask;
    unsigned char* ws = args.ws;
    if (F.tid < 2) ((LAS unsigned*)(F.lds + LDS_MISC))[F.tid] = 0u;
    __syncthreads();
    const XcdBarrier xbar = xcd_barrier_post((unsigned*)(ws + WS_CTL), (volatile LAS unsigned*)(F.lds + LDS_MISC));
#ifndef PH_CT_MASK
#define PH_CT_MASK 0xffffu
#endif
#define RUN(k) ((((PH_CT_MASK) >> (k)) & 1u) && ((pm_ >> (k)) & 1u))
#define SEAM(k) do { if ((pm_ & ((2u << (k)) - 1u)) && (pm_ >> ((k) + 1))) { if ((k) == 3) grid.sync(); else xcd_barrier(xbar); } } while (0)
    if (RUN(0) | RUN(1) | RUN(2) | RUN(3)) p0_prep(F, (int)(pm_ & 15u));
    SEAM(3);
    if (RUN(4)) {
        Sched1 S{(const char*)(ws + WS_HN), (const char*)(ws + WS_WIN), F.G, F.bid}; Epi1 E{ws};
        pg8::gemm_phase<Epi1, Sched1, false>(F.lds, D, S, E);
    }
    SEAM(4);
    if (RUN(5)) p2_sgu(F);
    if (RUN(6)) fft_stage<0>(F);
    SEAM(6);
    if (RUN(7)) fft_stage<1>(F);
    SEAM(7);
    if (RUN(8)) {
        Sched3 S{(const char*)(ws + WS_FM), (const char*)(ws + WS_SG), (const char*)(ws + WS_WFO), (const char*)(ws + WS_WSO), F.G, F.bid};
        Epi3 E{(const bf16_t*)(ws + WS_SGF), (const bf16_t*)(ws + WS_SGS), (bf16_t*)(ws + WS_MRG)};
        pg8::gemm_phase<Epi3, Sched3, false>(F.lds, 512, S, E);
    }
    SEAM(8);
    if (RUN(9)) {
        Sched4 S{(const char*)(ws + WS_MRG), (const char*)(ws + WS_WOUT), F.G, F.bid}; Epi4 E{F.x, F.out};
        pg8::gemm_phase<Epi4, Sched4, false>(F.lds, D, S, E);
    }
    SEAM(9);
    if (RUN(10) | RUN(11)) p5_rows(F, (int)((pm_ >> 10) & 3u));
    SEAM(11);
    if (RUN(12)) p6_topk(F);
    SEAM(12);
    if (RUN(13)) {
        Sched7 S{(const char*)(ws + WS_H2), (const char*)(ws + WS_RA), (const int*)(ws + WS_IDX), F.G, F.bid}; Epi7 E{(unsigned char*)(ws + WS_H)};
        pg8::gemm_phase<Epi7, Sched7, true, true>(F.lds, D / 2, S, E);
    }
    SEAM(13);
    if (RUN(14)) {
        Sched8 S{(const char*)(ws + WS_H), (const char*)(ws + WS_WD), F.G, F.bid}; Epi8 E{(bf16_t*)(ws + WS_RA), (const float*)(ws + WS_GATE)};
        pg8::gemm_phase<Epi8, Sched8, false, true>(F.lds, DFF / 2, S, E);
    }
    SEAM(14);
    if (RUN(15)) p9_final(F);
#undef RUN
#undef SEAM
}

extern "C" void kernel_launch(void* const* d_in, const int* in_sizes, int n_in, void* d_out, int out_size, void* d_ws, size_t ws_size, hipStream_t stream) {
    static int grid = 0;
    if (grid == 0) {
        if (n_in != 16 || out_size != MTOK * D || ws_size < WS_END) { fprintf(stderr, "kernel_launch: unexpected shapes (n_in %d, out %d, ws %zu < %zu)\n", n_in, out_size, ws_size, (size_t)WS_END); grid = -1; return; }
        int dev = 0, cus = 0, per_cu = 0;
        if (hipGetDevice(&dev) != hipSuccess || hipDeviceGetAttribute(&cus, hipDeviceAttributeMultiprocessorCount, dev) != hipSuccess) { grid = -1; return; }
        if (hipFuncSetAttribute((const void*)mk_fwd, hipFuncAttributeMaxDynamicSharedMemorySize, LDS_BYTES) != hipSuccess) { fprintf(stderr, "kernel_launch: hipFuncSetAttribute failed\n"); grid = -1; return; }
        if (hipOccupancyMaxActiveBlocksPerMultiprocessor(&per_cu, (const void*)mk_fwd, 512, LDS_BYTES) != hipSuccess || per_cu < 1) { fprintf(stderr, "kernel_launch: occupancy query failed (%d)\n", per_cu); grid = -1; return; }
        if (per_cu > 1) per_cu = 1;
        grid = cus * per_cu;
        if (grid != 256) fprintf(stderr, "kernel_launch: note: grid %d (tile orders are tuned for 256)\n", grid);
    }
    if (grid < 0) return;
    if (hipMemsetAsync((char*)d_ws + WS_CTL, 0, CTL_BYTES, stream) != hipSuccess) { fprintf(stderr, "kernel_launch: hipMemsetAsync failed\n"); return; }
    Args a{};
    for (int i = 0; i < 16; ++i) a.in[i] = (const float*)d_in[i];
    a.out = (float*)d_out; a.ws = (unsigned char*)d_ws;
#if MK_N_LAUNCHES == 1
    a.ph_mask = 0xffffu;
    void* kargs[] = {&a};
    hipError_t e = hipLaunchCooperativeKernel((const void*)mk_fwd, dim3(grid), dim3(512), kargs, LDS_BYTES, stream);
    if (e != hipSuccess) fprintf(stderr, "kernel_launch: cooperative launch failed: %s (grid %d)\n", hipGetErrorString(e), grid);
#else
#ifndef PROBE_DUP
#define PROBE_DUP 0
#endif
    for (int p = 0; p < 16; ++p) {
        const int reps = ((PROBE_DUP >> p) & 1) ? 2 : 1;
        for (int r = 0; r < reps; ++r) { a.ph_mask = 1u << p; hipLaunchKernelGGL(mk_fwd, dim3(grid), dim3(512), LDS_BYTES, stream, a); }
    }
#endif
}
```

```cpp
#include <hip/hip_runtime.h>
#include <hip/hip_cooperative_groups.h>
#include <cstdio>
#include <cstdint>
namespace cg = cooperative_groups;

#ifndef MK_N_LAUNCHES
#define MK_N_LAUNCHES 1
#endif

#define LAS __attribute__((address_space(3)))
typedef unsigned short bf16_t;
typedef short bf16x8 __attribute__((ext_vector_type(8)));
typedef float f32x4 __attribute__((ext_vector_type(4)));
typedef float f32x2 __attribute__((ext_vector_type(2)));
typedef unsigned u32x4 __attribute__((ext_vector_type(4)));
typedef unsigned u32x2 __attribute__((ext_vector_type(2)));
typedef int i32x4 __attribute__((ext_vector_type(4)));
typedef int i32x8 __attribute__((ext_vector_type(8)));

constexpr int D = 1024, NB = 8, SEQ = 4096, MTOK = NB * SEQ;
constexpr int FW = 512, SWD = 512, NE = 16, CAP = 512, DFF = 2048;
constexpr int N1 = 4096;
constexpr int INW = 3584;
constexpr float EPS = 1e-6f;

constexpr size_t MiB = 1u << 20;
constexpr size_t WS_RA = 0;
constexpr size_t WS_WD = 128 * MiB;
constexpr size_t WS_RH = 192 * MiB;
constexpr size_t WS_YF = WS_RH;
constexpr size_t WS_GU = WS_RH + 64 * MiB;
constexpr size_t WS_GV = WS_RH + 96 * MiB;
constexpr size_t WS_SGF = WS_RH + 128 * MiB;
constexpr size_t WS_SGS = WS_RH + 192 * MiB;
constexpr size_t WS_FM = WS_GU;
constexpr size_t WS_MRG = WS_RH;
constexpr size_t WS_H = WS_RH + 128 * MiB;
constexpr size_t WS_DLT = WS_RH + 64 * MiB;
constexpr size_t WS_RS = 448 * MiB;
constexpr size_t WS_HN = WS_RS;
constexpr size_t WS_AP = WS_RS;
constexpr size_t WS_SG = WS_RA;
constexpr size_t WS_H2 = WS_RS;
constexpr size_t WS_WIN = 512 * MiB;
constexpr size_t WS_WFO = 520 * MiB;
constexpr size_t WS_WSO = 521 * MiB;
constexpr size_t WS_WOUT = 522 * MiB;
constexpr size_t WS_AFF = 524 * MiB;
constexpr size_t WS_INV = 526 * MiB;
constexpr size_t WS_IDX = 527 * MiB;
constexpr size_t WS_GATE = WS_IDX + 256 * 1024;
constexpr size_t WS_MA = WS_IDX + 512 * 1024;
constexpr size_t WS_MB = WS_MA + 32 * 1024;
constexpr size_t WS_RSTD = WS_IDX + 832 * 1024;
constexpr size_t WS_CTL = WS_IDX + 768 * 1024;
constexpr size_t CTL_BYTES = 16384;
constexpr size_t WS_END = 528 * MiB;

constexpr int LDS_STAGE = 131072;
constexpr int LDS_X_OFF = LDS_STAGE;
constexpr int LDS_BYTES = 155648;
constexpr int LDS_MISC = LDS_BYTES - 64;

__device__ __forceinline__ unsigned f2bf(float f) { unsigned u = __builtin_bit_cast(unsigned, f); return (u + 0x7fffu + ((u >> 16) & 1u)) >> 16; }
__device__ __forceinline__ unsigned pk2(float lo, float hi) { return f2bf(lo) | (f2bf(hi) << 16); }
__device__ __forceinline__ unsigned cvt_pk_bf16(float lo, float hi) { unsigned r; asm volatile("v_cvt_pk_bf16_f32 %0, %1, %2" : "=v"(r) : "v"(lo), "v"(hi)); return r; }
__device__ __forceinline__ float bf_lo(unsigned w) { return __builtin_bit_cast(float, w << 16); }
__device__ __forceinline__ float bf_hi(unsigned w) { return __builtin_bit_cast(float, w & 0xffff0000u); }
__device__ __forceinline__ float wave_sum(float v) {
#pragma unroll
    for (int o = 1; o < 64; o <<= 1) v += __shfl_xor(v, o);
    return v;
}
__device__ __forceinline__ float fast_sigmoid(float x) { return __builtin_amdgcn_rcpf(1.0f + __builtin_amdgcn_exp2f(-1.44269504089f * x)); }
__device__ __forceinline__ float gelu_tanh(float x) {
    const float u = 1.5957691216f * (x + 0.044715f * x * x * x);
    return x * fast_sigmoid(u);
}
#define LDS_WAIT() asm volatile("s_waitcnt lgkmcnt(0)" ::: "memory")
__device__ __forceinline__ unsigned pk4_fp8(float a, float b, float c, float d) {
    a = __builtin_amdgcn_fmed3f(a, -448.f, 448.f); b = __builtin_amdgcn_fmed3f(b, -448.f, 448.f); c = __builtin_amdgcn_fmed3f(c, -448.f, 448.f); d = __builtin_amdgcn_fmed3f(d, -448.f, 448.f);
    int r = 0; r = __builtin_amdgcn_cvt_pk_fp8_f32(a, b, r, false); r = __builtin_amdgcn_cvt_pk_fp8_f32(c, d, r, true); return (unsigned)r;
}
constexpr float W8_SCALE = 32.0f;
constexpr float H8_SCALE = 8.0f;
constexpr float Y8_SCALE = 64.0f;

namespace pg8 {
constexpr int BM = 256, BK = 64, HALF = 128, HTB = HALF * BK * 2, NXCD = 8, WGM = 8;
__device__ __forceinline__ int lds_byte(int r, int c) { const int st = (r >> 4) * 2 + (c >> 5), rr = r & 15, cc = c & 31, ob = rr * 64 + cc * 2; return st * 1024 + (ob ^ (((ob >> 9) & 1) << 5)); }
__device__ __forceinline__ void stage_rc(int b, int& R, int& C) { const int st = b / 1024, sb = b % 1024, swz = sb ^ (((sb >> 9) & 1) << 5); R = (st >> 1) * 16 + swz / 64; C = (st & 1) * 32 + (swz % 64) / 2; }
__device__ __forceinline__ int perm32(int rho) { const int n = rho >> 4, i = rho & 15; return 8 * (i >> 2) + 4 * n + (i & 3); }

struct Unit { const char* A; const char* B; const int* ridx; int pm, pn, kind; };

__device__ __forceinline__ bool static_tile(int nM, int nN, int G, int c, int i, int& pm, int& pn) {
    const int nwg = nM * nN; const long L = (long)i * G + c; if (L >= nwg) return false;
    int wgid = (int)L; { const int q = nwg / NXCD, r = nwg % NXCD, xcd = wgid % NXCD, off = wgid / NXCD; wgid = (xcd < r ? xcd * (q + 1) : r * (q + 1) + (xcd - r) * q) + off; }
    const int nig = WGM * nN, gid = wgid / nig, fm = gid * WGM, gsz = (nM - fm) < WGM ? (nM - fm) : WGM;
    pm = fm + ((wgid % nig) % gsz); pn = (wgid % nig) / gsz; return true;
}

template <class Epi, class Sched, bool GATHER, bool FP8 = false>
__device__ __forceinline__ void gemm_phase(LAS unsigned char* lds, const int K, const Sched& S, const Epi& E) {
    const int tid = threadIdx.x, wid = __builtin_amdgcn_readfirstlane(tid >> 6), lane = tid & 63, wr = wid >> 2, wc = wid & 3, fr = lane & 15, fq = lane >> 4;
    const int nt = K / BK;
    unsigned voffA[2], voffB[2]; int RA[2], CA2[2];
#pragma unroll
    for (int i = 0; i < 2; ++i) { int R, C; stage_rc(tid * 16 + i * 8192, R, C); const int Rb = Epi::PERM ? ((R & ~31) + perm32(R & 31)) : R;
        voffA[i] = (unsigned)(R * K + C) * 2u; voffB[i] = (unsigned)(Rb * K + C) * 2u; RA[i] = R; CA2[i] = C * 2; }
    const size_t kstep = (size_t)(BK * 2);
    const size_t hstep = (size_t)HALF * K * 2;
    const unsigned ldsw = (unsigned)wid * 1024u;
    const int aoff = lds_byte(wr * 64 + fr, fq * 8), boff = lds_byte(wc * 32 + fr, fq * 8);
#define PG8_SA(b, h) (((b) * 2 + (h)) * HTB)
#define PG8_SB(b, h) ((4 + (b) * 2 + (h)) * HTB)
#define PG8_GLDS(bufoff, gptr, _i) __builtin_amdgcn_global_load_lds((const unsigned*)(gptr), (LAS unsigned*)(lds + (bufoff) + ldsw + (_i) * 8192), 16, 0, 0)
#define PG8_STAGE_B(bufoff, gbase) do { _Pragma("unroll") for (int _i = 0; _i < 2; ++_i) PG8_GLDS(bufoff, (const char*)(gbase) + voffB[_i], _i); } while (0)
#define PG8_STAGE_A(bufoff, gbase, h, go) do { _Pragma("unroll") for (int _i = 0; _i < 2; ++_i) { \
        if constexpr (GATHER) PG8_GLDS(bufoff, (const char*)(gbase) + go[h][_i], _i); else PG8_GLDS(bufoff, (const char*)(gbase) + (h) * hstep + voffA[_i], _i); } } while (0)
#define PG8_LD2(d2, d8, base) do { const LAS i32x4* p_ = (const LAS i32x4*)(base); const i32x4 lo_ = p_[0], hi_ = p_[64]; \
        if constexpr (FP8) d8 = __builtin_shufflevector(lo_, hi_, 0, 1, 2, 3, 4, 5, 6, 7); else { d2[0] = __builtin_bit_cast(bf16x8, lo_); d2[1] = __builtin_bit_cast(bf16x8, hi_); } } while (0)
#define PG8_LDA(dst, b, h) do { _Pragma("unroll") for (int m = 0; m < 4; ++m) PG8_LD2(dst[m], dst##8[m], lds + PG8_SA(b, h) + aoff + m * 2048); } while (0)
#define PG8_LDB(dst, b, h) do { _Pragma("unroll") for (int n = 0; n < 2; ++n) PG8_LD2(dst[n], dst##8[n], lds + PG8_SB(b, h) + boff + n * 2048); } while (0)
#define PG8_MMA(ai, bj, At, Bt) do { __builtin_amdgcn_s_setprio(1); _Pragma("unroll") for (int m = 0; m < 4; ++m) _Pragma("unroll") for (int n = 0; n < 2; ++n) { \
        if constexpr (FP8) asm volatile("v_mfma_f32_16x16x128_f8f6f4 %0, %1, %2, %0" : "+v"(acc[ai][bj][m][n]) : "v"(Bt##8[n]), "v"(At##8[m])); \
        else { _Pragma("unroll") for (int k = 0; k < 2; ++k) acc[ai][bj][m][n] = __builtin_amdgcn_mfma_f32_16x16x32_bf16(Bt[n][k], At[m][k], acc[ai][bj][m][n], 0, 0, 0); } } \
        __builtin_amdgcn_s_setprio(0); } while (0)
#define PG8_WAIT_V(n) asm volatile("s_waitcnt vmcnt(" #n ")" ::: "memory")
#define PG8_WAIT_L(n) asm volatile("s_waitcnt lgkmcnt(" #n ")" ::: "memory")
#define PG8_BAR __builtin_amdgcn_s_barrier()
#define PG8_SCHED __builtin_amdgcn_sched_barrier(0)
#define PG8_GOFS(dst, u) do { if constexpr (GATHER) { _Pragma("unroll") for (int _h = 0; _h < 2; ++_h) _Pragma("unroll") for (int _i = 0; _i < 2; ++_i) \
        dst[_h][_i] = (unsigned)(u).ridx[_h * HALF + RA[_i]] * (unsigned)(K * 2) + (unsigned)CA2[_i]; } } while (0)
    Unit cur, nxt; int ui = 0;
    if (!S.next(0, cur)) return;
    f32x4 acc[2][2][4][2];
#pragma unroll
    for (int a = 0; a < 2; ++a)
#pragma unroll
        for (int b = 0; b < 2; ++b)
#pragma unroll
            for (int m = 0; m < 4; ++m)
#pragma unroll
                for (int n = 0; n < 2; ++n) acc[a][b][m][n] = (f32x4){0.f, 0.f, 0.f, 0.f};
    bf16x8 At[4][2], B0[2][2], B1[2][2]; i32x8 At8[4], B08[2], B18[2];
    unsigned gA[2][2] = {{0u, 0u}, {0u, 0u}}, gN[2][2] = {{0u, 0u}, {0u, 0u}};
    PG8_GOFS(gA, cur);
    const char* cA = cur.A; const char* cB = cur.B;
    PG8_STAGE_B(PG8_SB(0, 0), cB); PG8_STAGE_B(PG8_SB(0, 1), cB + hstep); PG8_STAGE_A(PG8_SA(0, 0), cA, 0, gA); PG8_STAGE_A(PG8_SA(0, 1), cA, 1, gA);
    if (wr == 1) PG8_BAR;
    PG8_WAIT_V(2); PG8_BAR;
    PG8_STAGE_B(PG8_SB(1, 0), cB + kstep); PG8_STAGE_A(PG8_SA(1, 0), cA + kstep, 0, gA); PG8_STAGE_B(PG8_SB(1, 1), cB + hstep + kstep);
    PG8_WAIT_V(6); PG8_BAR;
    for (;;) {
        const bool has_next = S.next(ui + 1, nxt);
        if (!has_next) nxt = cur;
        PG8_GOFS(gN, nxt);
        const char* nA = nxt.A; const char* nB = nxt.B;
#pragma clang loop unroll(disable)
        for (int t = 0; t < nt; t += 2) {
            const bool last = (t == nt - 2);
            const char* a1 = cA + (size_t)(t + 1) * kstep;
            const char* a2 = last ? nA : cA + (size_t)(t + 2) * kstep; const char* b2 = last ? nB : cB + (size_t)(t + 2) * kstep;
            const char* a3 = a2 + kstep; const char* b3 = b2 + kstep;
            unsigned g2[2][2];
#pragma unroll
            for (int _h = 0; _h < 2; ++_h)
#pragma unroll
                for (int _i = 0; _i < 2; ++_i) g2[_h][_i] = last ? gN[_h][_i] : gA[_h][_i];
            PG8_LDB(B0, 0, 0); PG8_LDB(B1, 0, 1); PG8_SCHED; PG8_LDA(At, 0, 0); PG8_STAGE_A(PG8_SA(1, 1), a1, 1, gA);
            PG8_WAIT_V(8); PG8_WAIT_L(0); PG8_BAR; PG8_MMA(0, 0, At, B0); PG8_MMA(0, 1, At, B1); PG8_BAR; PG8_SCHED;
            PG8_LDA(At, 0, 1); PG8_STAGE_B(PG8_SB(0, 0), b2); PG8_STAGE_B(PG8_SB(0, 1), b2 + hstep); PG8_STAGE_A(PG8_SA(0, 0), a2, 0, g2);
            PG8_WAIT_V(8); PG8_WAIT_L(0); PG8_BAR; PG8_MMA(1, 0, At, B0); PG8_MMA(1, 1, At, B1); PG8_BAR; PG8_SCHED;
            PG8_LDB(B0, 1, 0); PG8_LDB(B1, 1, 1); PG8_SCHED; PG8_LDA(At, 1, 0); PG8_STAGE_A(PG8_SA(0, 1), a2, 1, g2);
            PG8_WAIT_V(8); PG8_WAIT_L(0); PG8_BAR; PG8_MMA(0, 0, At, B0); PG8_MMA(0, 1, At, B1); PG8_BAR; PG8_SCHED;
            PG8_LDA(At, 1, 1); PG8_STAGE_B(PG8_SB(1, 0), b3); PG8_STAGE_B(PG8_SB(1, 1), b3 + hstep); PG8_STAGE_A(PG8_SA(1, 0), a3, 0, g2);
            PG8_WAIT_V(8); PG8_WAIT_L(0); PG8_BAR; PG8_MMA(1, 0, At, B0); PG8_MMA(1, 1, At, B1); PG8_BAR; PG8_SCHED;
        }
        if (wr == 0) PG8_BAR;
        if constexpr (FP8) asm volatile("s_nop 15\n\ts_nop 15" ::: "memory");
        const bool keep = E(acc, cur, wr, wc, fr, fq);
        if (!has_next) break;
        if (!keep) {
#pragma unroll
            for (int a = 0; a < 2; ++a)
#pragma unroll
                for (int b = 0; b < 2; ++b)
#pragma unroll
                    for (int m = 0; m < 4; ++m)
#pragma unroll
                        for (int n = 0; n < 2; ++n) acc[a][b][m][n] = (f32x4){0.f, 0.f, 0.f, 0.f};
        }
        cur = nxt; cA = nA; cB = nB; ++ui;
#pragma unroll
        for (int _h = 0; _h < 2; ++_h)
#pragma unroll
            for (int _i = 0; _i < 2; ++_i) gA[_h][_i] = gN[_h][_i];
        if (wr == 1) PG8_BAR;
    }
    PG8_WAIT_V(0);
    PG8_BAR;
#undef PG8_SA
#undef PG8_SB
#undef PG8_GLDS
#undef PG8_STAGE_A
#undef PG8_STAGE_B
#undef PG8_LDA
#undef PG8_LDB
#undef PG8_MMA
#undef PG8_LD2
#undef PG8_WAIT_V
#undef PG8_WAIT_L
#undef PG8_BAR
#undef PG8_SCHED
#undef PG8_GOFS
}
}
using pg8::Unit;

#define XB_TMO      128
#define XB_XCNT(j)  (256  + 64 * (j))
#define XB_XSUB(j)  (1280 + 64 * (j))
#define XB_XGEN(j)  (2304 + 64 * (j))
#define XB_TOP      3328
#define XB_TOPGEN   3392
#define XB_SPIN_CAP (1u << 22)
__device__ __forceinline__ unsigned xb_ld(unsigned* p)              { return __hip_atomic_load(p, __ATOMIC_RELAXED, __HIP_MEMORY_SCOPE_AGENT); }
__device__ __forceinline__ unsigned xb_add(unsigned* p, unsigned v) { return __hip_atomic_fetch_add(p, v, __ATOMIC_RELAXED, __HIP_MEMORY_SCOPE_AGENT); }
__device__ __forceinline__ unsigned xb_xcc_id() { return (unsigned)__builtin_amdgcn_s_getreg((3 << 11) | 20) & 0xFu; }
#define XB_SPIN(cond, bar) do { unsigned _sp = 0; while (cond) { __builtin_amdgcn_s_sleep(1); \
    if ((++_sp & 255u) == 0u) { if (xb_ld(&(bar)[XB_TMO])) break; if (_sp > XB_SPIN_CAP) { atomicAdd(&(bar)[XB_TMO], 1u); break; } } } } while (0)
struct XcdBarrier { unsigned* bar; unsigned x; volatile LAS unsigned* st; };
__device__ __forceinline__ XcdBarrier xcd_barrier_post(unsigned* bar, volatile LAS unsigned* st) {
    XcdBarrier b; b.bar = bar; b.x = xb_xcc_id(); b.st = st;
    if (threadIdx.x == 0) (void)xb_add(&bar[XB_XCNT(b.x)], 1u);
    return b;
}
__device__ __forceinline__ void xcd_barrier_complete(unsigned* bar, unsigned x, unsigned& nloc, unsigned& nx) {
    const unsigned G = gridDim.x * gridDim.y * gridDim.z;
    unsigned sum, cnt, mine, sp = 0u;
    for (;;) {
        sum = 0u; cnt = 0u; mine = 0u;
#pragma unroll
        for (unsigned j = 0; j < 16; ++j) { const unsigned c = xb_ld(&bar[XB_XCNT(j)]); sum += c; cnt += (c > 0u) ? 1u : 0u; mine = (j == x) ? c : mine; }
        if (sum == G) break;
        __builtin_amdgcn_s_sleep(1);
        if ((++sp & 255u) == 0u) { if (xb_ld(&bar[XB_TMO])) break; if (sp > XB_SPIN_CAP) { atomicAdd(&bar[XB_TMO], 1u); break; } }
    }
    nloc = mine > 0u ? mine : 1u; nx = cnt > 0u ? cnt : 1u;
}
__device__ __forceinline__ void xcd_barrier(const XcdBarrier& b) {
    asm volatile("s_waitcnt vmcnt(0)" ::: "memory");
    __syncthreads();
    if (threadIdx.x == 0) {
        unsigned* bar = b.bar;
        __builtin_amdgcn_s_waitcnt(0);
        unsigned nloc = b.st[0], nx = b.st[1];
        if (nloc == 0u) { xcd_barrier_complete(bar, b.x, nloc, nx); b.st[0] = nloc; b.st[1] = nx; }
        const unsigned old = xb_add(&bar[XB_XSUB(b.x)], 1u);
        const unsigned gen = old / nloc;
        if (old + 1u == (gen + 1u) * nloc) {
            __builtin_amdgcn_fence(__ATOMIC_RELEASE, "agent");
            asm volatile("s_waitcnt vmcnt(0)" ::: "memory");
            const unsigned og = xb_add(&bar[XB_TOP], 1u);
            const unsigned tg = og / nx;
            if (og + 1u == (tg + 1u) * nx) xb_add(&bar[XB_TOPGEN], 1u);
            else XB_SPIN(xb_ld(&bar[XB_TOPGEN]) == tg, bar);
            __builtin_amdgcn_fence(__ATOMIC_ACQUIRE, "agent");
            xb_add(&bar[XB_XGEN(b.x)], 1u);
            asm volatile("s_waitcnt vmcnt(0)" ::: "memory");
        } else {
            XB_SPIN(xb_ld(&bar[XB_XGEN(b.x)]) == gen, bar);
            __builtin_amdgcn_fence(__ATOMIC_ACQUIRE, "agent");
            asm volatile("s_waitcnt vmcnt(0)" ::: "memory");
        }
    }
    __syncthreads();
}

struct Args {
    const float* in[16];
    float* out;
    unsigned char* ws;
    unsigned ph_mask, pad;
};

struct Ctx {
    LAS unsigned char* lds;
    int tid, lane, wave, G, bid;
    const float *x, *norm1_g, *w_in, *ln_g, *ln_b, *w_sp, *b_sp, *w_fo, *w_so, *w_out, *norm2_g, *w_router, *w_gate, *w_up, *w_down, *final_g;
    float* out;
    unsigned char* ws;
};

__device__ __forceinline__ void transpose_item(const float* W, int N, int k0, int n0, bf16_t* WT, size_t dst_row0, int Kd, LAS float* scr, int lane) {
    const float* src = W + (size_t)(k0 + (lane >> 4)) * N + n0;
#pragma unroll
    for (int i = 0; i < 16; ++i) {
        const int n4 = (lane & 15) ^ ((i >> 1) & 7);
        __builtin_amdgcn_global_load_lds((const unsigned*)(src + (size_t)(4 * i) * N + 4 * n4), (LAS unsigned*)(scr + i * 256), 16, 0, 0);
    }
    asm volatile("s_waitcnt vmcnt(0)" ::: "memory");
    const int hh = lane >> 5, c = (lane >> 2) & 7, sub = lane & 3;
#pragma unroll
    for (int j = 0; j < 8; ++j) {
        const int n4 = 2 * j + hh;
        const LAS float* p = scr + (16 * (8 * c) + (n4 ^ c)) * 4 + sub;
        float v[8];
#pragma unroll
        for (int i = 0; i < 8; ++i) v[i] = p[i * 64];
        u32x4 o; o.x = pk2(v[0], v[1]); o.y = pk2(v[2], v[3]); o.z = pk2(v[4], v[5]); o.w = pk2(v[6], v[7]);
        *(u32x4*)(WT + (dst_row0 + 4 * n4 + sub) * (size_t)Kd + k0 + 8 * c) = o;
    }
    LDS_WAIT(); asm volatile("" ::: "memory");
}

__device__ __forceinline__ void transpose_item8(const float* W, int N, int k0, int n0, unsigned char* WT8, size_t dst_row0, int Kd, LAS float* scr, int lane) {
    const float* src = W + (size_t)(k0 + (lane >> 4)) * N + n0;
#pragma unroll
    for (int i = 0; i < 16; ++i) {
        const int n4 = (lane & 15) ^ ((i >> 1) & 7);
        __builtin_amdgcn_global_load_lds((const unsigned*)(src + (size_t)(4 * i) * N + 4 * n4), (LAS unsigned*)(scr + i * 256), 16, 0, 0);
    }
    asm volatile("s_waitcnt vmcnt(0)" ::: "memory");
    const int hh = lane >> 5, c = (lane >> 2) & 7, sub = lane & 3;
#pragma unroll
    for (int j = 0; j < 8; ++j) {
        const int n4 = 2 * j + hh;
        const LAS float* p = scr + (16 * (8 * c) + (n4 ^ c)) * 4 + sub;
        float v[8];
#pragma unroll
        for (int i = 0; i < 8; ++i) v[i] = p[i * 64] * W8_SCALE;
        u32x2 o; o.x = pk4_fp8(v[0], v[1], v[2], v[3]); o.y = pk4_fp8(v[4], v[5], v[6], v[7]);
        *(u32x2*)(WT8 + (dst_row0 + 4 * n4 + sub) * (size_t)Kd + k0 + 8 * c) = o;
    }
    LDS_WAIT(); asm volatile("" ::: "memory");
}

__device__ __forceinline__ void rms_rows4_to_bf16(const float* x0, const f32x4 (&gg)[4], bf16_t* o0, int lane) {
    f32x4 v[4][4];
#pragma unroll
    for (int r = 0; r < 4; ++r)
#pragma unroll
        for (int j = 0; j < 4; ++j) v[r][j] = ((const f32x4*)(x0 + (size_t)r * D))[64 * j + lane];
#pragma unroll
    for (int r = 0; r < 4; ++r) {
        float s = 0.f;
#pragma unroll
        for (int j = 0; j < 4; ++j) s += (v[r][j].x * v[r][j].x + v[r][j].y * v[r][j].y) + (v[r][j].z * v[r][j].z + v[r][j].w * v[r][j].w);
        const float rstd = 1.0f / sqrtf(wave_sum(s) * (1.f / D) + EPS);
        u32x2* o8 = (u32x2*)(o0 + (size_t)r * D) + lane;
#pragma unroll
        for (int j = 0; j < 4; ++j) { u32x2 w; w.x = pk2(v[r][j].x * rstd * gg[j].x, v[r][j].y * rstd * gg[j].y); w.y = pk2(v[r][j].z * rstd * gg[j].z, v[r][j].w * rstd * gg[j].w); o8[64 * j] = w; }
    }
}

__device__ __forceinline__ void p0_prep(const Ctx& F, const int parts) {
    LAS float* scr = (LAS float*)(F.lds + F.wave * 16384);
    LAS float* tab128 = (LAS float*)(F.lds + LDS_X_OFF);
    if (F.tid < 128) tab128[F.tid] = cospif((float)F.tid * (1.0f / 64.0f));
    __syncthreads();
    const int gw = F.bid * 8 + F.wave, NGW = F.G * 8;
    bf16_t* WinT = (bf16_t*)(F.ws + WS_WIN);
    if (parts & 1) {
        constexpr int I1 = 16 * 48, I2 = 8 * 16, I3 = 8 * 16, I4 = 16 * 16, I5 = 16 * 32 * 16;
        constexpr int NIT = I1 + I2 + I3 + I4 + I5;
        for (int it = gw; it < NIT; it += NGW) {
            int r = it;
            if (r < I1) { const int kb = r / 48, nb = r % 48; transpose_item(F.w_in, INW, 64 * kb, 512 + 64 * nb, WinT, (size_t)(1024 + 64 * nb), D, scr, F.lane); continue; } r -= I1;
            if (r < I2) { const int kb = r / 16, nb = r % 16; transpose_item(F.w_fo, D, 64 * kb, 64 * nb, (bf16_t*)(F.ws + WS_WFO), (size_t)(64 * nb), FW, scr, F.lane); continue; } r -= I2;
            if (r < I3) { const int kb = r / 16, nb = r % 16; transpose_item(F.w_so, D, 64 * kb, 64 * nb, (bf16_t*)(F.ws + WS_WSO), (size_t)(64 * nb), SWD, scr, F.lane); continue; } r -= I3;
            if (r < I4) { const int kb = r / 16, nb = r % 16; transpose_item(F.w_out, D, 64 * kb, 64 * nb, (bf16_t*)(F.ws + WS_WOUT), (size_t)(64 * nb), D, scr, F.lane); continue; } r -= I4;
            { const int e = r >> 9, q = r & 511, kb = q >> 4, nb = q & 15;
              transpose_item8(F.w_down + (size_t)e * DFF * D, D, 64 * kb, 64 * nb, (unsigned char*)(F.ws + WS_WD) + (size_t)e * D * DFF, (size_t)(64 * nb), DFF, scr, F.lane); }
        }
    }
    if (parts & 2) {
        const float sc = 0.08838834764831845f;
        for (int it = gw; it < 4096; it += NGW) {
            const int g = it >> 10, dt = (it >> 4) & 63, jt = it & 15;
            const int d0 = dt * 16, j0 = jt * 16, kk = F.lane >> 4;
            const int jj = (j0 + (F.lane & 15)) & 127; const int shift = (j0 >= 128) ? 96 : 0;
            const float* ap = F.w_in + (size_t)(d0 + (F.lane & 15)) * INW + g * 128 + 4 * kk;
            f32x4 av[8];
#pragma unroll
            for (int q = 0; q < 8; ++q) av[q] = *(const f32x4*)(ap + 16 * q);
            f32x4 acc = (f32x4){0.f, 0.f, 0.f, 0.f};
#pragma unroll
            for (int q = 0; q < 8; ++q)
#pragma unroll
                for (int t = 0; t < 4; ++t) {
                    const int c = 16 * q + 4 * kk + t;
                    const float b = tab128[(jj * c + shift) & 127] * sc;
                    acc = __builtin_amdgcn_mfma_f32_16x16x4f32(av[q][t], b, acc, 0, 0, 0);
                }
            u32x2 w; w.x = pk2(acc[0], acc[1]); w.y = pk2(acc[2], acc[3]);
            *(u32x2*)(WinT + (size_t)(g * 256 + j0 + (F.lane & 15)) * D + d0 + 4 * (F.lane >> 4)) = w;
        }
    }
    if (parts & 4) {
        bf16_t* HN = (bf16_t*)(F.ws + WS_HN);
        f32x4 gg[4];
#pragma unroll
        for (int j = 0; j < 4; ++j) gg[j] = ((const f32x4*)F.norm1_g)[64 * j + F.lane];
        for (int m4 = gw; m4 < MTOK / 4; m4 += NGW) rms_rows4_to_bf16(F.x + (size_t)m4 * 4 * D, gg, HN + (size_t)m4 * 4 * D, F.lane);
    }
    if (parts & 8) {
        bf16_t* MA = (bf16_t*)(F.ws + WS_MA); bf16_t* MB = (bf16_t*)(F.ws + WS_MB);
        const int gt = F.bid * 512 + F.tid, NT = F.G * 512;
        for (int q = gt; q < 128 * 128 + 64 * 128; q += NT) {
            if (q < 128 * 128) { const int o = q >> 7, k = q & 127, kl = o >> 1, ri = o & 1, sh = k >> 1, half = k & 1; const float a = (float)((kl * sh) & 63) * (1.0f / 32.0f);
                const float C = cospif(a), S = sinpif(a); const float v = (ri == 0) ? (half == 0 ? C : -S) : (half == 0 ? -S : -C); MA[q] = (bf16_t)f2bf(v * 0.125f); }
            else { const int qq = q - 128 * 128, kh = qq >> 7, k = qq & 127, sl = k >> 1, ri = k & 1; const float a = (float)((kh * sl) & 63) * (1.0f / 32.0f);
                MB[qq] = (bf16_t)f2bf((ri == 0 ? cospif(a) : sinpif(a)) * 0.125f); }
        }
    }
}

struct Sched1 {
    const char* A; const char* B; int G, c;
    __device__ __forceinline__ bool next(int i, Unit& u) const {
        int pm, pn; if (!pg8::static_tile(MTOK / 256, N1 / 256, G, c, i, pm, pn)) return false;
        u.A = A + (size_t)pm * 256 * D * 2; u.B = B + (size_t)pn * 256 * D * 2; u.ridx = nullptr; u.pm = pm; u.pn = pn; u.kind = 0; return true;
    }
};
struct Epi1 {
    static constexpr bool PERM = true;
    unsigned char* ws;
    __device__ __forceinline__ bool operator()(f32x4 (&acc)[2][2][4][2], const Unit& u, int wr, int wc, int fr, int fq) const {
        const int pn = u.pn;
        if (pn < 4) {
            bf16_t* Y = (bf16_t*)(ws + WS_YF);
            const int b = u.pm >> 4;
#pragma unroll
            for (int ai = 0; ai < 2; ++ai)
#pragma unroll
                for (int m = 0; m < 4; ++m) { const int s_lo = m * 16 + fr, s_hi = (u.pm & 15) * 4 + ai * 2 + wr;
                    bf16_t* rowp = Y + ((size_t)((b * 4 + pn) * 64 + s_lo) * 64 + s_hi) * 256 + wc * 32 + 8 * fq;
#pragma unroll
                    for (int bj = 0; bj < 2; ++bj) { const f32x4 v0 = acc[ai][bj][m][0], v1 = acc[ai][bj][m][1];
                        u32x4 w; w.x = cvt_pk_bf16(v0[0], v0[1]); w.y = cvt_pk_bf16(v0[2], v0[3]); w.z = cvt_pk_bf16(v1[0], v1[1]); w.w = cvt_pk_bf16(v1[2], v1[3]);
                        *(u32x4*)(rowp + bj * 128) = w; } }
            return false;
        }
        bf16_t* base; int ldc, colt; int act;
        if (pn < 6) { base = (bf16_t*)(ws + WS_GU); ldc = 512; colt = (pn - 4) * 256; act = 0; }
        else if (pn < 8) { base = (bf16_t*)(ws + WS_GV); ldc = 512; colt = (pn - 6) * 256; act = 0; }
        else if (pn < 12) { base = (bf16_t*)(ws + WS_SGF); ldc = 1024; colt = (pn - 8) * 256; act = 1; }
        else { base = (bf16_t*)(ws + WS_SGS); ldc = 1024; colt = (pn - 12) * 256; act = 1; }
        const int row0 = u.pm * 256 + wr * 64 + fr, col0 = colt + wc * 32 + 8 * fq;
#pragma unroll
        for (int ai = 0; ai < 2; ++ai)
#pragma unroll
            for (int m = 0; m < 4; ++m) { bf16_t* rowp = base + (size_t)(row0 + ai * 128 + m * 16) * ldc + col0;
#pragma unroll
                for (int bj = 0; bj < 2; ++bj) { f32x4 v0 = acc[ai][bj][m][0], v1 = acc[ai][bj][m][1];
                    if (act == 0) {
#pragma unroll
                        for (int j = 0; j < 4; ++j) { v0[j] = gelu_tanh(v0[j]); v1[j] = gelu_tanh(v1[j]); }
                    } else {
#pragma unroll
                        for (int j = 0; j < 4; ++j) { v0[j] = fast_sigmoid(v0[j]); v1[j] = fast_sigmoid(v1[j]); }
                    }
                    u32x4 w; w.x = cvt_pk_bf16(v0[0], v0[1]); w.y = cvt_pk_bf16(v0[2], v0[3]); w.z = cvt_pk_bf16(v1[0], v1[1]); w.w = cvt_pk_bf16(v1[2], v1[3]);
                    *(u32x4*)(rowp + bj * 128) = w; } }
        return false;
    }
};

__device__ __forceinline__ void p2_sgu(const Ctx& F) {
    constexpr int PITCH = 136;
    LAS bf16_t* Ws = (LAS bf16_t*)(F.lds);
    LAS bf16_t* Vt = (LAS bf16_t*)(F.lds + 128 * PITCH * 2);
    const bf16_t* GU = (const bf16_t*)(F.ws + WS_GU); const bf16_t* GV = (const bf16_t*)(F.ws + WS_GV); bf16_t* SG = (bf16_t*)(F.ws + WS_SG);
    const int lane = F.lane, wave = F.wave;
    int h_loaded = -1;
    for (int tt = F.bid; tt < 1024; tt += F.G) {
        const int h = tt & 3, bn = tt >> 2; const size_t r0 = (size_t)bn * 128;
        __syncthreads();
        if (h != h_loaded) {
            const float* wsrc = F.w_sp + (size_t)h * 128 * 128;
#pragma unroll
            for (int i = 0; i < 8; ++i) { const int idx = F.tid * 4 + i * 2048; const int p = idx >> 7, q = idx & 127; const f32x4 v = *(const f32x4*)(wsrc + idx);
                u32x2 w; w.x = pk2(v.x, v.y); w.y = pk2(v.z, v.w); *(LAS u32x2*)(Ws + p * PITCH + q) = w; }
            h_loaded = h;
        }
        { const int cp = lane & 15, rs4 = lane >> 4;
          f32x4 g0v = *(const f32x4*)(F.ln_g + h * 128 + 8 * cp), g1v = *(const f32x4*)(F.ln_g + h * 128 + 8 * cp + 4), b0v = *(const f32x4*)(F.ln_b + h * 128 + 8 * cp), b1v = *(const f32x4*)(F.ln_b + h * 128 + 8 * cp + 4);
          u32x4 raw[4];
#pragma unroll
          for (int i = 0; i < 4; ++i) raw[i] = *(const u32x4*)(GV + (r0 + wave * 16 + i * 4 + rs4) * 512 + h * 128 + 8 * cp);
#pragma unroll
          for (int i = 0; i < 4; ++i) { const int q = wave * 16 + i * 4 + rs4;
              float x[8] = {bf_lo(raw[i].x), bf_hi(raw[i].x), bf_lo(raw[i].y), bf_hi(raw[i].y), bf_lo(raw[i].z), bf_hi(raw[i].z), bf_lo(raw[i].w), bf_hi(raw[i].w)};
              float sm = ((x[0] + x[1]) + (x[2] + x[3])) + ((x[4] + x[5]) + (x[6] + x[7]));
#pragma unroll
              for (int o = 1; o < 16; o <<= 1) sm += __shfl_xor(sm, o);
              const float mu = sm * (1.0f / 128.0f); float sq = 0.f;
#pragma unroll
              for (int j = 0; j < 8; ++j) { x[j] -= mu; sq += x[j] * x[j]; }
#pragma unroll
              for (int o = 1; o < 16; o <<= 1) sq += __shfl_xor(sq, o);
              const float rs = 1.0f / sqrtf(sq * (1.0f / 128.0f) + EPS);
              const float gq[8] = {g0v.x, g0v.y, g0v.z, g0v.w, g1v.x, g1v.y, g1v.z, g1v.w}, bq[8] = {b0v.x, b0v.y, b0v.z, b0v.w, b1v.x, b1v.y, b1v.z, b1v.w};
#pragma unroll
              for (int j = 0; j < 8; ++j) Vt[(8 * cp + j) * PITCH + q] = (bf16_t)f2bf(x[j] * rs * gq[j] + bq[j]); } }
        __syncthreads();
        f32x4 acc[8];
#pragma unroll
        for (int ct = 0; ct < 8; ++ct) acc[ct] = (f32x4){0.f, 0.f, 0.f, 0.f};
#pragma unroll
        for (int ks = 0; ks < 4; ++ks) {
            const bf16x8 bw = *(const LAS bf16x8*)(Ws + (wave * 16 + (lane & 15)) * PITCH + ks * 32 + 8 * (lane >> 4));
#pragma unroll
            for (int ct = 0; ct < 8; ++ct) { const bf16x8 av = *(const LAS bf16x8*)(Vt + (ct * 16 + (lane & 15)) * PITCH + ks * 32 + 8 * (lane >> 4));
                acc[ct] = __builtin_amdgcn_mfma_f32_16x16x32_bf16(av, bw, acc[ct], 0, 0, 0); }
        }
        const int p = wave * 16 + (lane & 15); const float bs = F.b_sp[h * 128 + p];
        u32x2 uu[8];
#pragma unroll
        for (int ct = 0; ct < 8; ++ct) uu[ct] = *(const u32x2*)(GU + (r0 + p) * 512 + h * 128 + ct * 16 + 4 * (lane >> 4));
#pragma unroll
        for (int ct = 0; ct < 8; ++ct) { const size_t off = (r0 + p) * 512 + h * 128 + ct * 16 + 4 * (lane >> 4);
            u32x2 o; o.x = pk2(bf_lo(uu[ct].x) * (acc[ct][0] + bs), bf_hi(uu[ct].x) * (acc[ct][1] + bs)); o.y = pk2(bf_lo(uu[ct].y) * (acc[ct][2] + bs), bf_hi(uu[ct].y) * (acc[ct][3] + bs));
            *(u32x2*)(SG + off) = o; }
    }
    __syncthreads();
}

typedef short s16x4 __attribute__((ext_vector_type(4)));
template <int STAGE>
__device__ __forceinline__ void fft_stage(const Ctx& F) {
    constexpr int OPITCH = 272;
    LAS unsigned char* lds = F.lds;
    const int lane = F.lane, wave = F.wave, tid = F.tid;
    const int G = lane >> 4, q = (lane >> 2) & 3, p = lane & 3, fsw = q | ((G & 1) << 2);
    const bf16_t* MAT = (const bf16_t*)(F.ws + (STAGE == 0 ? WS_MA : WS_MB));
    const bf16_t* SRC = (const bf16_t*)(F.ws + (STAGE == 0 ? WS_YF : WS_AP));
    const int mt = (STAGE == 0) ? wave : (wave & 3);
    constexpr int NJT = (STAGE == 0) ? 8 : 4;
    const int jt0 = (STAGE == 0) ? 0 : 4 * (wave >> 2);
    bf16x8 afr[4];
#pragma unroll
    for (int ks = 0; ks < 4; ++ks) afr[ks] = *(const bf16x8*)(MAT + (size_t)(mt * 16 + (lane & 15)) * 128 + ks * 32 + 8 * G);
    unsigned soff[4];
#pragma unroll
    for (int i = 0; i < 4; ++i) { const int pos = i * 512 + tid, row = pos >> 4, cp = pos & 15; const int f = (row & 3) | (((row >> 3) & 1) << 2); soff[i] = (unsigned)(row * 256 + ((cp ^ (f << 1)) << 4)); }
    const unsigned rbase = (unsigned)((8 * G + q) * 256 + p * 8);
#define FFT_DMA(buf, t) do { const char* src_ = (const char*)SRC + (size_t)(t) * 32768; _Pragma("unroll") for (int i_ = 0; i_ < 4; ++i_) \
        __builtin_amdgcn_global_load_lds((const unsigned*)(src_ + soff[i_]), (LAS unsigned*)(lds + (buf) * 32768 + i_ * 8192 + wave * 1024), 16, 0, 0); } while (0)
    int t = F.bid, buf = 0;
    if (t < 2048) FFT_DMA(0, t);
    for (; t < 2048; t += F.G, buf ^= 1) {
        asm volatile("s_waitcnt vmcnt(0)" ::: "memory");
        __builtin_amdgcn_s_barrier();
        asm volatile("" ::: "memory");
        if (t + F.G < 2048) FFT_DMA(buf ^ 1, t + F.G);
        f32x4 acc[NJT];
#pragma unroll
        for (int jt = 0; jt < NJT; ++jt) acc[jt] = (f32x4){0.f, 0.f, 0.f, 0.f};
        const LAS unsigned char* xb = lds + buf * 32768 + rbase;
#pragma unroll
        for (int ks = 0; ks < 4; ++ks)
#pragma unroll
            for (int jt = 0; jt < NJT; ++jt) {
                const unsigned o = (unsigned)(ks * 32 * 256) + ((unsigned)(((jt0 + jt) ^ fsw)) << 5);
                const s16x4 lo = __builtin_amdgcn_ds_read_tr16_b64_v4i16((LAS s16x4*)(xb + o));
                const s16x4 hi = __builtin_amdgcn_ds_read_tr16_b64_v4i16((LAS s16x4*)(xb + o + 4 * 256));
                bf16x8 bfr; bfr[0] = lo[0]; bfr[1] = lo[1]; bfr[2] = lo[2]; bfr[3] = lo[3]; bfr[4] = hi[0]; bfr[5] = hi[1]; bfr[6] = hi[2]; bfr[7] = hi[3];
                acc[jt] = __builtin_amdgcn_mfma_f32_16x16x32_bf16(afr[ks], bfr, acc[jt], 0, 0, 0);
            }
        LAS unsigned char* ob = lds + 65536;
        if constexpr (STAGE == 0) {
            const int s_lo = t & 63, kl0 = 8 * wave + 2 * G;
            float c0, s0, c1, s1;
            sincospif((float)((kl0 * s_lo) & 4095) * (1.0f / 2048.0f), &s0, &c0);
            sincospif((float)(((kl0 + 1) * s_lo) & 4095) * (1.0f / 2048.0f), &s1, &c1);
#pragma unroll
            for (int jt = 0; jt < NJT; ++jt) { const f32x4 a = acc[jt]; const int col = 16 * jt + (lane & 15);
                LAS bf16_t* o0 = (LAS bf16_t*)(ob + (mt * 16 + 4 * G) * OPITCH) + col;
                o0[0 * (OPITCH / 2)] = (bf16_t)f2bf(a[0] * c0 + a[1] * s0); o0[1 * (OPITCH / 2)] = (bf16_t)f2bf(a[1] * c0 - a[0] * s0);
                o0[2 * (OPITCH / 2)] = (bf16_t)f2bf(a[2] * c1 + a[3] * s1); o0[3 * (OPITCH / 2)] = (bf16_t)f2bf(a[3] * c1 - a[2] * s1); }
        } else {
#pragma unroll
            for (int jt = 0; jt < NJT; ++jt) { const f32x4 a = acc[jt]; const int col = 16 * (jt0 + jt) + (lane & 15);
                LAS bf16_t* o0 = (LAS bf16_t*)(ob + (mt * 16 + 4 * G) * OPITCH) + col;
#pragma unroll
                for (int r = 0; r < 4; ++r) o0[r * (OPITCH / 2)] = (bf16_t)f2bf(a[r]); }
        }
        asm volatile("s_waitcnt lgkmcnt(0)" ::: "memory");
        __builtin_amdgcn_s_barrier();
        asm volatile("" ::: "memory");
        const int bg = t >> 6, lo6 = t & 63;
        if constexpr (STAGE == 0) {
            bf16_t* AP = (bf16_t*)(F.ws + WS_AP);
#pragma unroll
            for (int i = 0; i < 4; ++i) { const int id = tid + 512 * i, row = id >> 4, c = id & 15;
                const u32x4 v = *(const LAS u32x4*)(ob + row * OPITCH + c * 16);
                *(u32x4*)(AP + ((size_t)(bg * 64 + (row >> 1)) * 64 + lo6) * 256 + (row & 1) * 128 + c * 8) = v; }
        } else {
            bf16_t* FM = (bf16_t*)(F.ws + WS_FM);
#pragma unroll
            for (int i = 0; i < 2; ++i) { const int id = tid + 512 * i, row = id >> 4, c = id & 15;
                const u32x4 v = *(const LAS u32x4*)(ob + row * OPITCH + c * 16);
                *(u32x4*)(FM + ((size_t)(bg >> 2) * SEQ + lo6 + 64 * row) * FW + (bg & 3) * 128 + c * 8) = v; }
        }
    }
    asm volatile("s_waitcnt vmcnt(0) lgkmcnt(0)" ::: "memory");
    __builtin_amdgcn_s_barrier();
#undef FFT_DMA
}

struct Sched3 {
    const char* A0; const char* A1; const char* B0; const char* B1; int G, c;
    __device__ __forceinline__ bool next(int i, Unit& u) const {
        int pm, pn; if (!pg8::static_tile(MTOK / 256, D / 256, G, c, i >> 1, pm, pn)) return false;
        const int sub = i & 1;
        u.A = (sub ? A1 : A0) + (size_t)pm * 256 * 512 * 2; u.B = (sub ? B1 : B0) + (size_t)pn * 256 * 512 * 2; u.ridx = nullptr; u.pm = pm; u.pn = pn; u.kind = sub; return true;
    }
};
struct Epi3 {
    static constexpr bool PERM = true;
    const bf16_t* SGF; const bf16_t* SGS; bf16_t* MRG;
    __device__ __forceinline__ bool operator()(f32x4 (&acc)[2][2][4][2], const Unit& u, int wr, int wc, int fr, int fq) const {
        const int row0 = u.pm * 256 + wr * 64 + fr, col0 = u.pn * 256 + wc * 32 + 8 * fq;
        if (u.kind == 0) {
#pragma unroll
            for (int ai = 0; ai < 2; ++ai)
#pragma unroll
                for (int m = 0; m < 4; ++m) { const size_t off = (size_t)(row0 + ai * 128 + m * 16) * D + col0;
#pragma unroll
                    for (int bj = 0; bj < 2; ++bj) { const u32x4 f = *(const u32x4*)(SGF + off + bj * 128); const u32x4 s = *(const u32x4*)(SGS + off + bj * 128);
                        f32x4& v0 = acc[ai][bj][m][0]; f32x4& v1 = acc[ai][bj][m][1];
                        v0[0] *= bf_lo(f.x) * __builtin_amdgcn_rcpf(bf_lo(s.x)); v0[1] *= bf_hi(f.x) * __builtin_amdgcn_rcpf(bf_hi(s.x));
                        v0[2] *= bf_lo(f.y) * __builtin_amdgcn_rcpf(bf_lo(s.y)); v0[3] *= bf_hi(f.y) * __builtin_amdgcn_rcpf(bf_hi(s.y));
                        v1[0] *= bf_lo(f.z) * __builtin_amdgcn_rcpf(bf_lo(s.z)); v1[1] *= bf_hi(f.z) * __builtin_amdgcn_rcpf(bf_hi(s.z));
                        v1[2] *= bf_lo(f.w) * __builtin_amdgcn_rcpf(bf_lo(s.w)); v1[3] *= bf_hi(f.w) * __builtin_amdgcn_rcpf(bf_hi(s.w)); } }
            return true;
        }
#pragma unroll
        for (int ai = 0; ai < 2; ++ai)
#pragma unroll
            for (int m = 0; m < 4; ++m) { const size_t off = (size_t)(row0 + ai * 128 + m * 16) * D + col0;
#pragma unroll
                for (int bj = 0; bj < 2; ++bj) { const u32x4 s = *(const u32x4*)(SGS + off + bj * 128);
                    const f32x4 v0 = acc[ai][bj][m][0], v1 = acc[ai][bj][m][1];
                    u32x4 w; w.x = cvt_pk_bf16(v0[0] * bf_lo(s.x), v0[1] * bf_hi(s.x)); w.y = cvt_pk_bf16(v0[2] * bf_lo(s.y), v0[3] * bf_hi(s.y));
                    w.z = cvt_pk_bf16(v1[0] * bf_lo(s.z), v1[1] * bf_hi(s.z)); w.w = cvt_pk_bf16(v1[2] * bf_lo(s.w), v1[3] * bf_hi(s.w));
                    *(u32x4*)(MRG + off + bj * 128) = w; } }
        return false;
    }
};

struct Sched4 {
    const char* A; const char* B; int G, c;
    __device__ __forceinline__ bool next(int i, Unit& u) const {
        int pm, pn; if (!pg8::static_tile(MTOK / 256, D / 256, G, c, i, pm, pn)) return false;
        u.A = A + (size_t)pm * 256 * D * 2; u.B = B + (size_t)pn * 256 * D * 2; u.ridx = nullptr; u.pm = pm; u.pn = pn; u.kind = 0; return true;
    }
};
struct Epi4 {
    static constexpr bool PERM = true;
    bf16_t* DLT;
    __device__ __forceinline__ bool operator()(f32x4 (&acc)[2][2][4][2], const Unit& u, int wr, int wc, int fr, int fq) const {
        const int row0 = u.pm * 256 + wr * 64 + fr, col0 = u.pn * 256 + wc * 32 + 8 * fq;
#pragma unroll
        for (int ai = 0; ai < 2; ++ai)
#pragma unroll
            for (int m = 0; m < 4; ++m) { bf16_t* rowp = DLT + (size_t)(row0 + ai * 128 + m * 16) * D + col0;
#pragma unroll
                for (int bj = 0; bj < 2; ++bj) { const f32x4 v0 = acc[ai][bj][m][0], v1 = acc[ai][bj][m][1];
                    u32x4 w; w.x = cvt_pk_bf16(v0[0], v0[1]); w.y = cvt_pk_bf16(v0[2], v0[3]); w.z = cvt_pk_bf16(v1[0], v1[1]); w.w = cvt_pk_bf16(v1[2], v1[3]);
                    *(u32x4*)(rowp + bj * 128) = w; } }
        return false;
    }
};

__device__ __forceinline__ void p5_rows(const Ctx& F, const int parts) {
    LAS float* scr = (LAS float*)(F.lds + F.wave * 16384);
    const int gw = F.bid * 8 + F.wave, NGW = F.G * 8;
    if (parts & 1) {
        unsigned char* WG = (unsigned char*)(F.ws + WS_RA);
        for (int it = gw; it < 16384; it += NGW) {
            const int e = it >> 10, src = (it >> 9) & 1, q = it & 511, kb = q >> 5, nb = q & 31;
            const int f0 = 64 * nb; const size_t dst_row0 = (size_t)e * 4096 + (size_t)(f0 >> 7) * 256 + (src ? 128 : 0) + (f0 & 127);
            transpose_item8((src ? F.w_up : F.w_gate) + (size_t)e * D * DFF, DFF, 64 * kb, f0, WG, dst_row0, D, scr, F.lane);
        }
    }
    __syncthreads();
    if (!(parts & 2)) return;
    LAS bf16x8* WB = (LAS bf16x8*)F.lds;
    for (int i = F.tid; i < 32 * 4 * 16; i += 512) {
        const int e = i & 15, kg = (i >> 4) & 3, ks = i >> 6; const int d0 = 32 * ks + 8 * kg;
        bf16x8 hi, lo;
#pragma unroll
        for (int j = 0; j < 8; ++j) { const float w = F.norm2_g[d0 + j] * F.w_router[(size_t)(d0 + j) * 16 + e]; const unsigned h = f2bf(w); hi[j] = (short)h; lo[j] = (short)f2bf(w - __builtin_bit_cast(float, h << 16)); }
        WB[i] = hi; WB[2048 + i] = lo;
    }
    __syncthreads();
    const float* X1 = F.x; const bf16_t* DLT = (const bf16_t*)(F.ws + WS_DLT); unsigned char* H2 = (unsigned char*)(F.ws + WS_H2); float* AFF = (float*)(F.ws + WS_AFF); float* RSTD = (float*)(F.ws + WS_RSTD);
    const int lane = F.lane, row = lane & 15, kg = lane >> 4;
    for (int task = gw; task < MTOK / 16; task += NGW) {
        const size_t r0 = (size_t)task * 16;
        const float* xp = X1 + (r0 + row) * D + 8 * kg; const bf16_t* dp = DLT + (r0 + row) * D + 8 * kg;
        unsigned char* hp = H2 + (r0 + row) * D + 8 * kg;
        f32x4 acc = (f32x4){0.f, 0.f, 0.f, 0.f}; float ss = 0.f;
#pragma unroll 1
        for (int kc = 0; kc < 4; ++kc) {
            f32x4 xa[8], xb[8]; u32x4 dd[8];
#pragma unroll
            for (int u = 0; u < 8; ++u) { xa[u] = *(const f32x4*)(xp + (kc * 8 + u) * 32); xb[u] = *(const f32x4*)(xp + (kc * 8 + u) * 32 + 4); dd[u] = *(const u32x4*)(dp + (kc * 8 + u) * 32); }
#pragma unroll
            for (int u = 0; u < 8; ++u) {
                const int ks = kc * 8 + u;
                const f32x4 a = xa[u] + (f32x4){bf_lo(dd[u].x), bf_hi(dd[u].x), bf_lo(dd[u].y), bf_hi(dd[u].y)}, b = xb[u] + (f32x4){bf_lo(dd[u].z), bf_hi(dd[u].z), bf_lo(dd[u].w), bf_hi(dd[u].w)};
                ss += (a.x * a.x + a.y * a.y) + (a.z * a.z + a.w * a.w) + (b.x * b.x + b.y * b.y) + (b.z * b.z + b.w * b.w);
                const f32x4 ga = *(const f32x4*)(F.norm2_g + 32 * ks + 8 * kg), gb = *(const f32x4*)(F.norm2_g + 32 * ks + 8 * kg + 4);
                u32x2 h8; h8.x = pk4_fp8(a.x * ga.x, a.y * ga.y, a.z * ga.z, a.w * ga.w); h8.y = pk4_fp8(b.x * gb.x, b.y * gb.y, b.z * gb.z, b.w * gb.w);
                *(u32x2*)(hp + 32 * ks) = h8;
                u32x4 hw, lw;
                hw.x = cvt_pk_bf16(a.x, a.y); hw.y = cvt_pk_bf16(a.z, a.w); hw.z = cvt_pk_bf16(b.x, b.y); hw.w = cvt_pk_bf16(b.z, b.w);
                lw.x = cvt_pk_bf16(a.x - bf_lo(hw.x), a.y - bf_hi(hw.x)); lw.y = cvt_pk_bf16(a.z - bf_lo(hw.y), a.w - bf_hi(hw.y));
                lw.z = cvt_pk_bf16(b.x - bf_lo(hw.z), b.y - bf_hi(hw.z)); lw.w = cvt_pk_bf16(b.z - bf_lo(hw.w), b.w - bf_hi(hw.w));
                const bf16x8 xh = __builtin_bit_cast(bf16x8, hw), xl = __builtin_bit_cast(bf16x8, lw);
                const bf16x8 wh = WB[(ks * 4 + kg) * 16 + row], wl = WB[2048 + (ks * 4 + kg) * 16 + row];
                acc = __builtin_amdgcn_mfma_f32_16x16x32_bf16(xh, wh, acc, 0, 0, 0);
                acc = __builtin_amdgcn_mfma_f32_16x16x32_bf16(xl, wh, acc, 0, 0, 0);
                acc = __builtin_amdgcn_mfma_f32_16x16x32_bf16(xh, wl, acc, 0, 0, 0);
            }
        }
        ss += __shfl_xor(ss, 16); ss += __shfl_xor(ss, 32);
        const float rstd = 1.0f / sqrtf(ss * (1.f / D) + EPS);
        if (kg == 0) RSTD[r0 + row] = rstd;
#pragma unroll
        for (int r = 0; r < 4; ++r) {
            const float lg = acc[r] * __shfl(rstd, 4 * kg + r);
            float mx = lg;
#pragma unroll
            for (int o = 1; o < 16; o <<= 1) mx = fmaxf(mx, __shfl_xor(mx, o));
            const float pe = __expf(lg - mx); float den = pe;
#pragma unroll
            for (int o = 1; o < 16; o <<= 1) den += __shfl_xor(den, o);
            AFF[(r0 + 4 * kg + r) * 16 + row] = pe / den;
        }
    }
    __syncthreads();
}

__device__ __forceinline__ void p6_topk(const Ctx& F) {
    LAS unsigned* cnt = (LAS unsigned*)F.lds;
    const float* AFF = (const float*)(F.ws + WS_AFF);
    int* IDX = (int*)(F.ws + WS_IDX); float* GATE = (float*)(F.ws + WS_GATE); unsigned short* INV = (unsigned short*)(F.ws + WS_INV);
    const int lane = F.lane, wave = F.wave, tid = F.tid;
    for (int item = F.bid; item < NB * NE; item += F.G) {
        const int b = item >> 4, e = item & 15;
        unsigned key[8];
#pragma unroll
        for (int i = 0; i < 8; ++i) key[i] = __builtin_bit_cast(unsigned, AFF[((size_t)b * SEQ + 8 * tid + i) * 16 + e]);
        __syncthreads();
        unsigned T = 0u;
        for (int bit = 30; bit >= 0; --bit) {
            const unsigned cand = T | (1u << bit);
            unsigned c = 0;
#pragma unroll
            for (int i = 0; i < 8; ++i) c += (unsigned)__popcll(__ballot(key[i] >= cand));
            LAS unsigned* cb = cnt + (bit & 1) * 8;
            if (lane == 0) cb[wave] = c;
            __syncthreads();
            unsigned tot = 0;
#pragma unroll
            for (int w = 0; w < 8; ++w) tot += cb[w];
            if (tot >= (unsigned)CAP) T = cand;
        }
        __syncthreads();
        unsigned ngt_w = 0;
        int neq_t = 0;
#pragma unroll
        for (int i = 0; i < 8; ++i) { ngt_w += (unsigned)__popcll(__ballot(key[i] > T)); neq_t += (key[i] == T) ? 1 : 0; }
        LAS unsigned* sc = cnt + 16;
        int incl = neq_t;
#pragma unroll
        for (int o = 1; o < 64; o <<= 1) { const int t = __shfl_up(incl, o); if (lane >= o) incl += t; }
        if (lane == 63) sc[wave] = (unsigned)incl;
        if (lane == 0) sc[16 + wave] = ngt_w;
        __syncthreads();
        unsigned eq_base = 0, ngt = 0;
#pragma unroll
        for (int w = 0; w < 8; ++w) { eq_base += (w < wave) ? sc[w] : 0u; ngt += sc[16 + w]; }
        const int need = CAP - (int)ngt;
        int eq_rank = (int)eq_base + incl - neq_t;
        unsigned selm = 0; int nsel = 0;
#pragma unroll
        for (int i = 0; i < 8; ++i) { bool s = key[i] > T; if (key[i] == T) { s = eq_rank < need; ++eq_rank; } if (s) { selm |= 1u << i; ++nsel; } }
        int incl2 = nsel;
#pragma unroll
        for (int o = 1; o < 64; o <<= 1) { const int t = __shfl_up(incl2, o); if (lane >= o) incl2 += t; }
        if (lane == 63) sc[8 + wave] = (unsigned)incl2;
        __syncthreads();
        unsigned sbase = 0;
#pragma unroll
        for (int w = 0; w < 8; ++w) sbase += (w < wave) ? sc[8 + w] : 0u;
        int slot = (int)sbase + incl2 - nsel;
#pragma unroll
        for (int i = 0; i < 8; ++i) { const int tok = 8 * tid + i; unsigned short iv = 0xFFFFu;
            if (selm & (1u << i)) { IDX[(size_t)item * CAP + slot] = tok; GATE[(size_t)item * CAP + slot] = __builtin_bit_cast(float, key[i]); iv = (unsigned short)slot; ++slot; }
            INV[((size_t)b * SEQ + tok) * 16 + e] = iv; }
        __syncthreads();
    }
}

struct Sched7 {
    const char* H2; const char* WG; const int* IDX; int G, c;
    __device__ __forceinline__ bool next(int i, Unit& u) const {
        if (i >= 16) return false;
        const int e = i, x = c & 7, j = c >> 3;
        const int mt = (x >> 1) * 4 + (j & 3), nt = (x & 1) * 8 + (j >> 2);
        const int b = mt >> 1;
        u.A = H2 + (size_t)b * SEQ * D; u.B = WG + ((size_t)e * 4096 + (size_t)nt * 256) * D;
        u.ridx = IDX + ((size_t)(b * NE + e) * CAP + (mt & 1) * 256); u.pm = e * 16 + mt; u.pn = nt; u.kind = 0; return true;
    }
};
struct Epi7 {
    static constexpr bool PERM = true;
    unsigned char* H; const float* RSTD;
    __device__ __forceinline__ bool operator()(f32x4 (&acc)[2][2][4][2], const Unit& u, int wr, int wc, int fr, int fq) const {
        const int row0 = u.pm * 256 + wr * 64 + fr, col0 = u.pn * 128 + wc * 32 + 8 * fq;
        const int b = (u.pm & 15) >> 1;
        int tok[8]; float rs[8];
#pragma unroll
        for (int i = 0; i < 8; ++i) tok[i] = u.ridx[(i >> 2) * 128 + wr * 64 + (i & 3) * 16 + fr];
#pragma unroll
        for (int i = 0; i < 8; ++i) rs[i] = RSTD[(size_t)b * SEQ + tok[i]];
#pragma unroll
        for (int ai = 0; ai < 2; ++ai)
#pragma unroll
            for (int m = 0; m < 4; ++m) {
                const float ws = rs[ai * 4 + m] * (1.0f / W8_SCALE), os = rs[ai * 4 + m] * (H8_SCALE / W8_SCALE);
                const f32x4 a0 = acc[ai][0][m][0], a1 = acc[ai][0][m][1], g0 = acc[ai][1][m][0], g1 = acc[ai][1][m][1];
                float r[8];
#pragma unroll
                for (int j = 0; j < 4; ++j) { const float x0 = a0[j] * ws, x1 = a1[j] * ws; r[j] = x0 * fast_sigmoid(x0) * (g0[j] * os); r[4 + j] = x1 * fast_sigmoid(x1) * (g1[j] * os); }
                u32x2 w; w.x = pk4_fp8(r[0], r[1], r[2], r[3]); w.y = pk4_fp8(r[4], r[5], r[6], r[7]);
                *(u32x2*)(H + (size_t)(row0 + ai * 128 + m * 16) * DFF + col0) = w; }
        return false;
    }
};

struct Sched8 {
    const char* H; const char* WD; int G, c;
    __device__ __forceinline__ bool next(int i, Unit& u) const {
        if (i >= 4) return false;
        const int x = c & 7, j = c >> 3;
        const int e = i * 4 + (x >> 1), mt = (x & 1) * 8 + (j & 7), nt = j >> 3;
        u.A = H + ((size_t)e * 4096 + (size_t)mt * 256) * DFF; u.B = WD + ((size_t)e * D + (size_t)nt * 256) * DFF; u.ridx = nullptr; u.pm = e * 16 + mt; u.pn = nt; u.kind = 0; return true;
    }
};
struct Epi8 {
    static constexpr bool PERM = true;
    unsigned char* Y; const float* GATE;
    __device__ __forceinline__ bool operator()(f32x4 (&acc)[2][2][4][2], const Unit& u, int wr, int wc, int fr, int fq) const {
        const int e = u.pm >> 4, mt = u.pm & 15, b = mt >> 1;
        const int rl0 = (mt & 1) * 256 + wr * 64 + fr;
        const int col0 = u.pn * 256 + wc * 32 + 8 * fq;
        float gv[8];
#pragma unroll
        for (int i = 0; i < 8; ++i) gv[i] = GATE[(size_t)(b * NE + e) * CAP + rl0 + (i >> 2) * 128 + (i & 3) * 16] * (Y8_SCALE / (W8_SCALE * H8_SCALE));
#pragma unroll
        for (int ai = 0; ai < 2; ++ai)
#pragma unroll
            for (int m = 0; m < 4; ++m) { const int sl = rl0 + ai * 128 + m * 16; const float g = gv[ai * 4 + m];
                unsigned char* rowp = Y + ((size_t)e * 4096 + (size_t)b * CAP + sl) * D + col0;
#pragma unroll
                for (int bj = 0; bj < 2; ++bj) { const f32x4 v0 = acc[ai][bj][m][0] * g, v1 = acc[ai][bj][m][1] * g;
                    u32x2 w; w.x = pk4_fp8(v0[0], v0[1], v0[2], v0[3]); w.y = pk4_fp8(v1[0], v1[1], v1[2], v1[3]);
                    *(u32x2*)(rowp + bj * 128) = w; } }
        return false;
    }
};

__device__ __forceinline__ void p9_final(const Ctx& F) {
    const int gw = F.bid * 8 + F.wave, NGW = F.G * 8, lane = F.lane;
    const unsigned short* INV = (const unsigned short*)(F.ws + WS_INV); const unsigned char* Y = (const unsigned char*)(F.ws + WS_RA); const bf16_t* DLT = (const bf16_t*)(F.ws + WS_DLT);
    f32x4 gg[4];
#pragma unroll
    for (int j = 0; j < 4; ++j) gg[j] = ((const f32x4*)F.final_g)[64 * j + lane];
    for (int m2 = gw; m2 < MTOK / 2; m2 += NGW) {
        const int m = m2 * 2, b = m >> 12;
        const f32x4* xr = (const f32x4*)(F.x + (size_t)m * D) + lane; const u32x2* dr = (const u32x2*)(DLT + (size_t)m * D) + lane;
        f32x4* orow = (f32x4*)(F.out + (size_t)m * D) + lane;
        f32x4 v[2][4]; u32x2 dl[2][4];
#pragma unroll
        for (int r = 0; r < 2; ++r)
#pragma unroll
            for (int j = 0; j < 4; ++j) { v[r][j] = xr[r * 256 + 64 * j]; dl[r][j] = dr[r * 256 + 64 * j]; }
        const unsigned myinv = INV[(size_t)m * 16 + (lane & 31)];
#pragma unroll
        for (int r = 0; r < 2; ++r)
#pragma unroll
            for (int j = 0; j < 4; ++j) { v[r][j].x += bf_lo(dl[r][j].x); v[r][j].y += bf_hi(dl[r][j].x); v[r][j].z += bf_lo(dl[r][j].y); v[r][j].w += bf_hi(dl[r][j].y); }
        f32x4 ys[2][4];
#pragma unroll
        for (int r = 0; r < 2; ++r)
#pragma unroll
            for (int j = 0; j < 4; ++j) ys[r][j] = (f32x4){0.f, 0.f, 0.f, 0.f};
#pragma unroll 1
        for (int e = 0; e < 16; ++e) {
#pragma unroll
            for (int r = 0; r < 2; ++r) {
                const unsigned sl = (unsigned)__builtin_amdgcn_readlane((int)myinv, e + 16 * r);
                if (sl != 0xFFFFu) {
                    const unsigned* yr = (const unsigned*)(Y + ((size_t)e * 4096 + (size_t)b * CAP + sl) * D) + lane;
#pragma unroll
                    for (int j = 0; j < 4; ++j) { const unsigned w = yr[64 * j]; const f32x2 lo = __builtin_amdgcn_cvt_pk_f32_fp8((int)w, false), hi = __builtin_amdgcn_cvt_pk_f32_fp8((int)w, true);
                        ys[r][j].x += lo.x; ys[r][j].y += lo.y; ys[r][j].z += hi.x; ys[r][j].w += hi.y; }
                }
            }
        }
#pragma unroll
        for (int r = 0; r < 2; ++r) {
            float s = 0.f;
#pragma unroll
            for (int j = 0; j < 4; ++j) { v[r][j] = v[r][j] + ys[r][j] * (1.0f / Y8_SCALE); s += (v[r][j].x * v[r][j].x + v[r][j].y * v[r][j].y) + (v[r][j].z * v[r][j].z + v[r][j].w * v[r][j].w); }
            const float rstd = 1.0f / sqrtf(wave_sum(s) * (1.f / D) + EPS);
#pragma unroll
            for (int j = 0; j < 4; ++j) orow[r * 256 + 64 * j] = v[r][j] * rstd * gg[j];
        }
    }
}

__global__ void __launch_bounds__(512, 2) mk_fwd(Args args) {
    extern __shared__ __attribute__((aligned(16))) unsigned char lds_raw[];
    cg::grid_group grid = cg::this_grid();
    Ctx F;
    F.lds = (LAS unsigned char*)lds_raw;
    F.tid = threadIdx.x; F.lane = F.tid & 63; F.wave = __builtin_amdgcn_readfirstlane(F.tid >> 6); F.G = gridDim.x; F.bid = blockIdx.x;
    F.x = args.in[0]; F.norm1_g = args.in[1]; F.w_in = args.in[2]; F.ln_g = args.in[3]; F.ln_b = args.in[4]; F.w_sp = args.in[5]; F.b_sp = args.in[6];
    F.w_fo = args.in[7]; F.w_so = args.in[8]; F.w_out = args.in[9]; F.norm2_g = args.in[10]; F.w_router = args.in[11]; F.w_gate = args.in[12]; F.w_up = args.in[13];
    F.w_down = args.in[14]; F.final_g = args.in[15]; F.out = args.out; F.ws = args.ws;
    const unsigned pm_ = args.ph_mask;
    unsigned char* ws = args.ws;
    if (F.tid < 2) ((LAS unsigned*)(F.lds + LDS_MISC))[F.tid] = 0u;
    __syncthreads();
    if (args.pad == 0x5eedu) grid.sync();
    const XcdBarrier xbar = xcd_barrier_post((unsigned*)(ws + WS_CTL), (volatile LAS unsigned*)(F.lds + LDS_MISC));
#ifndef PROBE_PHASE
#define PROBE_PHASE -1
#endif
    volatile LAS unsigned long long* stamps_ = (volatile LAS unsigned long long*)(F.lds + LDS_BYTES - 256);
#define STAMP(k) do { if (PROBE_PHASE >= 0 && F.bid == 0 && F.tid == 0) stamps_[k] = __builtin_amdgcn_s_memrealtime(); } while (0)
#ifndef PH_CT_MASK
#define PH_CT_MASK 0xffffu
#endif
#define RUN(k) ((((PH_CT_MASK) >> (k)) & 1u) && ((pm_ >> (k)) & 1u))
#define SEAM(k) do { if ((pm_ & ((2u << (k)) - 1u)) && (pm_ >> ((k) + 1))) { xcd_barrier(xbar); } } while (0)
    STAMP(0); if (RUN(0)) p0_prep(F, 1); STAMP(1); if (RUN(1)) p0_prep(F, 2); STAMP(2); if (RUN(2)) p0_prep(F, 4); STAMP(3); if (RUN(3)) p0_prep(F, 8);
    SEAM(3); STAMP(4);
    if (RUN(4)) {
        Sched1 S{(const char*)(ws + WS_HN), (const char*)(ws + WS_WIN), F.G, F.bid}; Epi1 E{ws};
        pg8::gemm_phase<Epi1, Sched1, false>(F.lds, D, S, E);
    }
    SEAM(4); STAMP(5);
    if (RUN(5)) p2_sgu(F);
    STAMP(6);
    if (RUN(6)) fft_stage<0>(F);
    SEAM(6); STAMP(7);
    if (RUN(7)) fft_stage<1>(F);
    SEAM(7); STAMP(8);
    if (RUN(8)) {
        Sched3 S{(const char*)(ws + WS_FM), (const char*)(ws + WS_SG), (const char*)(ws + WS_WFO), (const char*)(ws + WS_WSO), F.G, F.bid};
        Epi3 E{(const bf16_t*)(ws + WS_SGF), (const bf16_t*)(ws + WS_SGS), (bf16_t*)(ws + WS_MRG)};
        pg8::gemm_phase<Epi3, Sched3, false>(F.lds, 512, S, E);
    }
    SEAM(8); STAMP(9);
    if (RUN(9)) {
        Sched4 S{(const char*)(ws + WS_MRG), (const char*)(ws + WS_WOUT), F.G, F.bid}; Epi4 E{(bf16_t*)(ws + WS_DLT)};
        pg8::gemm_phase<Epi4, Sched4, false>(F.lds, D, S, E);
    }
    SEAM(9); STAMP(10);
    if (RUN(10)) p5_rows(F, 1);
    STAMP(11);
    if (RUN(11)) p5_rows(F, 2);
    SEAM(11); STAMP(12);
    if (RUN(12)) p6_topk(F);
    SEAM(12); STAMP(13);
    if (RUN(13)) {
        Sched7 S{(const char*)(ws + WS_H2), (const char*)(ws + WS_RA), (const int*)(ws + WS_IDX), F.G, F.bid}; Epi7 E{(unsigned char*)(ws + WS_H), (const float*)(ws + WS_RSTD)};
        pg8::gemm_phase<Epi7, Sched7, true, true>(F.lds, D / 2, S, E);
    }
    SEAM(13); STAMP(14);
    if (RUN(14)) {
        Sched8 S{(const char*)(ws + WS_H), (const char*)(ws + WS_WD), F.G, F.bid}; Epi8 E{(unsigned char*)(ws + WS_RA), (const float*)(ws + WS_GATE)};
        pg8::gemm_phase<Epi8, Sched8, false, true>(F.lds, DFF / 2, S, E);
    }
    SEAM(14); STAMP(15);
    if (RUN(15)) p9_final(F);
    STAMP(16);
    if (PROBE_PHASE >= 0 && F.bid == 0 && F.tid == 0) { const unsigned long long dt = 4ull * (stamps_[PROBE_PHASE + 1] - stamps_[PROBE_PHASE]), t0 = __builtin_amdgcn_s_memrealtime();
        while (__builtin_amdgcn_s_memrealtime() - t0 < dt) __builtin_amdgcn_s_sleep(32); }
#undef RUN
#undef SEAM
}

extern "C" void kernel_launch(void* const* d_in, const int* in_sizes, int n_in, void* d_out, int out_size, void* d_ws, size_t ws_size, hipStream_t stream) {
    static int grid = 0;
    if (grid == 0) {
        if (n_in != 16 || out_size != MTOK * D || ws_size < WS_END) { fprintf(stderr, "kernel_launch: unexpected shapes (n_in %d, out %d, ws %zu < %zu)\n", n_in, out_size, ws_size, (size_t)WS_END); grid = -1; return; }
        int dev = 0, cus = 0, per_cu = 0;
        if (hipGetDevice(&dev) != hipSuccess || hipDeviceGetAttribute(&cus, hipDeviceAttributeMultiprocessorCount, dev) != hipSuccess) { grid = -1; return; }
        if (hipFuncSetAttribute((const void*)mk_fwd, hipFuncAttributeMaxDynamicSharedMemorySize, LDS_BYTES) != hipSuccess) { fprintf(stderr, "kernel_launch: hipFuncSetAttribute failed\n"); grid = -1; return; }
        if (hipOccupancyMaxActiveBlocksPerMultiprocessor(&per_cu, (const void*)mk_fwd, 512, LDS_BYTES) != hipSuccess || per_cu < 1) { fprintf(stderr, "kernel_launch: occupancy query failed (%d)\n", per_cu); grid = -1; return; }
        if (per_cu > 1) per_cu = 1;
        grid = cus * per_cu;
        if (grid != 256) fprintf(stderr, "kernel_launch: note: grid %d (tile orders are tuned for 256)\n", grid);
    }
    if (grid < 0) return;
    if (hipMemsetAsync((char*)d_ws + WS_CTL, 0, CTL_BYTES, stream) != hipSuccess) { fprintf(stderr, "kernel_launch: hipMemsetAsync failed\n"); return; }
    Args a{};
    for (int i = 0; i < 16; ++i) a.in[i] = (const float*)d_in[i];
    a.out = (float*)d_out; a.ws = (unsigned char*)d_ws;
#if MK_N_LAUNCHES == 1
    a.ph_mask = 0xffffu;
    void* kargs[] = {&a};
    hipError_t e = hipLaunchCooperativeKernel((const void*)mk_fwd, dim3(grid), dim3(512), kargs, LDS_BYTES, stream);
    if (e != hipSuccess) fprintf(stderr, "kernel_launch: cooperative launch failed: %s (grid %d)\n", hipGetErrorString(e), grid);
#else
#ifndef PROBE_DUP
#define PROBE_DUP 0
#endif
    for (int p = 0; p < 16; ++p) {
        const int reps = ((PROBE_DUP >> p) & 1) ? 2 : 1;
        for (int r = 0; r < reps; ++r) { a.ph_mask = 1u << p; hipLaunchKernelGGL(mk_fwd, dim3(grid), dim3(512), LDS_BYTES, stream, a); }
    }
#endif
}
```

```cpp
#include <hip/hip_runtime.h>
#include <hip/hip_cooperative_groups.h>
#include <cstdio>
#include <cstdint>
namespace cg = cooperative_groups;

#ifndef MK_N_LAUNCHES
#define MK_N_LAUNCHES 1
#endif

#define LAS __attribute__((address_space(3)))
typedef unsigned short bf16_t;
typedef short bf16x8 __attribute__((ext_vector_type(8)));
typedef float f32x4 __attribute__((ext_vector_type(4)));
typedef float f32x2 __attribute__((ext_vector_type(2)));
typedef unsigned u32x4 __attribute__((ext_vector_type(4)));
typedef unsigned u32x2 __attribute__((ext_vector_type(2)));
typedef int i32x4 __attribute__((ext_vector_type(4)));
typedef int i32x8 __attribute__((ext_vector_type(8)));

constexpr int D = 1024, NB = 8, SEQ = 4096, MTOK = NB * SEQ;
constexpr int FW = 512, SWD = 512, NE = 16, CAP = 512, DFF = 2048;
constexpr int N1 = 3584;
constexpr int INW = 3584;
constexpr float EPS = 1e-6f;

constexpr size_t MiB = 1u << 20;
constexpr size_t WS_RA = 0;
constexpr size_t WS_WGU = 64 * MiB;
constexpr size_t WS_WD = 128 * MiB;
constexpr size_t WS_RH = 192 * MiB;
constexpr size_t WS_YF = WS_RH;
constexpr size_t WS_GU = WS_RH + 64 * MiB;
constexpr size_t WS_GV = WS_RH + 96 * MiB;
constexpr size_t WS_SGF = WS_RH + 128 * MiB;
constexpr size_t WS_SGS = WS_RH + 192 * MiB;
constexpr size_t WS_FM = WS_GU;
constexpr size_t WS_MRG = WS_RH;
constexpr size_t WS_H = WS_RH + 128 * MiB;
constexpr size_t WS_DLT = WS_RH + 64 * MiB;
constexpr size_t WS_RS = 448 * MiB;
constexpr size_t WS_HN = WS_RS;
constexpr size_t WS_AP = WS_RS;
constexpr size_t WS_SG = WS_RA;
constexpr size_t WS_H2 = WS_RS;
constexpr size_t WS_WIN = 512 * MiB;
constexpr size_t WS_WFO = 520 * MiB;
constexpr size_t WS_WSO = 521 * MiB;
constexpr size_t WS_WOUT = 522 * MiB;
constexpr size_t WS_AFF = 524 * MiB;
constexpr size_t WS_INV = 526 * MiB;
constexpr size_t WS_IDX = 527 * MiB;
constexpr size_t WS_GATE = WS_IDX + 256 * 1024;
constexpr size_t WS_MA = WS_IDX + 512 * 1024;
constexpr size_t WS_MB = WS_MA + 32 * 1024;
constexpr size_t WS_RSTD = WS_IDX + 832 * 1024;
constexpr size_t WS_WRT = WS_IDX + 960 * 1024;
constexpr size_t WS_CST = WS_IDX + 576 * 1024;
constexpr size_t WS_CTL = WS_IDX + 768 * 1024;
constexpr size_t CTL_BYTES = 16384;
constexpr size_t WS_END = 528 * MiB;

constexpr int LDS_STAGE = 131072;
constexpr int LDS_X_OFF = LDS_STAGE;
constexpr int LDS_BYTES = 155648;
constexpr int LDS_MISC = LDS_BYTES - 64;

__device__ __forceinline__ unsigned f2bf(float f) { unsigned u = __builtin_bit_cast(unsigned, f); return (u + 0x7fffu + ((u >> 16) & 1u)) >> 16; }
__device__ __forceinline__ unsigned pk2(float lo, float hi) { return f2bf(lo) | (f2bf(hi) << 16); }
__device__ __forceinline__ unsigned cvt_pk_bf16(float lo, float hi) { unsigned r; asm volatile("v_cvt_pk_bf16_f32 %0, %1, %2" : "=v"(r) : "v"(lo), "v"(hi)); return r; }
__device__ __forceinline__ float bf_lo(unsigned w) { return __builtin_bit_cast(float, w << 16); }
__device__ __forceinline__ float bf_hi(unsigned w) { return __builtin_bit_cast(float, w & 0xffff0000u); }
__device__ __forceinline__ float wave_sum(float v) {
#pragma unroll
    for (int o = 1; o < 64; o <<= 1) v += __shfl_xor(v, o);
    return v;
}
__device__ __forceinline__ float fast_sigmoid(float x) { return __builtin_amdgcn_rcpf(1.0f + __builtin_amdgcn_exp2f(-1.44269504089f * x)); }
__device__ __forceinline__ float gelu_tanh(float x) {
    const float u = 1.5957691216f * (x + 0.044715f * x * x * x);
    return x * fast_sigmoid(u);
}
#define LDS_WAIT() asm volatile("s_waitcnt lgkmcnt(0)" ::: "memory")
__device__ __forceinline__ unsigned pk4_fp8(float a, float b, float c, float d) {
    a = __builtin_amdgcn_fmed3f(a, -448.f, 448.f); b = __builtin_amdgcn_fmed3f(b, -448.f, 448.f); c = __builtin_amdgcn_fmed3f(c, -448.f, 448.f); d = __builtin_amdgcn_fmed3f(d, -448.f, 448.f);
    int r = 0; r = __builtin_amdgcn_cvt_pk_fp8_f32(a, b, r, false); r = __builtin_amdgcn_cvt_pk_fp8_f32(c, d, r, true); return (unsigned)r;
}
constexpr float W8_SCALE = 32.0f;
constexpr float H8_SCALE = 8.0f;
constexpr float Y8_SCALE = 64.0f;

namespace pg8 {
constexpr int BM = 256, BK = 64, HALF = 128, HTB = HALF * BK * 2, NXCD = 8, WGM = 8;
__device__ __forceinline__ int lds_byte(int r, int c) { const int st = (r >> 4) * 2 + (c >> 5), rr = r & 15, cc = c & 31, ob = rr * 64 + cc * 2; return st * 1024 + (ob ^ (((ob >> 9) & 1) << 5)); }
__device__ __forceinline__ void stage_rc(int b, int& R, int& C) { const int st = b / 1024, sb = b % 1024, swz = sb ^ (((sb >> 9) & 1) << 5); R = (st >> 1) * 16 + swz / 64; C = (st & 1) * 32 + (swz % 64) / 2; }
__device__ __forceinline__ int perm32(int rho) { const int n = rho >> 4, i = rho & 15; return 8 * (i >> 2) + 4 * n + (i & 3); }

struct Unit { const char* A; const char* B; const int* ridx; int pm, pn, kind; };

__device__ __forceinline__ bool static_tile(int nM, int nN, int G, int c, int i, int& pm, int& pn) {
    const int nwg = nM * nN; const long L = (long)i * G + c; if (L >= nwg) return false;
    int wgid = (int)L; { const int q = nwg / NXCD, r = nwg % NXCD, xcd = wgid % NXCD, off = wgid / NXCD; wgid = (xcd < r ? xcd * (q + 1) : r * (q + 1) + (xcd - r) * q) + off; }
    const int nig = WGM * nN, gid = wgid / nig, fm = gid * WGM, gsz = (nM - fm) < WGM ? (nM - fm) : WGM;
    pm = fm + ((wgid % nig) % gsz); pn = (wgid % nig) / gsz; return true;
}

template <class Epi, class Sched, bool GATHER, bool FP8 = false>
__device__ __forceinline__ void gemm_phase(LAS unsigned char* lds, const int K, const Sched& S, const Epi& E) {
    const int tid = threadIdx.x, wid = __builtin_amdgcn_readfirstlane(tid >> 6), lane = tid & 63, wr = wid >> 2, wc = wid & 3, fr = lane & 15, fq = lane >> 4;
    const int nt = K / BK;
    unsigned voffA[2], voffB[2]; int RA[2], CA2[2];
#pragma unroll
    for (int i = 0; i < 2; ++i) { int R, C; stage_rc(tid * 16 + i * 8192, R, C); const int Rb = Epi::PERM ? ((R & ~31) + perm32(R & 31)) : R;
        voffA[i] = (unsigned)(R * K + C) * 2u; voffB[i] = (unsigned)(Rb * K + C) * 2u; RA[i] = R; CA2[i] = C * 2; }
    const size_t kstep = (size_t)(BK * 2);
    const size_t hstep = (size_t)HALF * K * 2;
    const unsigned ldsw = (unsigned)wid * 1024u;
    const int aoff = lds_byte(wr * 64 + fr, fq * 8), boff = lds_byte(wc * 32 + fr, fq * 8);
#define PG8_SA(b, h) (((b) * 2 + (h)) * HTB)
#define PG8_SB(b, h) ((4 + (b) * 2 + (h)) * HTB)
#define PG8_GLDS(bufoff, gptr, _i) __builtin_amdgcn_global_load_lds((const unsigned*)(gptr), (LAS unsigned*)(lds + (bufoff) + ldsw + (_i) * 8192), 16, 0, 0)
#define PG8_STAGE_B(bufoff, gbase) do { _Pragma("unroll") for (int _i = 0; _i < 2; ++_i) PG8_GLDS(bufoff, (const char*)(gbase) + voffB[_i], _i); } while (0)
#define PG8_STAGE_A(bufoff, gbase, h, go) do { _Pragma("unroll") for (int _i = 0; _i < 2; ++_i) { \
        if constexpr (GATHER) PG8_GLDS(bufoff, (const char*)(gbase) + go[h][_i], _i); else PG8_GLDS(bufoff, (const char*)(gbase) + (h) * hstep + voffA[_i], _i); } } while (0)
#define PG8_LD2(d2, d8, base) do { const LAS i32x4* p_ = (const LAS i32x4*)(base); const i32x4 lo_ = p_[0], hi_ = p_[64]; \
        if constexpr (FP8) d8 = __builtin_shufflevector(lo_, hi_, 0, 1, 2, 3, 4, 5, 6, 7); else { d2[0] = __builtin_bit_cast(bf16x8, lo_); d2[1] = __builtin_bit_cast(bf16x8, hi_); } } while (0)
#define PG8_LDA(dst, b, h) do { _Pragma("unroll") for (int m = 0; m < 4; ++m) PG8_LD2(dst[m], dst##8[m], lds + PG8_SA(b, h) + aoff + m * 2048); } while (0)
#define PG8_LDB(dst, b, h) do { _Pragma("unroll") for (int n = 0; n < 2; ++n) PG8_LD2(dst[n], dst##8[n], lds + PG8_SB(b, h) + boff + n * 2048); } while (0)
#define PG8_MMA(ai, bj, At, Bt) do { __builtin_amdgcn_s_setprio(1); _Pragma("unroll") for (int m = 0; m < 4; ++m) _Pragma("unroll") for (int n = 0; n < 2; ++n) { \
        if constexpr (FP8) asm volatile("v_mfma_f32_16x16x128_f8f6f4 %0, %1, %2, %0" : "+v"(acc[ai][bj][m][n]) : "v"(Bt##8[n]), "v"(At##8[m])); \
        else { _Pragma("unroll") for (int k = 0; k < 2; ++k) acc[ai][bj][m][n] = __builtin_amdgcn_mfma_f32_16x16x32_bf16(Bt[n][k], At[m][k], acc[ai][bj][m][n], 0, 0, 0); } } \
        __builtin_amdgcn_s_setprio(0); } while (0)
#define PG8_WAIT_V(n) asm volatile("s_waitcnt vmcnt(" #n ")" ::: "memory")
#define PG8_WAIT_L(n) asm volatile("s_waitcnt lgkmcnt(" #n ")" ::: "memory")
#define PG8_BAR __builtin_amdgcn_s_barrier()
#define PG8_SCHED __builtin_amdgcn_sched_barrier(0)
#define PG8_GOFS(dst, u) do { if constexpr (GATHER) { _Pragma("unroll") for (int _h = 0; _h < 2; ++_h) _Pragma("unroll") for (int _i = 0; _i < 2; ++_i) \
        dst[_h][_i] = (unsigned)(u).ridx[_h * HALF + RA[_i]] * (unsigned)(K * 2) + (unsigned)CA2[_i]; } } while (0)
    Unit cur, nxt; int ui = 0;
    if (!S.next(0, cur)) return;
    f32x4 acc[2][2][4][2];
#pragma unroll
    for (int a = 0; a < 2; ++a)
#pragma unroll
        for (int b = 0; b < 2; ++b)
#pragma unroll
            for (int m = 0; m < 4; ++m)
#pragma unroll
                for (int n = 0; n < 2; ++n) acc[a][b][m][n] = (f32x4){0.f, 0.f, 0.f, 0.f};
    bf16x8 At[4][2], B0[2][2], B1[2][2]; i32x8 At8[4], B08[2], B18[2];
    unsigned gA[2][2] = {{0u, 0u}, {0u, 0u}}, gN[2][2] = {{0u, 0u}, {0u, 0u}};
    PG8_GOFS(gA, cur);
    const char* cA = cur.A; const char* cB = cur.B;
    PG8_STAGE_B(PG8_SB(0, 0), cB); PG8_STAGE_B(PG8_SB(0, 1), cB + hstep); PG8_STAGE_A(PG8_SA(0, 0), cA, 0, gA); PG8_STAGE_A(PG8_SA(0, 1), cA, 1, gA);
    if (wr == 1) PG8_BAR;
    PG8_WAIT_V(2); PG8_BAR;
    PG8_STAGE_B(PG8_SB(1, 0), cB + kstep); PG8_STAGE_A(PG8_SA(1, 0), cA + kstep, 0, gA); PG8_STAGE_B(PG8_SB(1, 1), cB + hstep + kstep);
    PG8_WAIT_V(6); PG8_BAR;
    for (;;) {
        const bool has_next = S.next(ui + 1, nxt);
        if (!has_next) nxt = cur;
        PG8_GOFS(gN, nxt);
        const char* nA = nxt.A; const char* nB = nxt.B;
#pragma clang loop unroll(disable)
        for (int t = 0; t < nt; t += 2) {
            const bool last = (t == nt - 2);
            const char* a1 = cA + (size_t)(t + 1) * kstep;
            const char* a2 = last ? nA : cA + (size_t)(t + 2) * kstep; const char* b2 = last ? nB : cB + (size_t)(t + 2) * kstep;
            const char* a3 = a2 + kstep; const char* b3 = b2 + kstep;
            unsigned g2[2][2];
#pragma unroll
            for (int _h = 0; _h < 2; ++_h)
#pragma unroll
                for (int _i = 0; _i < 2; ++_i) g2[_h][_i] = last ? gN[_h][_i] : gA[_h][_i];
            PG8_LDB(B0, 0, 0); PG8_LDB(B1, 0, 1); PG8_SCHED; PG8_LDA(At, 0, 0); PG8_STAGE_A(PG8_SA(1, 1), a1, 1, gA);
            PG8_WAIT_V(8); PG8_WAIT_L(0); PG8_BAR; PG8_MMA(0, 0, At, B0); PG8_MMA(0, 1, At, B1); PG8_BAR; PG8_SCHED;
            PG8_LDA(At, 0, 1); PG8_STAGE_B(PG8_SB(0, 0), b2); PG8_STAGE_B(PG8_SB(0, 1), b2 + hstep); PG8_STAGE_A(PG8_SA(0, 0), a2, 0, g2);
            PG8_WAIT_V(8); PG8_WAIT_L(0); PG8_BAR; PG8_MMA(1, 0, At, B0); PG8_MMA(1, 1, At, B1); PG8_BAR; PG8_SCHED;
            PG8_LDB(B0, 1, 0); PG8_LDB(B1, 1, 1); PG8_SCHED; PG8_LDA(At, 1, 0); PG8_STAGE_A(PG8_SA(0, 1), a2, 1, g2);
            PG8_WAIT_V(8); PG8_WAIT_L(0); PG8_BAR; PG8_MMA(0, 0, At, B0); PG8_MMA(0, 1, At, B1); PG8_BAR; PG8_SCHED;
            PG8_LDA(At, 1, 1); PG8_STAGE_B(PG8_SB(1, 0), b3); PG8_STAGE_B(PG8_SB(1, 1), b3 + hstep); PG8_STAGE_A(PG8_SA(1, 0), a3, 0, g2);
            PG8_WAIT_V(8); PG8_WAIT_L(0); PG8_BAR; PG8_MMA(1, 0, At, B0); PG8_MMA(1, 1, At, B1); PG8_BAR; PG8_SCHED;
        }
        if (wr == 0) PG8_BAR;
        if constexpr (FP8) asm volatile("s_nop 15\n\ts_nop 15" ::: "memory");
        const bool keep = E(acc, cur, wr, wc, fr, fq);
        if (!has_next) break;
        if (!keep) {
#pragma unroll
            for (int a = 0; a < 2; ++a)
#pragma unroll
                for (int b = 0; b < 2; ++b)
#pragma unroll
                    for (int m = 0; m < 4; ++m)
#pragma unroll
                        for (int n = 0; n < 2; ++n) acc[a][b][m][n] = (f32x4){0.f, 0.f, 0.f, 0.f};
        }
        cur = nxt; cA = nA; cB = nB; ++ui;
#pragma unroll
        for (int _h = 0; _h < 2; ++_h)
#pragma unroll
            for (int _i = 0; _i < 2; ++_i) gA[_h][_i] = gN[_h][_i];
        if (wr == 1) PG8_BAR;
    }
    PG8_WAIT_V(0);
    PG8_BAR;
#undef PG8_SA
#undef PG8_SB
#undef PG8_GLDS
#undef PG8_STAGE_A
#undef PG8_STAGE_B
#undef PG8_LDA
#undef PG8_LDB
#undef PG8_MMA
#undef PG8_LD2
#undef PG8_WAIT_V
#undef PG8_WAIT_L
#undef PG8_BAR
#undef PG8_SCHED
#undef PG8_GOFS
}
}
using pg8::Unit;

#define XB_TMO      128
#define XB_XCNT(j)  (256  + 64 * (j))
#define XB_XSUB(j)  (1280 + 64 * (j))
#define XB_XGEN(j)  (2304 + 64 * (j))
#define XB_TOP      3328
#define XB_TOPGEN   3392
#define XB_SPIN_CAP (1u << 22)
__device__ __forceinline__ unsigned xb_ld(unsigned* p)              { return __hip_atomic_load(p, __ATOMIC_RELAXED, __HIP_MEMORY_SCOPE_AGENT); }
__device__ __forceinline__ unsigned xb_add(unsigned* p, unsigned v) { return __hip_atomic_fetch_add(p, v, __ATOMIC_RELAXED, __HIP_MEMORY_SCOPE_AGENT); }
__device__ __forceinline__ unsigned xb_xcc_id() { return (unsigned)__builtin_amdgcn_s_getreg((3 << 11) | 20) & 0xFu; }
#define XB_SPIN(cond, bar) do { unsigned _sp = 0; while (cond) { __builtin_amdgcn_s_sleep(1); \
    if ((++_sp & 255u) == 0u) { if (xb_ld(&(bar)[XB_TMO])) break; if (_sp > XB_SPIN_CAP) { atomicAdd(&(bar)[XB_TMO], 1u); break; } } } } while (0)
struct XcdBarrier { unsigned* bar; unsigned x; volatile LAS unsigned* st; };
__device__ __forceinline__ XcdBarrier xcd_barrier_post(unsigned* bar, volatile LAS unsigned* st) {
    XcdBarrier b; b.bar = bar; b.x = xb_xcc_id(); b.st = st;
    if (threadIdx.x == 0) (void)xb_add(&bar[XB_XCNT(b.x)], 1u);
    return b;
}
__device__ __forceinline__ void xcd_barrier_complete(unsigned* bar, unsigned x, unsigned& nloc, unsigned& nx) {
    const unsigned G = gridDim.x * gridDim.y * gridDim.z;
    unsigned sum, cnt, mine, sp = 0u;
    for (;;) {
        sum = 0u; cnt = 0u; mine = 0u;
#pragma unroll
        for (unsigned j = 0; j < 16; ++j) { const unsigned c = xb_ld(&bar[XB_XCNT(j)]); sum += c; cnt += (c > 0u) ? 1u : 0u; mine = (j == x) ? c : mine; }
        if (sum == G) break;
        __builtin_amdgcn_s_sleep(1);
        if ((++sp & 255u) == 0u) { if (xb_ld(&bar[XB_TMO])) break; if (sp > XB_SPIN_CAP) { atomicAdd(&bar[XB_TMO], 1u); break; } }
    }
    nloc = mine > 0u ? mine : 1u; nx = cnt > 0u ? cnt : 1u;
}
__device__ __forceinline__ void xcd_barrier(const XcdBarrier& b) {
    asm volatile("s_waitcnt vmcnt(0)" ::: "memory");
    __syncthreads();
    if (threadIdx.x == 0) {
        unsigned* bar = b.bar;
        __builtin_amdgcn_s_waitcnt(0);
        unsigned nloc = b.st[0], nx = b.st[1];
        if (nloc == 0u) { xcd_barrier_complete(bar, b.x, nloc, nx); b.st[0] = nloc; b.st[1] = nx; }
        const unsigned old = xb_add(&bar[XB_XSUB(b.x)], 1u);
        const unsigned gen = old / nloc;
        if (old + 1u == (gen + 1u) * nloc) {
            __builtin_amdgcn_fence(__ATOMIC_RELEASE, "agent");
            asm volatile("s_waitcnt vmcnt(0)" ::: "memory");
            const unsigned og = xb_add(&bar[XB_TOP], 1u);
            const unsigned tg = og / nx;
            if (og + 1u == (tg + 1u) * nx) xb_add(&bar[XB_TOPGEN], 1u);
            else XB_SPIN(xb_ld(&bar[XB_TOPGEN]) == tg, bar);
            __builtin_amdgcn_fence(__ATOMIC_ACQUIRE, "agent");
            xb_add(&bar[XB_XGEN(b.x)], 1u);
            asm volatile("s_waitcnt vmcnt(0)" ::: "memory");
        } else {
            XB_SPIN(xb_ld(&bar[XB_XGEN(b.x)]) == gen, bar);
            __builtin_amdgcn_fence(__ATOMIC_ACQUIRE, "agent");
            asm volatile("s_waitcnt vmcnt(0)" ::: "memory");
        }
    }
    __syncthreads();
}

struct Args {
    const float* in[16];
    float* out;
    unsigned char* ws;
    unsigned ph_mask, pad;
};

struct Ctx {
    LAS unsigned char* lds;
    int tid, lane, wave, G, bid;
    const float *x, *norm1_g, *w_in, *ln_g, *ln_b, *w_sp, *b_sp, *w_fo, *w_so, *w_out, *norm2_g, *w_router, *w_gate, *w_up, *w_down, *final_g;
    float* out;
    unsigned char* ws;
};

__device__ __forceinline__ void transpose_item(const float* W, int N, int k0, int n0, bf16_t* WT, size_t dst_row0, int Kd, LAS float* scr, int lane) {
    const float* src = W + (size_t)(k0 + (lane >> 4)) * N + n0;
#pragma unroll
    for (int i = 0; i < 16; ++i) {
        const int n4 = (lane & 15) ^ ((i >> 1) & 7);
        __builtin_amdgcn_global_load_lds((const unsigned*)(src + (size_t)(4 * i) * N + 4 * n4), (LAS unsigned*)(scr + i * 256), 16, 0, 0);
    }
    asm volatile("s_waitcnt vmcnt(0)" ::: "memory");
    const int hh = lane >> 5, c = (lane >> 2) & 7, sub = lane & 3;
#pragma unroll
    for (int j = 0; j < 8; ++j) {
        const int n4 = 2 * j + hh;
        const LAS float* p = scr + (16 * (8 * c) + (n4 ^ c)) * 4 + sub;
        float v[8];
#pragma unroll
        for (int i = 0; i < 8; ++i) v[i] = p[i * 64];
        u32x4 o; o.x = pk2(v[0], v[1]); o.y = pk2(v[2], v[3]); o.z = pk2(v[4], v[5]); o.w = pk2(v[6], v[7]);
        *(u32x4*)(WT + (dst_row0 + 4 * n4 + sub) * (size_t)Kd + k0 + 8 * c) = o;
    }
    LDS_WAIT(); asm volatile("" ::: "memory");
}

__device__ __forceinline__ void transpose_item8(const float* W, int N, int k0, int n0, unsigned char* WT8, size_t dst_row0, int Kd, LAS float* scr, int lane) {
    const float* src = W + (size_t)(k0 + (lane >> 4)) * N + n0;
#pragma unroll
    for (int i = 0; i < 16; ++i) {
        const int n4 = (lane & 15) ^ ((i >> 1) & 7);
        __builtin_amdgcn_global_load_lds((const unsigned*)(src + (size_t)(4 * i) * N + 4 * n4), (LAS unsigned*)(scr + i * 256), 16, 0, 0);
    }
    asm volatile("s_waitcnt vmcnt(0)" ::: "memory");
    const int hh = lane >> 5, c = (lane >> 2) & 7, sub = lane & 3;
#pragma unroll
    for (int j = 0; j < 8; ++j) {
        const int n4 = 2 * j + hh;
        const LAS float* p = scr + (16 * (8 * c) + (n4 ^ c)) * 4 + sub;
        float v[8];
#pragma unroll
        for (int i = 0; i < 8; ++i) v[i] = p[i * 64] * W8_SCALE;
        u32x2 o; o.x = pk4_fp8(v[0], v[1], v[2], v[3]); o.y = pk4_fp8(v[4], v[5], v[6], v[7]);
        *(u32x2*)(WT8 + (dst_row0 + 4 * n4 + sub) * (size_t)Kd + k0 + 8 * c) = o;
    }
    LDS_WAIT(); asm volatile("" ::: "memory");
}

__device__ __forceinline__ void rms_rows4_to_bf16(const float* x0, const f32x4 (&gg)[4], bf16_t* o0, int lane) {
    f32x4 v[4][4];
#pragma unroll
    for (int r = 0; r < 4; ++r)
#pragma unroll
        for (int j = 0; j < 4; ++j) v[r][j] = ((const f32x4*)(x0 + (size_t)r * D))[64 * j + lane];
#pragma unroll
    for (int r = 0; r < 4; ++r) {
        float s = 0.f;
#pragma unroll
        for (int j = 0; j < 4; ++j) s += (v[r][j].x * v[r][j].x + v[r][j].y * v[r][j].y) + (v[r][j].z * v[r][j].z + v[r][j].w * v[r][j].w);
        const float rstd = 1.0f / sqrtf(wave_sum(s) * (1.f / D) + EPS);
        u32x2* o8 = (u32x2*)(o0 + (size_t)r * D) + lane;
#pragma unroll
        for (int j = 0; j < 4; ++j) { u32x2 w; w.x = pk2(v[r][j].x * rstd * gg[j].x, v[r][j].y * rstd * gg[j].y); w.y = pk2(v[r][j].z * rstd * gg[j].z, v[r][j].w * rstd * gg[j].w); o8[64 * j] = w; }
    }
}

__device__ __forceinline__ void weight_filler(const Ctx& F, const int which, const int k_lo, const int k_hi) {
    LAS float* scr = (LAS float*)(F.lds + F.wave * 16384);
    const int gw = F.bid * 8 + F.wave, NGW = F.G * 8;
    if (k_lo >= k_hi) return;
    if (which == 0) {
        for (int r = gw + k_lo * NGW; r < 8192 && r < gw + k_hi * NGW; r += NGW) { const int e = r >> 9, q = r & 511, kb = q >> 4, nb = q & 15;
            transpose_item8(F.w_down + (size_t)e * DFF * D, D, 64 * kb, 64 * nb, (unsigned char*)(F.ws + WS_WD) + (size_t)e * D * DFF, (size_t)(64 * nb), DFF, scr, F.lane); }
    } else {
        unsigned char* WG = (unsigned char*)(F.ws + WS_WGU);
        for (int it = gw + (which - 1) * 8192 + k_lo * NGW; it < which * 8192 && it < gw + (which - 1) * 8192 + k_hi * NGW; it += NGW) {
            const int e = it >> 10, src = (it >> 9) & 1, q = it & 511, kb = q >> 5, nb = q & 31;
            const int f0 = 64 * nb; const size_t dst_row0 = (size_t)e * 4096 + (size_t)(f0 >> 7) * 256 + (src ? 128 : 0) + (f0 & 127);
            transpose_item8((src ? F.w_up : F.w_gate) + (size_t)e * D * DFF, DFF, 64 * kb, f0, WG, dst_row0, D, scr, F.lane);
        }
    }
    __syncthreads();
}

__device__ __forceinline__ void p0_prep(const Ctx& F, const int parts) {
    LAS float* scr = (LAS float*)(F.lds + F.wave * 16384);
    LAS float* tab128 = (LAS float*)(F.lds + LDS_X_OFF);
    if (F.tid < 128) tab128[F.tid] = cospif((float)F.tid * (1.0f / 64.0f));
    __syncthreads();
    const int gw = F.bid * 8 + F.wave, NGW = F.G * 8;
    bf16_t* WinT = (bf16_t*)(F.ws + WS_WIN);
    if (parts & 1) {
        constexpr int I1 = 16 * 56, I2 = 8 * 16, I3 = 8 * 16, I4 = 16 * 16;
        constexpr int NIT = I1 + I2 + I3 + I4;
        for (int it = gw; it < NIT; it += NGW) {
            int r = it;
            if (r < I1) { const int kb = r / 56, nb = r % 56;
                size_t drow = (size_t)(64 * nb); if (nb >= 24) { const int c = 64 * nb - 1536, cc = c & 1023; drow = (size_t)(1536 + (cc >> 7) * 256 + (c >= 1024 ? 128 : 0) + (cc & 127)); }
                transpose_item(F.w_in, INW, 64 * kb, 64 * nb, WinT, drow, D, scr, F.lane); continue; } r -= I1;
            if (r < I2) { const int kb = r / 16, nb = r % 16; transpose_item(F.w_fo, D, 64 * kb, 64 * nb, (bf16_t*)(F.ws + WS_WFO), (size_t)(64 * nb), FW, scr, F.lane); continue; } r -= I2;
            if (r < I3) { const int kb = r / 16, nb = r % 16; transpose_item(F.w_so, D, 64 * kb, 64 * nb, (bf16_t*)(F.ws + WS_WSO), (size_t)(64 * nb), SWD, scr, F.lane); continue; } r -= I3;
            { const int kb = r / 16, nb = r % 16; transpose_item(F.w_out, D, 64 * kb, 64 * nb, (bf16_t*)(F.ws + WS_WOUT), (size_t)(64 * nb), D, scr, F.lane); }
        }
    }
    if (parts & 4) {
        bf16_t* HN = (bf16_t*)(F.ws + WS_HN);
        f32x4 gg[4];
#pragma unroll
        for (int j = 0; j < 4; ++j) gg[j] = ((const f32x4*)F.norm1_g)[64 * j + F.lane];
        for (int m4 = gw; m4 < MTOK / 4; m4 += NGW) rms_rows4_to_bf16(F.x + (size_t)m4 * 4 * D, gg, HN + (size_t)m4 * 4 * D, F.lane);
    }
    if (parts & 8) {
        bf16_t* MA = (bf16_t*)(F.ws + WS_MA); bf16_t* MB = (bf16_t*)(F.ws + WS_MB);
        const int gt = F.bid * 512 + F.tid, NT = F.G * 512;
        for (int i = gt; i < 32 * 4 * 16; i += NT) {
            const int e = i & 15, kg = (i >> 4) & 3, ks = i >> 6; const int d0 = 32 * ks + 8 * kg;
            bf16x8 hi, lo;
#pragma unroll
            for (int j = 0; j < 8; ++j) { const float w = F.norm2_g[d0 + j] * F.w_router[(size_t)(d0 + j) * 16 + e]; const unsigned h = f2bf(w); hi[j] = (short)h; lo[j] = (short)f2bf(w - __builtin_bit_cast(float, h << 16)); }
            ((bf16x8*)(F.ws + WS_WRT))[i] = hi; ((bf16x8*)(F.ws + WS_WRT))[2048 + i] = lo;
        }
        for (int i = gt; i < 256 * 128; i += NT) {
            const int jp = i >> 7, c = i & 127; const float a = (float)(((jp & 127) * c) & 127) * (1.0f / 64.0f);
            ((bf16_t*)(F.ws + WS_CST))[i] = (bf16_t)f2bf((jp < 128 ? cospif(a) : sinpif(a)) * 0.08838834764831845f);
        }
        for (int q = gt; q < 128 * 128 + 64 * 128; q += NT) {
            if (q < 128 * 128) { const int o = q >> 7, k = q & 127, kl = o >> 1, ri = o & 1, sh = k >> 1, half = k & 1; const float a = (float)((kl * sh) & 63) * (1.0f / 32.0f);
                const float C = cospif(a), S = sinpif(a); const float v = (ri == 0) ? (half == 0 ? C : -S) : (half == 0 ? -S : -C); MA[q] = (bf16_t)f2bf(v * 0.125f); }
            else { const int qq = q - 128 * 128, kh = qq >> 7, k = qq & 127, sl = k >> 1, ri = k & 1; const float a = (float)((kh * sl) & 63) * (1.0f / 32.0f);
                MB[qq] = (bf16_t)f2bf((ri == 0 ? cospif(a) : sinpif(a)) * 0.125f); }
        }
    }
}

struct Sched1 {
    const char* A; const char* B; int G, c;
    __device__ __forceinline__ bool next(int i, Unit& u) const {
        int pm, pn; if (!pg8::static_tile(MTOK / 256, N1 / 256, G, c, i, pm, pn)) return false;
        u.A = A + (size_t)pm * 256 * D * 2; u.B = B + (size_t)pn * 256 * D * 2; u.ridx = nullptr; u.pm = pm; u.pn = pn; u.kind = 0; return true;
    }
};
struct Epi1 {
    static constexpr bool PERM = true;
    unsigned char* ws;
    __device__ __forceinline__ bool operator()(f32x4 (&acc)[2][2][4][2], const Unit& u, int wr, int wc, int fr, int fq) const {
        const int pn = u.pn;
        if (pn < 2) {
            bf16_t* Z = (bf16_t*)(ws + WS_YF);
            const int b = u.pm >> 4;
#pragma unroll
            for (int ai = 0; ai < 2; ++ai)
#pragma unroll
                for (int m = 0; m < 4; ++m) { const int s_lo = m * 16 + fr, s_hi = (u.pm & 15) * 4 + ai * 2 + wr;
#pragma unroll
                    for (int bj = 0; bj < 2; ++bj) { const f32x4 v0 = acc[ai][bj][m][0], v1 = acc[ai][bj][m][1];
                        u32x4 w; w.x = cvt_pk_bf16(v0[0], v0[1]); w.y = cvt_pk_bf16(v0[2], v0[3]); w.z = cvt_pk_bf16(v1[0], v1[1]); w.w = cvt_pk_bf16(v1[2], v1[3]);
                        *(u32x4*)(Z + ((size_t)((b * 4 + 2 * pn + bj) * 64 + s_lo) * 64 + s_hi) * 128 + wc * 32 + 8 * fq) = w; } }
            return false;
        }
        const int row0 = u.pm * 256 + wr * 64 + fr;
        if (pn >= 6) {
            bf16_t* RHO = (bf16_t*)(ws + WS_SGF); bf16_t* SGS = (bf16_t*)(ws + WS_SGS);
            const int col0 = (pn - 6) * 128 + wc * 32 + 8 * fq;
#pragma unroll
            for (int ai = 0; ai < 2; ++ai)
#pragma unroll
                for (int m = 0; m < 4; ++m) { const size_t off = (size_t)(row0 + ai * 128 + m * 16) * 1024 + col0;
                    float rho[8], sg[8];
#pragma unroll
                    for (int n = 0; n < 2; ++n)
#pragma unroll
                        for (int j = 0; j < 4; ++j) { const float ef = __builtin_amdgcn_exp2f(-1.44269504089f * acc[ai][0][m][n][j]), es = __builtin_amdgcn_exp2f(-1.44269504089f * acc[ai][1][m][n][j]);
                            const float s_ = __builtin_amdgcn_rcpf(1.0f + es); sg[n * 4 + j] = s_; rho[n * 4 + j] = (1.0f + es) * __builtin_amdgcn_rcpf(1.0f + ef); }
                    u32x4 w; w.x = cvt_pk_bf16(rho[0], rho[1]); w.y = cvt_pk_bf16(rho[2], rho[3]); w.z = cvt_pk_bf16(rho[4], rho[5]); w.w = cvt_pk_bf16(rho[6], rho[7]);
                    *(u32x4*)(RHO + off) = w;
                    w.x = cvt_pk_bf16(sg[0], sg[1]); w.y = cvt_pk_bf16(sg[2], sg[3]); w.z = cvt_pk_bf16(sg[4], sg[5]); w.w = cvt_pk_bf16(sg[6], sg[7]);
                    *(u32x4*)(SGS + off) = w; }
            return false;
        }
        bf16_t* base = (bf16_t*)(ws + (pn < 4 ? WS_GU : WS_GV)); const int colt = (pn & 1) * 256;
        const int col0 = colt + wc * 32 + 8 * fq;
#pragma unroll
        for (int ai = 0; ai < 2; ++ai)
#pragma unroll
            for (int m = 0; m < 4; ++m) { bf16_t* rowp = base + (size_t)(row0 + ai * 128 + m * 16) * 512 + col0;
#pragma unroll
                for (int bj = 0; bj < 2; ++bj) { f32x4 v0 = acc[ai][bj][m][0], v1 = acc[ai][bj][m][1];
#pragma unroll
                    for (int j = 0; j < 4; ++j) { v0[j] = gelu_tanh(v0[j]); v1[j] = gelu_tanh(v1[j]); }
                    u32x4 w; w.x = cvt_pk_bf16(v0[0], v0[1]); w.y = cvt_pk_bf16(v0[2], v0[3]); w.z = cvt_pk_bf16(v1[0], v1[1]); w.w = cvt_pk_bf16(v1[2], v1[3]);
                    *(u32x4*)(rowp + bj * 128) = w; } }
        return false;
    }
};

__device__ __forceinline__ void p2_sgu(const Ctx& F) {
    constexpr int PITCH = 136;
    LAS bf16_t* Ws = (LAS bf16_t*)(F.lds);
    LAS bf16_t* Vt = (LAS bf16_t*)(F.lds + 128 * PITCH * 2);
    const bf16_t* GU = (const bf16_t*)(F.ws + WS_GU); const bf16_t* GV = (const bf16_t*)(F.ws + WS_GV); bf16_t* SG = (bf16_t*)(F.ws + WS_SG);
    const int lane = F.lane, wave = F.wave, cp = lane & 15, rs4 = lane >> 4;
    int h_loaded = -1;
    u32x4 raw[4];
    if (F.bid < 1024) { const int h = F.bid & 3; const size_t r0 = (size_t)(F.bid >> 2) * 128;
#pragma unroll
        for (int i = 0; i < 4; ++i) raw[i] = *(const u32x4*)(GV + (r0 + wave * 16 + i * 4 + rs4) * 512 + h * 128 + 8 * cp); }
    for (int tt = F.bid; tt < 1024; tt += F.G) {
        const int h = tt & 3, bn = tt >> 2; const size_t r0 = (size_t)bn * 128;
        __syncthreads();
        if (h != h_loaded) {
            const float* wsrc = F.w_sp + (size_t)h * 128 * 128;
#pragma unroll
            for (int i = 0; i < 8; ++i) { const int idx = F.tid * 4 + i * 2048; const int p = idx >> 7, q = idx & 127; const f32x4 v = *(const f32x4*)(wsrc + idx);
                u32x2 w; w.x = pk2(v.x, v.y); w.y = pk2(v.z, v.w); *(LAS u32x2*)(Ws + p * PITCH + q) = w; }
            h_loaded = h;
        }
        { const f32x4 g0v = *(const f32x4*)(F.ln_g + h * 128 + 8 * cp), g1v = *(const f32x4*)(F.ln_g + h * 128 + 8 * cp + 4), b0v = *(const f32x4*)(F.ln_b + h * 128 + 8 * cp), b1v = *(const f32x4*)(F.ln_b + h * 128 + 8 * cp + 4);
#pragma unroll
          for (int i = 0; i < 4; ++i) { const int q = wave * 16 + i * 4 + rs4;
              float x[8] = {bf_lo(raw[i].x), bf_hi(raw[i].x), bf_lo(raw[i].y), bf_hi(raw[i].y), bf_lo(raw[i].z), bf_hi(raw[i].z), bf_lo(raw[i].w), bf_hi(raw[i].w)};
              float sm = ((x[0] + x[1]) + (x[2] + x[3])) + ((x[4] + x[5]) + (x[6] + x[7]));
#pragma unroll
              for (int o = 1; o < 16; o <<= 1) sm += __shfl_xor(sm, o);
              const float mu = sm * (1.0f / 128.0f); float sq = 0.f;
#pragma unroll
              for (int j = 0; j < 8; ++j) { x[j] -= mu; sq += x[j] * x[j]; }
#pragma unroll
              for (int o = 1; o < 16; o <<= 1) sq += __shfl_xor(sq, o);
              const float rs = 1.0f / sqrtf(sq * (1.0f / 128.0f) + EPS);
              const float gq[8] = {g0v.x, g0v.y, g0v.z, g0v.w, g1v.x, g1v.y, g1v.z, g1v.w}, bq[8] = {b0v.x, b0v.y, b0v.z, b0v.w, b1v.x, b1v.y, b1v.z, b1v.w};
#pragma unroll
              for (int j = 0; j < 8; ++j) Vt[(8 * cp + j) * PITCH + (q ^ (cp << 3))] = (bf16_t)f2bf(x[j] * rs * gq[j] + bq[j]); } }
        const int p = wave * 16 + (lane & 15);
        u32x2 uu[8];
#pragma unroll
        for (int ct = 0; ct < 8; ++ct) uu[ct] = *(const u32x2*)(GU + (r0 + p) * 512 + h * 128 + ct * 16 + 4 * (lane >> 4));
        if (tt + F.G < 1024) { const int tn = tt + F.G, hn = tn & 3; const size_t rn = (size_t)(tn >> 2) * 128;
#pragma unroll
            for (int i = 0; i < 4; ++i) raw[i] = *(const u32x4*)(GV + (rn + wave * 16 + i * 4 + rs4) * 512 + hn * 128 + 8 * cp); }
        __syncthreads();
        f32x4 acc[8];
#pragma unroll
        for (int ct = 0; ct < 8; ++ct) acc[ct] = (f32x4){0.f, 0.f, 0.f, 0.f};
#pragma unroll
        for (int ks = 0; ks < 4; ++ks) {
            const bf16x8 bw = *(const LAS bf16x8*)(Ws + (wave * 16 + (lane & 15)) * PITCH + ks * 32 + 8 * (lane >> 4));
#pragma unroll
            for (int ct = 0; ct < 8; ++ct) { const int c_ = ct * 16 + (lane & 15); const bf16x8 av = *(const LAS bf16x8*)(Vt + c_ * PITCH + ((ks * 32 + 8 * (lane >> 4)) ^ (((c_ >> 3) & 15) << 3)));
                acc[ct] = __builtin_amdgcn_mfma_f32_16x16x32_bf16(av, bw, acc[ct], 0, 0, 0); }
        }
        const float bs = F.b_sp[h * 128 + p];
#pragma unroll
        for (int ct = 0; ct < 8; ++ct) { const size_t off = (r0 + p) * 512 + h * 128 + ct * 16 + 4 * (lane >> 4);
            u32x2 o; o.x = pk2(bf_lo(uu[ct].x) * (acc[ct][0] + bs), bf_hi(uu[ct].x) * (acc[ct][1] + bs)); o.y = pk2(bf_lo(uu[ct].y) * (acc[ct][2] + bs), bf_hi(uu[ct].y) * (acc[ct][3] + bs));
            *(u32x2*)(SG + off) = o; }
    }
    __syncthreads();
}

typedef short s16x4 __attribute__((ext_vector_type(4)));
template <int STAGE>
__device__ __forceinline__ void fft_stage(const Ctx& F) {
    constexpr int OPITCH = 272;
    constexpr int OBYTES = 128 * OPITCH;
    constexpr int IMG = (STAGE == 0) ? 16384 : 32768;
    constexpr int NDMA = IMG / 8192;
    LAS unsigned char* lds = F.lds;
    const int lane = F.lane, wave = F.wave, tid = F.tid, l15 = lane & 15;
    const int G = lane >> 4, q = (lane >> 2) & 3, p = lane & 3, fsw = q | ((G & 1) << 2);
    const bf16_t* MAT = (const bf16_t*)(F.ws + (STAGE == 0 ? WS_MA : WS_MB));
    const bf16_t* SRC = (const bf16_t*)(F.ws + (STAGE == 0 ? WS_YF : WS_AP));
    const int mt = (STAGE == 0) ? wave : (wave & 3);
    constexpr int NJT = (STAGE == 0) ? 8 : 4;
    const int jt0 = (STAGE == 0) ? 0 : 4 * (wave >> 2);
    bf16x8 afr[4];
#pragma unroll
    for (int ks = 0; ks < 4; ++ks) afr[ks] = *(const bf16x8*)(MAT + (size_t)(mt * 16 + l15) * 128 + ks * 32 + 8 * G);
    bf16x8 bcs[2][4];
    if constexpr (STAGE == 0) {
#pragma unroll
        for (int t2 = 0; t2 < 2; ++t2)
#pragma unroll
            for (int ks = 0; ks < 4; ++ks) bcs[t2][ks] = *(const bf16x8*)((const bf16_t*)(F.ws + WS_CST) + (size_t)(16 * (2 * wave + t2) + l15) * 128 + ks * 32 + 8 * G);
    }
    unsigned soff[NDMA];
#pragma unroll
    for (int i = 0; i < NDMA; ++i) { const int pos = i * 512 + tid, row = pos >> 4, cp = pos & 15; const int f = (row & 3) | (((row >> 3) & 1) << 2);
        soff[i] = (unsigned)(row * 256 + ((STAGE == 0 ? (cp ^ (row & 15)) : (cp ^ (f << 1))) << 4)); }
    const unsigned rbase = (unsigned)((8 * G + q) * 256 + p * 8);
#define FFT_DMA(buf, t) do { const char* src_ = (const char*)SRC + (size_t)(t) * IMG; _Pragma("unroll") for (int i_ = 0; i_ < NDMA; ++i_) \
        __builtin_amdgcn_global_load_lds((const unsigned*)(src_ + soff[i_]), (LAS unsigned*)(lds + (buf) * IMG + i_ * 8192 + wave * 1024), 16, 0, 0); } while (0)
#define FFT_STORE(tp, ob) do { const int bg_ = (tp) >> 6, lo6_ = (tp) & 63; \
        if constexpr (STAGE == 0) { bf16_t* AP = (bf16_t*)(F.ws + WS_AP); _Pragma("unroll") for (int i_ = 0; i_ < 4; ++i_) { const int id_ = tid + 512 * i_, row_ = id_ >> 4, c_ = id_ & 15; \
                const u32x4 v_ = *(const LAS u32x4*)((ob) + row_ * OPITCH + c_ * 16); \
                *(u32x4*)(AP + ((size_t)(bg_ * 64 + (row_ >> 1)) * 64 + lo6_) * 256 + (row_ & 1) * 128 + c_ * 8) = v_; } } \
        else { bf16_t* FM = (bf16_t*)(F.ws + WS_FM); _Pragma("unroll") for (int i_ = 0; i_ < 2; ++i_) { const int id_ = tid + 512 * i_, row_ = id_ >> 4, c_ = id_ & 15; \
                const u32x4 v_ = *(const LAS u32x4*)((ob) + row_ * OPITCH + c_ * 16); \
                *(u32x4*)(FM + ((size_t)(bg_ >> 2) * SEQ + lo6_ + 64 * row_) * FW + (bg_ & 3) * 128 + c_ * 8) = v_; } } } while (0)
    int t = F.bid, buf = 0, tprev = -1;
    if (t < 2048) FFT_DMA(0, t);
    for (; t < 2048; tprev = t, t += F.G, buf ^= 1) {
        asm volatile("s_waitcnt vmcnt(0) lgkmcnt(0)" ::: "memory");
        __builtin_amdgcn_s_barrier();
        asm volatile("" ::: "memory");
        if (t + F.G < 2048) FFT_DMA(buf ^ 1, t + F.G);
        if (tprev >= 0) FFT_STORE(tprev, lds + 65536 + (buf ^ 1) * OBYTES);
        const LAS unsigned char* xb;
        if constexpr (STAGE == 0) {
            const LAS unsigned char* zb = lds + buf * IMG;
            f32x4 a1[4][2];
#pragma unroll
            for (int st = 0; st < 4; ++st) { a1[st][0] = (f32x4){0.f, 0.f, 0.f, 0.f}; a1[st][1] = (f32x4){0.f, 0.f, 0.f, 0.f}; }
#pragma unroll
            for (int ks = 0; ks < 4; ++ks)
#pragma unroll
                for (int st = 0; st < 4; ++st) { const bf16x8 az = *(const LAS bf16x8*)(zb + (16 * st + l15) * 256 + (((4 * ks + G) ^ l15) << 4));
                    a1[st][0] = __builtin_amdgcn_mfma_f32_16x16x32_bf16(az, bcs[0][ks], a1[st][0], 0, 0, 0);
                    a1[st][1] = __builtin_amdgcn_mfma_f32_16x16x32_bf16(az, bcs[1][ks], a1[st][1], 0, 0, 0); }
            LAS unsigned char* xw = lds + 32768;
#pragma unroll
            for (int t2 = 0; t2 < 2; ++t2) { const int jt = 2 * wave + t2, half = jt >> 3, j = 16 * (jt & 7) + l15;
#pragma unroll
                for (int st = 0; st < 4; ++st)
#pragma unroll
                    for (int r = 0; r < 4; ++r) { const int k = 2 * (16 * st + 4 * G + r) + half; const int f = (k & 3) | (((k >> 3) & 1) << 2);
                        *(LAS bf16_t*)(xw + k * 256 + ((((j >> 3) ^ (f << 1))) << 4) + (j & 7) * 2) = (bf16_t)f2bf(a1[st][t2][r]); } }
            asm volatile("s_waitcnt lgkmcnt(0)" ::: "memory");
            __builtin_amdgcn_s_barrier();
            asm volatile("" ::: "memory");
            xb = lds + 32768 + rbase;
        } else {
            xb = lds + buf * IMG + rbase;
        }
        f32x4 acc[NJT];
#pragma unroll
        for (int jt = 0; jt < NJT; ++jt) acc[jt] = (f32x4){0.f, 0.f, 0.f, 0.f};
#pragma unroll
        for (int ks = 0; ks < 4; ++ks)
#pragma unroll
            for (int jt = 0; jt < NJT; ++jt) {
                const unsigned o = (unsigned)(ks * 32 * 256) + ((unsigned)(((jt0 + jt) ^ fsw)) << 5);
                const s16x4 lo = __builtin_amdgcn_ds_read_tr16_b64_v4i16((LAS s16x4*)(xb + o));
                const s16x4 hi = __builtin_amdgcn_ds_read_tr16_b64_v4i16((LAS s16x4*)(xb + o + 4 * 256));
                bf16x8 bfr; bfr[0] = lo[0]; bfr[1] = lo[1]; bfr[2] = lo[2]; bfr[3] = lo[3]; bfr[4] = hi[0]; bfr[5] = hi[1]; bfr[6] = hi[2]; bfr[7] = hi[3];
                acc[jt] = __builtin_amdgcn_mfma_f32_16x16x32_bf16(afr[ks], bfr, acc[jt], 0, 0, 0);
            }
        LAS unsigned char* ob = lds + 65536 + buf * OBYTES;
        if constexpr (STAGE == 0) {
            const int s_lo = t & 63, kl0 = 8 * wave + 2 * G;
            float c0, s0, c1, s1;
            sincospif((float)((kl0 * s_lo) & 4095) * (1.0f / 2048.0f), &s0, &c0);
            sincospif((float)(((kl0 + 1) * s_lo) & 4095) * (1.0f / 2048.0f), &s1, &c1);
#pragma unroll
            for (int jt = 0; jt < NJT; ++jt) { const f32x4 a = acc[jt]; const int col = 16 * jt + l15;
                LAS bf16_t* o0 = (LAS bf16_t*)(ob + (mt * 16 + 4 * G) * OPITCH) + col;
                o0[0 * (OPITCH / 2)] = (bf16_t)f2bf(a[0] * c0 + a[1] * s0); o0[1 * (OPITCH / 2)] = (bf16_t)f2bf(a[1] * c0 - a[0] * s0);
                o0[2 * (OPITCH / 2)] = (bf16_t)f2bf(a[2] * c1 + a[3] * s1); o0[3 * (OPITCH / 2)] = (bf16_t)f2bf(a[3] * c1 - a[2] * s1); }
        } else {
#pragma unroll
            for (int jt = 0; jt < NJT; ++jt) { const f32x4 a = acc[jt]; const int col = 16 * (jt0 + jt) + l15;
                LAS bf16_t* o0 = (LAS bf16_t*)(ob + (mt * 16 + 4 * G) * OPITCH) + col;
#pragma unroll
                for (int r = 0; r < 4; ++r) o0[r * (OPITCH / 2)] = (bf16_t)f2bf(a[r]); }
        }
    }
    asm volatile("s_waitcnt lgkmcnt(0)" ::: "memory");
    __builtin_amdgcn_s_barrier();
    asm volatile("" ::: "memory");
    if (tprev >= 0) FFT_STORE(tprev, lds + 65536 + (buf ^ 1) * OBYTES);
    asm volatile("s_waitcnt vmcnt(0) lgkmcnt(0)" ::: "memory");
    __builtin_amdgcn_s_barrier();
#undef FFT_STORE
#undef FFT_DMA
}

struct Sched3 {
    const char* A0; const char* A1; const char* B0; const char* B1; int G, c;
    __device__ __forceinline__ bool next(int i, Unit& u) const {
        int pm, pn; if (!pg8::static_tile(MTOK / 256, D / 256, G, c, i >> 1, pm, pn)) return false;
        const int sub = i & 1;
        u.A = (sub ? A1 : A0) + (size_t)pm * 256 * 512 * 2; u.B = (sub ? B1 : B0) + (size_t)pn * 256 * 512 * 2; u.ridx = nullptr; u.pm = pm; u.pn = pn; u.kind = sub; return true;
    }
};
struct Epi3 {
    static constexpr bool PERM = true;
    const bf16_t* RHO; const bf16_t* SGS; bf16_t* MRG;
    __device__ __forceinline__ bool operator()(f32x4 (&acc)[2][2][4][2], const Unit& u, int wr, int wc, int fr, int fq) const {
        const int row0 = u.pm * 256 + wr * 64 + fr, col0 = u.pn * 256 + wc * 32 + 8 * fq;
        const bf16_t* G = (u.kind == 0) ? RHO : SGS;
        u32x4 g[2][4][2];
#pragma unroll
        for (int ai = 0; ai < 2; ++ai)
#pragma unroll
            for (int m = 0; m < 4; ++m)
#pragma unroll
                for (int bj = 0; bj < 2; ++bj) g[ai][m][bj] = *(const u32x4*)(G + (size_t)(row0 + ai * 128 + m * 16) * D + col0 + bj * 128);
#pragma unroll
        for (int ai = 0; ai < 2; ++ai)
#pragma unroll
            for (int m = 0; m < 4; ++m)
#pragma unroll
                for (int bj = 0; bj < 2; ++bj) { const u32x4 s = g[ai][m][bj]; f32x4& v0 = acc[ai][bj][m][0]; f32x4& v1 = acc[ai][bj][m][1];
                    v0[0] *= bf_lo(s.x); v0[1] *= bf_hi(s.x); v0[2] *= bf_lo(s.y); v0[3] *= bf_hi(s.y); v1[0] *= bf_lo(s.z); v1[1] *= bf_hi(s.z); v1[2] *= bf_lo(s.w); v1[3] *= bf_hi(s.w);
                    if (u.kind != 0) { u32x4 w; w.x = cvt_pk_bf16(v0[0], v0[1]); w.y = cvt_pk_bf16(v0[2], v0[3]); w.z = cvt_pk_bf16(v1[0], v1[1]); w.w = cvt_pk_bf16(v1[2], v1[3]);
                        *(u32x4*)(MRG + (size_t)(row0 + ai * 128 + m * 16) * D + col0 + bj * 128) = w; } }
        return u.kind == 0;
    }
};

struct Sched4 {
    const char* A; const char* B; int G, c;
    __device__ __forceinline__ bool next(int i, Unit& u) const {
        int pm, pn; if (!pg8::static_tile(MTOK / 256, D / 256, G, c, i, pm, pn)) return false;
        u.A = A + (size_t)pm * 256 * D * 2; u.B = B + (size_t)pn * 256 * D * 2; u.ridx = nullptr; u.pm = pm; u.pn = pn; u.kind = 0; return true;
    }
};
struct Epi4 {
    static constexpr bool PERM = true;
    bf16_t* DLT;
    __device__ __forceinline__ bool operator()(f32x4 (&acc)[2][2][4][2], const Unit& u, int wr, int wc, int fr, int fq) const {
        const int row0 = u.pm * 256 + wr * 64 + fr, col0 = u.pn * 256 + wc * 32 + 8 * fq;
#pragma unroll
        for (int ai = 0; ai < 2; ++ai)
#pragma unroll
            for (int m = 0; m < 4; ++m) { bf16_t* rowp = DLT + (size_t)(row0 + ai * 128 + m * 16) * D + col0;
#pragma unroll
                for (int bj = 0; bj < 2; ++bj) { const f32x4 v0 = acc[ai][bj][m][0], v1 = acc[ai][bj][m][1];
                    u32x4 w; w.x = cvt_pk_bf16(v0[0], v0[1]); w.y = cvt_pk_bf16(v0[2], v0[3]); w.z = cvt_pk_bf16(v1[0], v1[1]); w.w = cvt_pk_bf16(v1[2], v1[3]);
                    *(u32x4*)(rowp + bj * 128) = w; } }
        return false;
    }
};

__device__ __forceinline__ void p5_rows(const Ctx& F, const int parts) {
    LAS float* scr = (LAS float*)(F.lds + F.wave * 16384);
    const int gw = F.bid * 8 + F.wave, NGW = F.G * 8;
    if (!(parts & 2)) return;
    LAS bf16x8* WB = (LAS bf16x8*)F.lds;
    LAS float* G2L = (LAS float*)(F.lds + 65536);
    for (int i = F.tid; i < 4096; i += 512) WB[i] = ((const bf16x8*)(F.ws + WS_WRT))[i];
    for (int i = F.tid; i < 256; i += 512) ((LAS f32x4*)G2L)[i] = ((const f32x4*)F.norm2_g)[i];
    __syncthreads();
    const float* X1 = F.x; const bf16_t* DLT = (const bf16_t*)(F.ws + WS_DLT); unsigned char* H2 = (unsigned char*)(F.ws + WS_H2); float* AFF = (float*)(F.ws + WS_AFF); float* RSTD = (float*)(F.ws + WS_RSTD);
    const int lane = F.lane, row = lane & 15, kg = lane >> 4;
    for (int task = gw; task < MTOK / 16; task += NGW) {
        const size_t r0 = (size_t)task * 16;
        const float* xp = X1 + (r0 + row) * D + 8 * kg; const bf16_t* dp = DLT + (r0 + row) * D + 8 * kg;
        unsigned char* hp = H2 + (r0 + row) * D + 8 * kg;
        f32x4 acc = (f32x4){0.f, 0.f, 0.f, 0.f}; float ss = 0.f;
#pragma unroll 1
        for (int kc = 0; kc < 4; ++kc) {
            f32x4 xa[8], xb[8]; u32x4 dd[8];
#pragma unroll
            for (int u = 0; u < 8; ++u) { xa[u] = *(const f32x4*)(xp + (kc * 8 + u) * 32); xb[u] = *(const f32x4*)(xp + (kc * 8 + u) * 32 + 4); dd[u] = *(const u32x4*)(dp + (kc * 8 + u) * 32); }
#pragma unroll
            for (int u = 0; u < 8; ++u) {
                const int ks = kc * 8 + u;
                const f32x4 a = xa[u] + (f32x4){bf_lo(dd[u].x), bf_hi(dd[u].x), bf_lo(dd[u].y), bf_hi(dd[u].y)}, b = xb[u] + (f32x4){bf_lo(dd[u].z), bf_hi(dd[u].z), bf_lo(dd[u].w), bf_hi(dd[u].w)};
                ss += (a.x * a.x + a.y * a.y) + (a.z * a.z + a.w * a.w) + (b.x * b.x + b.y * b.y) + (b.z * b.z + b.w * b.w);
                const f32x4 ga = *(const LAS f32x4*)(G2L + 32 * ks + 8 * kg), gb = *(const LAS f32x4*)(G2L + 32 * ks + 8 * kg + 4);
                u32x2 h8; h8.x = pk4_fp8(a.x * ga.x, a.y * ga.y, a.z * ga.z, a.w * ga.w); h8.y = pk4_fp8(b.x * gb.x, b.y * gb.y, b.z * gb.z, b.w * gb.w);
                *(u32x2*)(hp + 32 * ks) = h8;
                u32x4 hw, lw;
                hw.x = cvt_pk_bf16(a.x, a.y); hw.y = cvt_pk_bf16(a.z, a.w); hw.z = cvt_pk_bf16(b.x, b.y); hw.w = cvt_pk_bf16(b.z, b.w);
                lw.x = cvt_pk_bf16(a.x - bf_lo(hw.x), a.y - bf_hi(hw.x)); lw.y = cvt_pk_bf16(a.z - bf_lo(hw.y), a.w - bf_hi(hw.y));
                lw.z = cvt_pk_bf16(b.x - bf_lo(hw.z), b.y - bf_hi(hw.z)); lw.w = cvt_pk_bf16(b.z - bf_lo(hw.w), b.w - bf_hi(hw.w));
                const bf16x8 xh = __builtin_bit_cast(bf16x8, hw), xl = __builtin_bit_cast(bf16x8, lw);
                const bf16x8 wh = WB[(ks * 4 + kg) * 16 + row], wl = WB[2048 + (ks * 4 + kg) * 16 + row];
                acc = __builtin_amdgcn_mfma_f32_16x16x32_bf16(xh, wh, acc, 0, 0, 0);
                acc = __builtin_amdgcn_mfma_f32_16x16x32_bf16(xl, wh, acc, 0, 0, 0);
                acc = __builtin_amdgcn_mfma_f32_16x16x32_bf16(xh, wl, acc, 0, 0, 0);
            }
        }
        ss += __shfl_xor(ss, 16); ss += __shfl_xor(ss, 32);
        const float rstd = 1.0f / sqrtf(ss * (1.f / D) + EPS);
        if (kg == 0) RSTD[r0 + row] = rstd;
#pragma unroll
        for (int r = 0; r < 4; ++r) {
            const float lg = acc[r] * __shfl(rstd, 4 * kg + r);
            float mx = lg;
#pragma unroll
            for (int o = 1; o < 16; o <<= 1) mx = fmaxf(mx, __shfl_xor(mx, o));
            const float pe = __expf(lg - mx); float den = pe;
#pragma unroll
            for (int o = 1; o < 16; o <<= 1) den += __shfl_xor(den, o);
            AFF[(r0 + 4 * kg + r) * 16 + row] = pe / den;
        }
    }
    __syncthreads();
}

__device__ __forceinline__ void p6_topk(const Ctx& F) {
    LAS unsigned* cnt = (LAS unsigned*)F.lds;
    const float* AFF = (const float*)(F.ws + WS_AFF);
    int* IDX = (int*)(F.ws + WS_IDX); float* GATE = (float*)(F.ws + WS_GATE); unsigned short* INV = (unsigned short*)(F.ws + WS_INV);
    const int lane = F.lane, wave = F.wave, tid = F.tid;
    for (int item = F.bid; item < NB * NE; item += F.G) {
        const int b = item >> 4, e = item & 15;
        unsigned key[8];
#pragma unroll
        for (int i = 0; i < 8; ++i) key[i] = __builtin_bit_cast(unsigned, AFF[((size_t)b * SEQ + 8 * tid + i) * 16 + e]);
        __syncthreads();
        unsigned T = 0u;
        for (int bit = 30; bit >= 0; --bit) {
            const unsigned cand = T | (1u << bit);
            unsigned c = 0;
#pragma unroll
            for (int i = 0; i < 8; ++i) c += (unsigned)__popcll(__ballot(key[i] >= cand));
            LAS unsigned* cb = cnt + (bit & 1) * 8;
            if (lane == 0) cb[wave] = c;
            __syncthreads();
            unsigned tot = 0;
#pragma unroll
            for (int w = 0; w < 8; ++w) tot += cb[w];
            if (tot >= (unsigned)CAP) T = cand;
        }
        __syncthreads();
        unsigned ngt_w = 0;
        int neq_t = 0;
#pragma unroll
        for (int i = 0; i < 8; ++i) { ngt_w += (unsigned)__popcll(__ballot(key[i] > T)); neq_t += (key[i] == T) ? 1 : 0; }
        LAS unsigned* sc = cnt + 16;
        int incl = neq_t;
#pragma unroll
        for (int o = 1; o < 64; o <<= 1) { const int t = __shfl_up(incl, o); if (lane >= o) incl += t; }
        if (lane == 63) sc[wave] = (unsigned)incl;
        if (lane == 0) sc[16 + wave] = ngt_w;
        __syncthreads();
        unsigned eq_base = 0, ngt = 0;
#pragma unroll
        for (int w = 0; w < 8; ++w) { eq_base += (w < wave) ? sc[w] : 0u; ngt += sc[16 + w]; }
        const int need = CAP - (int)ngt;
        int eq_rank = (int)eq_base + incl - neq_t;
        unsigned selm = 0; int nsel = 0;
#pragma unroll
        for (int i = 0; i < 8; ++i) { bool s = key[i] > T; if (key[i] == T) { s = eq_rank < need; ++eq_rank; } if (s) { selm |= 1u << i; ++nsel; } }
        int incl2 = nsel;
#pragma unroll
        for (int o = 1; o < 64; o <<= 1) { const int t = __shfl_up(incl2, o); if (lane >= o) incl2 += t; }
        if (lane == 63) sc[8 + wave] = (unsigned)incl2;
        __syncthreads();
        unsigned sbase = 0;
#pragma unroll
        for (int w = 0; w < 8; ++w) sbase += (w < wave) ? sc[8 + w] : 0u;
        int slot = (int)sbase + incl2 - nsel;
#pragma unroll
        for (int i = 0; i < 8; ++i) { const int tok = 8 * tid + i; unsigned short iv = 0xFFFFu;
            if (selm & (1u << i)) { IDX[(size_t)item * CAP + slot] = tok; GATE[(size_t)item * CAP + slot] = __builtin_bit_cast(float, key[i]); iv = (unsigned short)slot; ++slot; }
            INV[((size_t)b * SEQ + tok) * 16 + e] = iv; }
        __syncthreads();
    }
}

struct Sched7 {
    const char* H2; const char* WG; const int* IDX; int G, c;
    __device__ __forceinline__ bool next(int i, Unit& u) const {
        if (i >= 16) return false;
        const int e = i, x = c & 7, j = c >> 3;
        const int mt = (x >> 1) * 4 + (j & 3), nt = (x & 1) * 8 + (j >> 2);
        const int b = mt >> 1;
        u.A = H2 + (size_t)b * SEQ * D; u.B = WG + ((size_t)e * 4096 + (size_t)nt * 256) * D;
        u.ridx = IDX + ((size_t)(b * NE + e) * CAP + (mt & 1) * 256); u.pm = e * 16 + mt; u.pn = nt; u.kind = 0; return true;
    }
};
struct Epi7 {
    static constexpr bool PERM = true;
    unsigned char* H; const float* RSTD;
    __device__ __forceinline__ bool operator()(f32x4 (&acc)[2][2][4][2], const Unit& u, int wr, int wc, int fr, int fq) const {
        const int row0 = u.pm * 256 + wr * 64 + fr, col0 = u.pn * 128 + wc * 32 + 8 * fq;
        const int b = (u.pm & 15) >> 1;
        int tok[8]; float rs[8];
#pragma unroll
        for (int i = 0; i < 8; ++i) tok[i] = u.ridx[(i >> 2) * 128 + wr * 64 + (i & 3) * 16 + fr];
#pragma unroll
        for (int i = 0; i < 8; ++i) rs[i] = RSTD[(size_t)b * SEQ + tok[i]];
#pragma unroll
        for (int ai = 0; ai < 2; ++ai)
#pragma unroll
            for (int m = 0; m < 4; ++m) {
                const float ws = rs[ai * 4 + m] * (1.0f / W8_SCALE), os = rs[ai * 4 + m] * (H8_SCALE / W8_SCALE);
                const f32x4 a0 = acc[ai][0][m][0], a1 = acc[ai][0][m][1], g0 = acc[ai][1][m][0], g1 = acc[ai][1][m][1];
                float r[8];
#pragma unroll
                for (int j = 0; j < 4; ++j) { const float x0 = a0[j] * ws, x1 = a1[j] * ws; r[j] = x0 * fast_sigmoid(x0) * (g0[j] * os); r[4 + j] = x1 * fast_sigmoid(x1) * (g1[j] * os); }
                u32x2 w; w.x = pk4_fp8(r[0], r[1], r[2], r[3]); w.y = pk4_fp8(r[4], r[5], r[6], r[7]);
                *(u32x2*)(H + (size_t)(row0 + ai * 128 + m * 16) * DFF + col0) = w; }
        return false;
    }
};

struct Sched8 {
    const char* H; const char* WD; int G, c;
    __device__ __forceinline__ bool next(int i, Unit& u) const {
        if (i >= 4) return false;
        const int x = c & 7, j = c >> 3;
        const int e = i * 4 + (x >> 1), mt = (x & 1) * 8 + (j & 7), nt = j >> 3;
        u.A = H + ((size_t)e * 4096 + (size_t)mt * 256) * DFF; u.B = WD + ((size_t)e * D + (size_t)nt * 256) * DFF; u.ridx = nullptr; u.pm = e * 16 + mt; u.pn = nt; u.kind = 0; return true;
    }
};
struct Epi8 {
    static constexpr bool PERM = true;
    unsigned char* Y; const float* GATE;
    __device__ __forceinline__ bool operator()(f32x4 (&acc)[2][2][4][2], const Unit& u, int wr, int wc, int fr, int fq) const {
        const int e = u.pm >> 4, mt = u.pm & 15, b = mt >> 1;
        const int rl0 = (mt & 1) * 256 + wr * 64 + fr;
        const int col0 = u.pn * 256 + wc * 32 + 8 * fq;
        float gv[8];
#pragma unroll
        for (int i = 0; i < 8; ++i) gv[i] = GATE[(size_t)(b * NE + e) * CAP + rl0 + (i >> 2) * 128 + (i & 3) * 16] * (Y8_SCALE / (W8_SCALE * H8_SCALE));
#pragma unroll
        for (int ai = 0; ai < 2; ++ai)
#pragma unroll
            for (int m = 0; m < 4; ++m) { const int sl = rl0 + ai * 128 + m * 16; const float g = gv[ai * 4 + m];
                unsigned char* rowp = Y + ((size_t)e * 4096 + (size_t)b * CAP + sl) * D + col0;
#pragma unroll
                for (int bj = 0; bj < 2; ++bj) { const f32x4 v0 = acc[ai][bj][m][0] * g, v1 = acc[ai][bj][m][1] * g;
                    u32x2 w; w.x = pk4_fp8(v0[0], v0[1], v0[2], v0[3]); w.y = pk4_fp8(v1[0], v1[1], v1[2], v1[3]);
                    *(u32x2*)(rowp + bj * 128) = w; } }
        return false;
    }
};

__device__ __forceinline__ void p9_final(const Ctx& F) {
    const int gw = F.bid * 8 + F.wave, NGW = F.G * 8, lane = F.lane;
    const unsigned short* INV = (const unsigned short*)(F.ws + WS_INV); const unsigned char* Y = (const unsigned char*)(F.ws + WS_RA); const bf16_t* DLT = (const bf16_t*)(F.ws + WS_DLT);
    f32x4 gg[4];
#pragma unroll
    for (int j = 0; j < 4; ++j) gg[j] = ((const f32x4*)F.final_g)[64 * j + lane];
    for (int m2 = gw; m2 < MTOK / 2; m2 += NGW) {
        const int m = m2 * 2, b = m >> 12;
        const f32x4* xr = (const f32x4*)(F.x + (size_t)m * D) + lane; const u32x2* dr = (const u32x2*)(DLT + (size_t)m * D) + lane;
        f32x4* orow = (f32x4*)(F.out + (size_t)m * D) + lane;
        f32x4 v[2][4]; u32x2 dl[2][4];
#pragma unroll
        for (int r = 0; r < 2; ++r)
#pragma unroll
            for (int j = 0; j < 4; ++j) { v[r][j] = xr[r * 256 + 64 * j]; dl[r][j] = dr[r * 256 + 64 * j]; }
        const unsigned myinv = INV[(size_t)m * 16 + (lane & 31)];
#pragma unroll
        for (int r = 0; r < 2; ++r)
#pragma unroll
            for (int j = 0; j < 4; ++j) { v[r][j].x += bf_lo(dl[r][j].x); v[r][j].y += bf_hi(dl[r][j].x); v[r][j].z += bf_lo(dl[r][j].y); v[r][j].w += bf_hi(dl[r][j].y); }
        f32x4 ys[2][4];
#pragma unroll
        for (int r = 0; r < 2; ++r)
#pragma unroll
            for (int j = 0; j < 4; ++j) ys[r][j] = (f32x4){0.f, 0.f, 0.f, 0.f};
#pragma unroll 1
        for (int e = 0; e < 16; ++e) {
#pragma unroll
            for (int r = 0; r < 2; ++r) {
                const unsigned sl = (unsigned)__builtin_amdgcn_readlane((int)myinv, e + 16 * r);
                if (sl != 0xFFFFu) {
                    const unsigned* yr = (const unsigned*)(Y + ((size_t)e * 4096 + (size_t)b * CAP + sl) * D) + lane;
#pragma unroll
                    for (int j = 0; j < 4; ++j) { const unsigned w = yr[64 * j]; const f32x2 lo = __builtin_amdgcn_cvt_pk_f32_fp8((int)w, false), hi = __builtin_amdgcn_cvt_pk_f32_fp8((int)w, true);
                        ys[r][j].x += lo.x; ys[r][j].y += lo.y; ys[r][j].z += hi.x; ys[r][j].w += hi.y; }
                }
            }
        }
#pragma unroll
        for (int r = 0; r < 2; ++r) {
            float s = 0.f;
#pragma unroll
            for (int j = 0; j < 4; ++j) { v[r][j] = v[r][j] + ys[r][j] * (1.0f / Y8_SCALE); s += (v[r][j].x * v[r][j].x + v[r][j].y * v[r][j].y) + (v[r][j].z * v[r][j].z + v[r][j].w * v[r][j].w); }
            const float rstd = 1.0f / sqrtf(wave_sum(s) * (1.f / D) + EPS);
#pragma unroll
            for (int j = 0; j < 4; ++j) orow[r * 256 + 64 * j] = v[r][j] * rstd * gg[j];
        }
    }
}

__global__ void __launch_bounds__(512, 2) mk_fwd(Args args) {
    extern __shared__ __attribute__((aligned(16))) unsigned char lds_raw[];
    cg::grid_group grid = cg::this_grid();
    Ctx F;
    F.lds = (LAS unsigned char*)lds_raw;
    F.tid = threadIdx.x; F.lane = F.tid & 63; F.wave = __builtin_amdgcn_readfirstlane(F.tid >> 6); F.G = gridDim.x; F.bid = blockIdx.x;
    F.x = args.in[0]; F.norm1_g = args.in[1]; F.w_in = args.in[2]; F.ln_g = args.in[3]; F.ln_b = args.in[4]; F.w_sp = args.in[5]; F.b_sp = args.in[6];
    F.w_fo = args.in[7]; F.w_so = args.in[8]; F.w_out = args.in[9]; F.norm2_g = args.in[10]; F.w_router = args.in[11]; F.w_gate = args.in[12]; F.w_up = args.in[13];
    F.w_down = args.in[14]; F.final_g = args.in[15]; F.out = args.out; F.ws = args.ws;
    const unsigned pm_ = args.ph_mask;
    unsigned char* ws = args.ws;
    if (F.tid < 2) ((LAS unsigned*)(F.lds + LDS_MISC))[F.tid] = 0u;
    __syncthreads();
    if (args.pad == 0x5eedu) grid.sync();
    const XcdBarrier xbar = xcd_barrier_post((unsigned*)(ws + WS_CTL), (volatile LAS unsigned*)(F.lds + LDS_MISC));
#ifndef PROBE_PHASE
#define PROBE_PHASE -1
#endif
    volatile LAS unsigned long long* stamps_ = (volatile LAS unsigned long long*)(F.lds + LDS_BYTES - 256);
#define STAMP(k) do { if (PROBE_PHASE >= 0 && F.bid == 0 && F.tid == 0) stamps_[k] = __builtin_amdgcn_s_memrealtime(); } while (0)
#ifndef PH_CT_MASK
#define PH_CT_MASK 0xffffu
#endif
#define RUN(k) ((((PH_CT_MASK) >> (k)) & 1u) && ((pm_ >> (k)) & 1u))
#define SEAM(k) do { if ((pm_ & ((2u << (k)) - 1u)) && (pm_ >> ((k) + 1))) { xcd_barrier(xbar); } } while (0)
    STAMP(0); if ((F.bid & 1) && RUN(2)) p0_prep(F, 4);
    if (RUN(0)) p0_prep(F, 1); STAMP(1); if (RUN(1)) p0_prep(F, 2); STAMP(2); if (!(F.bid & 1) && RUN(2)) p0_prep(F, 4); STAMP(3); if (RUN(3)) p0_prep(F, 8);
    SEAM(3); STAMP(4);
    if (RUN(4)) {
        const int nk = (8192 + F.G * 8 - 1) / (F.G * 8);
        weight_filler(F, 0, 0, (F.bid & 1) ? nk : 0);
        Sched1 S{(const char*)(ws + WS_HN), (const char*)(ws + WS_WIN), F.G, F.bid}; Epi1 E{ws};
        pg8::gemm_phase<Epi1, Sched1, false>(F.lds, D, S, E);
        weight_filler(F, 0, (F.bid & 1) ? nk : 0, nk);
    }
    SEAM(4); STAMP(5);
    if (RUN(5)) p2_sgu(F);
    STAMP(6);
    if (RUN(6)) fft_stage<0>(F);
    SEAM(6); STAMP(7);
    if (RUN(7)) fft_stage<1>(F);
    SEAM(7); STAMP(8);
    if (RUN(8)) {
        Sched3 S{(const char*)(ws + WS_FM), (const char*)(ws + WS_SG), (const char*)(ws + WS_WFO), (const char*)(ws + WS_WSO), F.G, F.bid};
        Epi3 E{(const bf16_t*)(ws + WS_SGF), (const bf16_t*)(ws + WS_SGS), (bf16_t*)(ws + WS_MRG)};
        const int nk = (8192 + F.G * 8 - 1) / (F.G * 8);
        weight_filler(F, 1, 0, (F.bid & 1) ? nk : 0);
        pg8::gemm_phase<Epi3, Sched3, false>(F.lds, 512, S, E);
        weight_filler(F, 1, (F.bid & 1) ? nk : 0, nk);
    }
    SEAM(8); STAMP(9);
    if (RUN(9)) {
        Sched4 S{(const char*)(ws + WS_MRG), (const char*)(ws + WS_WOUT), F.G, F.bid}; Epi4 E{(bf16_t*)(ws + WS_DLT)};
        const int nk = (8192 + F.G * 8 - 1) / (F.G * 8);
        weight_filler(F, 2, 0, (F.bid & 1) ? nk : 0);
        pg8::gemm_phase<Epi4, Sched4, false>(F.lds, D, S, E);
        weight_filler(F, 2, (F.bid & 1) ? nk : 0, nk);
    }
    SEAM(9); STAMP(10);
    if (RUN(10)) p5_rows(F, 1);
    STAMP(11);
    if (RUN(11)) p5_rows(F, 2);
    SEAM(11); STAMP(12);
    if (RUN(12)) p6_topk(F);
    SEAM(12); STAMP(13);
    if (RUN(13)) {
        Sched7 S{(const char*)(ws + WS_H2), (const char*)(ws + WS_WGU), (const int*)(ws + WS_IDX), F.G, F.bid}; Epi7 E{(unsigned char*)(ws + WS_H), (const float*)(ws + WS_RSTD)};
        pg8::gemm_phase<Epi7, Sched7, true, true>(F.lds, D / 2, S, E);
    }
    SEAM(13); STAMP(14);
    if (RUN(14)) {
        Sched8 S{(const char*)(ws + WS_H), (const char*)(ws + WS_WD), F.G, F.bid}; Epi8 E{(unsigned char*)(ws + WS_RA), (const float*)(ws + WS_GATE)};
        pg8::gemm_phase<Epi8, Sched8, false, true>(F.lds, DFF / 2, S, E);
    }
    SEAM(14); STAMP(15);
    if (RUN(15)) p9_final(F);
    STAMP(16);
    if (PROBE_PHASE >= 0 && F.bid == 0 && F.tid == 0) { const unsigned long long dt = 4ull * (stamps_[PROBE_PHASE + 1] - stamps_[PROBE_PHASE]), t0 = __builtin_amdgcn_s_memrealtime();
        while (__builtin_amdgcn_s_memrealtime() - t0 < dt) __builtin_amdgcn_s_sleep(32); }
#undef RUN
#undef SEAM
}

extern "C" void kernel_launch(void* const* d_in, const int* in_sizes, int n_in, void* d_out, int out_size, void* d_ws, size_t ws_size, hipStream_t stream) {
    static int grid = 0;
    if (grid == 0) {
        if (n_in != 16 || out_size != MTOK * D || ws_size < WS_END) { fprintf(stderr, "kernel_launch: unexpected shapes (n_in %d, out %d, ws %zu < %zu)\n", n_in, out_size, ws_size, (size_t)WS_END); grid = -1; return; }
        int dev = 0, cus = 0, per_cu = 0;
        if (hipGetDevice(&dev) != hipSuccess || hipDeviceGetAttribute(&cus, hipDeviceAttributeMultiprocessorCount, dev) != hipSuccess) { grid = -1; return; }
        if (hipFuncSetAttribute((const void*)mk_fwd, hipFuncAttributeMaxDynamicSharedMemorySize, LDS_BYTES) != hipSuccess) { fprintf(stderr, "kernel_launch: hipFuncSetAttribute failed\n"); grid = -1; return; }
        if (hipOccupancyMaxActiveBlocksPerMultiprocessor(&per_cu, (const void*)mk_fwd, 512, LDS_BYTES) != hipSuccess || per_cu < 1) { fprintf(stderr, "kernel_launch: occupancy query failed (%d)\n", per_cu); grid = -1; return; }
        if (per_cu > 1) per_cu = 1;
        grid = cus * per_cu;
        if (grid != 256) fprintf(stderr, "kernel_launch: note: grid %d (tile orders are tuned for 256)\n", grid);
    }
    if (grid < 0) return;
    if (hipMemsetAsync((char*)d_ws + WS_CTL, 0, CTL_BYTES, stream) != hipSuccess) { fprintf(stderr, "kernel_launch: hipMemsetAsync failed\n"); return; }
    Args a{};
    for (int i = 0; i < 16; ++i) a.in[i] = (const float*)d_in[i];
    a.out = (float*)d_out; a.ws = (unsigned char*)d_ws;
#if MK_N_LAUNCHES == 1
    a.ph_mask = 0xffffu;
    void* kargs[] = {&a};
    hipError_t e = hipLaunchCooperativeKernel((const void*)mk_fwd, dim3(grid), dim3(512), kargs, LDS_BYTES, stream);
    if (e != hipSuccess) fprintf(stderr, "kernel_launch: cooperative launch failed: %s (grid %d)\n", hipGetErrorString(e), grid);
#else
#ifndef PROBE_DUP
#define PROBE_DUP 0
#endif
    for (int p = 0; p < 16; ++p) {
        const int reps = ((PROBE_DUP >> p) & 1) ? 2 : 1;
        for (int r = 0; r < reps; ++r) { a.ph_mask = 1u << p; hipLaunchKernelGGL(mk_fwd, dim3(grid), dim3(512), LDS_BYTES, stream, a); }
    }
#endif
}
```

```cpp
#include <hip/hip_runtime.h>
#include <hip/hip_cooperative_groups.h>
#include <cstdio>
#include <cstdint>
namespace cg = cooperative_groups;

#ifndef MK_N_LAUNCHES
#define MK_N_LAUNCHES 1
#endif

#define LAS __attribute__((address_space(3)))
typedef unsigned short bf16_t;
typedef short bf16x8 __attribute__((ext_vector_type(8)));
typedef float f32x4 __attribute__((ext_vector_type(4)));
typedef float f32x2 __attribute__((ext_vector_type(2)));
typedef unsigned u32x4 __attribute__((ext_vector_type(4)));
typedef unsigned u32x2 __attribute__((ext_vector_type(2)));
typedef int i32x4 __attribute__((ext_vector_type(4)));
typedef int i32x8 __attribute__((ext_vector_type(8)));

constexpr int D = 1024, NB = 8, SEQ = 4096, MTOK = NB * SEQ;
constexpr int FW = 512, SWD = 512, NE = 16, CAP = 512, DFF = 2048;
constexpr int N1 = 3584;
constexpr int INW = 3584;
constexpr float EPS = 1e-6f;

constexpr size_t MiB = 1u << 20;
constexpr size_t WS_RA = 0;
constexpr size_t WS_WGU = 64 * MiB;
constexpr size_t WS_WD = 128 * MiB;
constexpr size_t WS_RH = 192 * MiB;
constexpr size_t WS_YF = WS_RH;
constexpr size_t WS_GU = WS_RH + 64 * MiB;
constexpr size_t WS_GV = WS_RH + 96 * MiB;
constexpr size_t WS_SGF = WS_RH + 128 * MiB;
constexpr size_t WS_SGS = WS_RH + 192 * MiB;
constexpr size_t WS_FM = WS_GU;
constexpr size_t WS_MRG = WS_RH;
constexpr size_t WS_H = WS_RH + 128 * MiB;
constexpr size_t WS_DLT = WS_RH + 64 * MiB;
constexpr size_t WS_RS = 448 * MiB;
constexpr size_t WS_HN = WS_RS;
constexpr size_t WS_AP = WS_RS;
constexpr size_t WS_SG = WS_RA;
constexpr size_t WS_H2 = WS_RS;
constexpr size_t WS_WIN = 512 * MiB;
constexpr size_t WS_WFO = 520 * MiB;
constexpr size_t WS_WSO = 521 * MiB;
constexpr size_t WS_WOUT = 522 * MiB;
constexpr size_t WS_AFF = 524 * MiB;
constexpr size_t WS_INV = 526 * MiB;
constexpr size_t WS_IDX = 527 * MiB;
constexpr size_t WS_GATE = WS_IDX + 256 * 1024;
constexpr size_t WS_MA = WS_IDX + 512 * 1024;
constexpr size_t WS_MB = WS_MA + 32 * 1024;
constexpr size_t WS_RSTD = WS_IDX + 832 * 1024;
constexpr size_t WS_WRT = WS_IDX + 960 * 1024;
constexpr size_t WS_CST = WS_IDX + 576 * 1024;
constexpr size_t WS_CTL = WS_IDX + 768 * 1024;
constexpr size_t CTL_BYTES = 16384;
constexpr size_t WS_END = 528 * MiB;

constexpr int LDS_STAGE = 131072;
constexpr int LDS_X_OFF = LDS_STAGE;
constexpr int LDS_BYTES = 155648;
constexpr int LDS_MISC = LDS_BYTES - 64;

__device__ __forceinline__ unsigned f2bf(float f) { unsigned u = __builtin_bit_cast(unsigned, f); return (u + 0x7fffu + ((u >> 16) & 1u)) >> 16; }
__device__ __forceinline__ unsigned pk2(float lo, float hi) { return f2bf(lo) | (f2bf(hi) << 16); }
__device__ __forceinline__ unsigned cvt_pk_bf16(float lo, float hi) { unsigned r; asm volatile("v_cvt_pk_bf16_f32 %0, %1, %2" : "=v"(r) : "v"(lo), "v"(hi)); return r; }
__device__ __forceinline__ float bf_lo(unsigned w) { return __builtin_bit_cast(float, w << 16); }
__device__ __forceinline__ float bf_hi(unsigned w) { return __builtin_bit_cast(float, w & 0xffff0000u); }
__device__ __forceinline__ float wave_sum(float v) {
#pragma unroll
    for (int o = 1; o < 64; o <<= 1) v += __shfl_xor(v, o);
    return v;
}
__device__ __forceinline__ float fast_sigmoid(float x) { return __builtin_amdgcn_rcpf(1.0f + __builtin_amdgcn_exp2f(-1.44269504089f * x)); }
__device__ __forceinline__ float gelu_tanh(float x) {
    const float u = 1.5957691216f * (x + 0.044715f * x * x * x);
    return x * fast_sigmoid(u);
}
#define LDS_WAIT() asm volatile("s_waitcnt lgkmcnt(0)" ::: "memory")
__device__ __forceinline__ unsigned pk4_fp8(float a, float b, float c, float d) {
    a = __builtin_amdgcn_fmed3f(a, -448.f, 448.f); b = __builtin_amdgcn_fmed3f(b, -448.f, 448.f); c = __builtin_amdgcn_fmed3f(c, -448.f, 448.f); d = __builtin_amdgcn_fmed3f(d, -448.f, 448.f);
    int r = 0; r = __builtin_amdgcn_cvt_pk_fp8_f32(a, b, r, false); r = __builtin_amdgcn_cvt_pk_fp8_f32(c, d, r, true); return (unsigned)r;
}
constexpr float W8_SCALE = 32.0f;
constexpr float H8_SCALE = 8.0f;
constexpr float Y8_SCALE = 64.0f;

namespace pg8 {
constexpr int BM = 256, BK = 64, HALF = 128, HTB = HALF * BK * 2, NXCD = 8, WGM = 8;
__device__ __forceinline__ int lds_byte(int r, int c) { const int st = (r >> 4) * 2 + (c >> 5), rr = r & 15, cc = c & 31, ob = rr * 64 + cc * 2; return st * 1024 + (ob ^ (((ob >> 9) & 1) << 5)); }
__device__ __forceinline__ void stage_rc(int b, int& R, int& C) { const int st = b / 1024, sb = b % 1024, swz = sb ^ (((sb >> 9) & 1) << 5); R = (st >> 1) * 16 + swz / 64; C = (st & 1) * 32 + (swz % 64) / 2; }
__device__ __forceinline__ int perm32(int rho) { const int n = rho >> 4, i = rho & 15; return 8 * (i >> 2) + 4 * n + (i & 3); }

struct Unit { const char* A; const char* B; const int* ridx; int pm, pn, kind; };

__device__ __forceinline__ bool static_tile(int nM, int nN, int G, int c, int i, int& pm, int& pn) {
    const int nwg = nM * nN; const long L = (long)i * G + c; if (L >= nwg) return false;
    int wgid = (int)L; { const int q = nwg / NXCD, r = nwg % NXCD, xcd = wgid % NXCD, off = wgid / NXCD; wgid = (xcd < r ? xcd * (q + 1) : r * (q + 1) + (xcd - r) * q) + off; }
    const int nig = WGM * nN, gid = wgid / nig, fm = gid * WGM, gsz = (nM - fm) < WGM ? (nM - fm) : WGM;
    pm = fm + ((wgid % nig) % gsz); pn = (wgid % nig) / gsz; return true;
}

template <class Epi, class Sched, bool GATHER, bool FP8 = false>
__device__ __forceinline__ void gemm_phase(LAS unsigned char* lds, const int K, const Sched& S, const Epi& E) {
    const int tid = threadIdx.x, wid = __builtin_amdgcn_readfirstlane(tid >> 6), lane = tid & 63, wr = wid >> 2, wc = wid & 3, fr = lane & 15, fq = lane >> 4;
    const int nt = K / BK;
    unsigned voffA[2], voffB[2]; int RA[2], CA2[2];
#pragma unroll
    for (int i = 0; i < 2; ++i) { int R, C; stage_rc(tid * 16 + i * 8192, R, C); const int Rb = Epi::PERM ? ((R & ~31) + perm32(R & 31)) : R;
        voffA[i] = (unsigned)(R * K + C) * 2u; voffB[i] = (unsigned)(Rb * K + C) * 2u; RA[i] = R; CA2[i] = C * 2; }
    const size_t kstep = (size_t)(BK * 2);
    const size_t hstep = (size_t)HALF * K * 2;
    const unsigned ldsw = (unsigned)wid * 1024u;
    const int aoff = lds_byte(wr * 64 + fr, fq * 8), boff = lds_byte(wc * 32 + fr, fq * 8);
#define PG8_SA(b, h) (((b) * 2 + (h)) * HTB)
#define PG8_SB(b, h) ((4 + (b) * 2 + (h)) * HTB)
#define PG8_GLDS(bufoff, gptr, _i) __builtin_amdgcn_global_load_lds((const unsigned*)(gptr), (LAS unsigned*)(lds + (bufoff) + ldsw + (_i) * 8192), 16, 0, 0)
#define PG8_STAGE_B(bufoff, gbase) do { _Pragma("unroll") for (int _i = 0; _i < 2; ++_i) PG8_GLDS(bufoff, (const char*)(gbase) + voffB[_i], _i); } while (0)
#define PG8_STAGE_A(bufoff, gbase, h, go) do { _Pragma("unroll") for (int _i = 0; _i < 2; ++_i) { \
        if constexpr (GATHER) PG8_GLDS(bufoff, (const char*)(gbase) + go[h][_i], _i); else PG8_GLDS(bufoff, (const char*)(gbase) + (h) * hstep + voffA[_i], _i); } } while (0)
#define PG8_LD2(d2, d8, base) do { const LAS i32x4* p_ = (const LAS i32x4*)(base); const i32x4 lo_ = p_[0], hi_ = p_[64]; \
        if constexpr (FP8) d8 = __builtin_shufflevector(lo_, hi_, 0, 1, 2, 3, 4, 5, 6, 7); else { d2[0] = __builtin_bit_cast(bf16x8, lo_); d2[1] = __builtin_bit_cast(bf16x8, hi_); } } while (0)
#define PG8_LDA(dst, b, h) do { _Pragma("unroll") for (int m = 0; m < 4; ++m) PG8_LD2(dst[m], dst##8[m], lds + PG8_SA(b, h) + aoff + m * 2048); } while (0)
#define PG8_LDB(dst, b, h) do { _Pragma("unroll") for (int n = 0; n < 2; ++n) PG8_LD2(dst[n], dst##8[n], lds + PG8_SB(b, h) + boff + n * 2048); } while (0)
#define PG8_MMA(ai, bj, At, Bt) do { __builtin_amdgcn_s_setprio(1); _Pragma("unroll") for (int m = 0; m < 4; ++m) _Pragma("unroll") for (int n = 0; n < 2; ++n) { \
        if constexpr (FP8) asm volatile("v_mfma_f32_16x16x128_f8f6f4 %0, %1, %2, %0" : "+v"(acc[ai][bj][m][n]) : "v"(Bt##8[n]), "v"(At##8[m])); \
        else { _Pragma("unroll") for (int k = 0; k < 2; ++k) acc[ai][bj][m][n] = __builtin_amdgcn_mfma_f32_16x16x32_bf16(Bt[n][k], At[m][k], acc[ai][bj][m][n], 0, 0, 0); } } \
        __builtin_amdgcn_s_setprio(0); } while (0)
#define PG8_WAIT_V(n) asm volatile("s_waitcnt vmcnt(" #n ")" ::: "memory")
#define PG8_WAIT_L(n) asm volatile("s_waitcnt lgkmcnt(" #n ")" ::: "memory")
#define PG8_BAR __builtin_amdgcn_s_barrier()
#define PG8_SCHED __builtin_amdgcn_sched_barrier(0)
#define PG8_GOFS(dst, u) do { if constexpr (GATHER) { _Pragma("unroll") for (int _h = 0; _h < 2; ++_h) _Pragma("unroll") for (int _i = 0; _i < 2; ++_i) \
        dst[_h][_i] = (unsigned)(u).ridx[_h * HALF + RA[_i]] * (unsigned)(K * 2) + (unsigned)CA2[_i]; } } while (0)
    Unit cur, nxt; int ui = 0;
    if (!S.next(0, cur)) return;
    f32x4 acc[2][2][4][2];
#pragma unroll
    for (int a = 0; a < 2; ++a)
#pragma unroll
        for (int b = 0; b < 2; ++b)
#pragma unroll
            for (int m = 0; m < 4; ++m)
#pragma unroll
                for (int n = 0; n < 2; ++n) acc[a][b][m][n] = (f32x4){0.f, 0.f, 0.f, 0.f};
    bf16x8 At[4][2], B0[2][2], B1[2][2]; i32x8 At8[4], B08[2], B18[2];
    unsigned gA[2][2] = {{0u, 0u}, {0u, 0u}}, gN[2][2] = {{0u, 0u}, {0u, 0u}};
    PG8_GOFS(gA, cur);
    const char* cA = cur.A; const char* cB = cur.B;
    PG8_STAGE_B(PG8_SB(0, 0), cB); PG8_STAGE_B(PG8_SB(0, 1), cB + hstep); PG8_STAGE_A(PG8_SA(0, 0), cA, 0, gA); PG8_STAGE_A(PG8_SA(0, 1), cA, 1, gA);
    if (wr == 1) PG8_BAR;
    PG8_WAIT_V(2); PG8_BAR;
    PG8_STAGE_B(PG8_SB(1, 0), cB + kstep); PG8_STAGE_A(PG8_SA(1, 0), cA + kstep, 0, gA); PG8_STAGE_B(PG8_SB(1, 1), cB + hstep + kstep);
    PG8_WAIT_V(6); PG8_BAR;
    for (;;) {
        const bool has_next = S.next(ui + 1, nxt);
        if (!has_next) nxt = cur;
        PG8_GOFS(gN, nxt);
        const char* nA = nxt.A; const char* nB = nxt.B;
#pragma clang loop unroll(disable)
        for (int t = 0; t < nt; t += 2) {
            const bool last = (t == nt - 2);
            const char* a1 = cA + (size_t)(t + 1) * kstep;
            const char* a2 = last ? nA : cA + (size_t)(t + 2) * kstep; const char* b2 = last ? nB : cB + (size_t)(t + 2) * kstep;
            const char* a3 = a2 + kstep; const char* b3 = b2 + kstep;
            unsigned g2[2][2];
#pragma unroll
            for (int _h = 0; _h < 2; ++_h)
#pragma unroll
                for (int _i = 0; _i < 2; ++_i) g2[_h][_i] = last ? gN[_h][_i] : gA[_h][_i];
            PG8_LDB(B0, 0, 0); PG8_LDB(B1, 0, 1); PG8_SCHED; PG8_LDA(At, 0, 0); PG8_STAGE_A(PG8_SA(1, 1), a1, 1, gA);
            PG8_WAIT_V(8); PG8_WAIT_L(0); PG8_BAR; PG8_MMA(0, 0, At, B0); PG8_MMA(0, 1, At, B1); PG8_BAR; PG8_SCHED;
            PG8_LDA(At, 0, 1); PG8_STAGE_B(PG8_SB(0, 0), b2); PG8_STAGE_B(PG8_SB(0, 1), b2 + hstep); PG8_STAGE_A(PG8_SA(0, 0), a2, 0, g2);
            PG8_WAIT_V(8); PG8_WAIT_L(0); PG8_BAR; PG8_MMA(1, 0, At, B0); PG8_MMA(1, 1, At, B1); PG8_BAR; PG8_SCHED;
            PG8_LDB(B0, 1, 0); PG8_LDB(B1, 1, 1); PG8_SCHED; PG8_LDA(At, 1, 0); PG8_STAGE_A(PG8_SA(0, 1), a2, 1, g2);
            PG8_WAIT_V(8); PG8_WAIT_L(0); PG8_BAR; PG8_MMA(0, 0, At, B0); PG8_MMA(0, 1, At, B1); PG8_BAR; PG8_SCHED;
            PG8_LDA(At, 1, 1); PG8_STAGE_B(PG8_SB(1, 0), b3); PG8_STAGE_B(PG8_SB(1, 1), b3 + hstep); PG8_STAGE_A(PG8_SA(1, 0), a3, 0, g2);
            PG8_WAIT_V(8); PG8_WAIT_L(0); PG8_BAR; PG8_MMA(1, 0, At, B0); PG8_MMA(1, 1, At, B1); PG8_BAR; PG8_SCHED;
        }
        if (wr == 0) PG8_BAR;
        if constexpr (FP8) asm volatile("s_nop 15\n\ts_nop 15" ::: "memory");
        const bool keep = E(acc, cur, wr, wc, fr, fq);
        if (!has_next) break;
        if (!keep) {
#pragma unroll
            for (int a = 0; a < 2; ++a)
#pragma unroll
                for (int b = 0; b < 2; ++b)
#pragma unroll
                    for (int m = 0; m < 4; ++m)
#pragma unroll
                        for (int n = 0; n < 2; ++n) acc[a][b][m][n] = (f32x4){0.f, 0.f, 0.f, 0.f};
        }
        cur = nxt; cA = nA; cB = nB; ++ui;
#pragma unroll
        for (int _h = 0; _h < 2; ++_h)
#pragma unroll
            for (int _i = 0; _i < 2; ++_i) gA[_h][_i] = gN[_h][_i];
        if (wr == 1) PG8_BAR;
    }
    PG8_WAIT_V(0);
    PG8_BAR;
#undef PG8_SA
#undef PG8_SB
#undef PG8_GLDS
#undef PG8_STAGE_A
#undef PG8_STAGE_B
#undef PG8_LDA
#undef PG8_LDB
#undef PG8_MMA
#undef PG8_LD2
#undef PG8_WAIT_V
#undef PG8_WAIT_L
#undef PG8_BAR
#undef PG8_SCHED
#undef PG8_GOFS
}
}
using pg8::Unit;

#define XB_TMO      128
#define XB_XCNT(j)  (256  + 64 * (j))
#define XB_XSUB(j)  (1280 + 64 * (j))
#define XB_XGEN(j)  (2304 + 64 * (j))
#define XB_TOP      3328
#define XB_TOPGEN   3392
#define XB_SPIN_CAP (1u << 22)
__device__ __forceinline__ unsigned xb_ld(unsigned* p)              { return __hip_atomic_load(p, __ATOMIC_RELAXED, __HIP_MEMORY_SCOPE_AGENT); }
__device__ __forceinline__ unsigned xb_add(unsigned* p, unsigned v) { return __hip_atomic_fetch_add(p, v, __ATOMIC_RELAXED, __HIP_MEMORY_SCOPE_AGENT); }
__device__ __forceinline__ unsigned xb_xcc_id() { return (unsigned)__builtin_amdgcn_s_getreg((3 << 11) | 20) & 0xFu; }
#define XB_SPIN(cond, bar) do { unsigned _sp = 0; while (cond) { __builtin_amdgcn_s_sleep(1); \
    if ((++_sp & 255u) == 0u) { if (xb_ld(&(bar)[XB_TMO])) break; if (_sp > XB_SPIN_CAP) { atomicAdd(&(bar)[XB_TMO], 1u); break; } } } } while (0)
struct XcdBarrier { unsigned* bar; unsigned x; volatile LAS unsigned* st; };
__device__ __forceinline__ XcdBarrier xcd_barrier_post(unsigned* bar, volatile LAS unsigned* st) {
    XcdBarrier b; b.bar = bar; b.x = xb_xcc_id(); b.st = st;
    if (threadIdx.x == 0) (void)xb_add(&bar[XB_XCNT(b.x)], 1u);
    return b;
}
__device__ __forceinline__ void xcd_barrier_complete(unsigned* bar, unsigned x, unsigned& nloc, unsigned& nx) {
    const unsigned G = gridDim.x * gridDim.y * gridDim.z;
    unsigned sum, cnt, mine, sp = 0u;
    for (;;) {
        sum = 0u; cnt = 0u; mine = 0u;
#pragma unroll
        for (unsigned j = 0; j < 16; ++j) { const unsigned c = xb_ld(&bar[XB_XCNT(j)]); sum += c; cnt += (c > 0u) ? 1u : 0u; mine = (j == x) ? c : mine; }
        if (sum == G) break;
        __builtin_amdgcn_s_sleep(1);
        if ((++sp & 255u) == 0u) { if (xb_ld(&bar[XB_TMO])) break; if (sp > XB_SPIN_CAP) { atomicAdd(&bar[XB_TMO], 1u); break; } }
    }
    nloc = mine > 0u ? mine : 1u; nx = cnt > 0u ? cnt : 1u;
}
__device__ __forceinline__ void xcd_barrier(const XcdBarrier& b) {
    asm volatile("s_waitcnt vmcnt(0)" ::: "memory");
    __syncthreads();
    if (threadIdx.x == 0) {
        unsigned* bar = b.bar;
        __builtin_amdgcn_s_waitcnt(0);
        unsigned nloc = b.st[0], nx = b.st[1];
        if (nloc == 0u) { xcd_barrier_complete(bar, b.x, nloc, nx); b.st[0] = nloc; b.st[1] = nx; }
        const unsigned old = xb_add(&bar[XB_XSUB(b.x)], 1u);
        const unsigned gen = old / nloc;
        if (old + 1u == (gen + 1u) * nloc) {
            __builtin_amdgcn_fence(__ATOMIC_RELEASE, "agent");
            asm volatile("s_waitcnt vmcnt(0)" ::: "memory");
            const unsigned og = xb_add(&bar[XB_TOP], 1u);
            const unsigned tg = og / nx;
            if (og + 1u == (tg + 1u) * nx) xb_add(&bar[XB_TOPGEN], 1u);
            else XB_SPIN(xb_ld(&bar[XB_TOPGEN]) == tg, bar);
            __builtin_amdgcn_fence(__ATOMIC_ACQUIRE, "agent");
            xb_add(&bar[XB_XGEN(b.x)], 1u);
            asm volatile("s_waitcnt vmcnt(0)" ::: "memory");
        } else {
            XB_SPIN(xb_ld(&bar[XB_XGEN(b.x)]) == gen, bar);
            __builtin_amdgcn_fence(__ATOMIC_ACQUIRE, "agent");
            asm volatile("s_waitcnt vmcnt(0)" ::: "memory");
        }
    }
    __syncthreads();
}

struct Args {
    const float* in[16];
    float* out;
    unsigned char* ws;
    unsigned ph_mask, pad;
};

struct Ctx {
    LAS unsigned char* lds;
    int tid, lane, wave, G, bid;
    const float *x, *norm1_g, *w_in, *ln_g, *ln_b, *w_sp, *b_sp, *w_fo, *w_so, *w_out, *norm2_g, *w_router, *w_gate, *w_up, *w_down, *final_g;
    float* out;
    unsigned char* ws;
};

__device__ __forceinline__ void transpose_item(const float* W, int N, int k0, int n0, bf16_t* WT, size_t dst_row0, int Kd, LAS float* scr, int lane) {
    const float* src = W + (size_t)(k0 + (lane >> 4)) * N + n0;
#pragma unroll
    for (int i = 0; i < 16; ++i) {
        const int n4 = (lane & 15) ^ ((i >> 1) & 7);
        __builtin_amdgcn_global_load_lds((const unsigned*)(src + (size_t)(4 * i) * N + 4 * n4), (LAS unsigned*)(scr + i * 256), 16, 0, 2);
    }
    asm volatile("s_waitcnt vmcnt(0)" ::: "memory");
    const int hh = lane >> 5, c = (lane >> 2) & 7, sub = lane & 3;
#pragma unroll
    for (int j = 0; j < 8; ++j) {
        const int n4 = 2 * j + hh;
        const LAS float* p = scr + (16 * (8 * c) + (n4 ^ c)) * 4 + sub;
        float v[8];
#pragma unroll
        for (int i = 0; i < 8; ++i) v[i] = p[i * 64];
        u32x4 o; o.x = pk2(v[0], v[1]); o.y = pk2(v[2], v[3]); o.z = pk2(v[4], v[5]); o.w = pk2(v[6], v[7]);
        *(u32x4*)(WT + (dst_row0 + 4 * n4 + sub) * (size_t)Kd + k0 + 8 * c) = o;
    }
    LDS_WAIT(); asm volatile("" ::: "memory");
}

__device__ __forceinline__ void transpose_item8(const float* W, int N, int k0, int n0, unsigned char* WT8, size_t dst_row0, int Kd, LAS float* scr, int lane) {
    const float* src = W + (size_t)(k0 + (lane >> 4)) * N + n0;
#pragma unroll
    for (int i = 0; i < 16; ++i) {
        const int n4 = (lane & 15) ^ ((i >> 1) & 7);
        __builtin_amdgcn_global_load_lds((const unsigned*)(src + (size_t)(4 * i) * N + 4 * n4), (LAS unsigned*)(scr + i * 256), 16, 0, 2);
    }
    asm volatile("s_waitcnt vmcnt(0)" ::: "memory");
    const int hh = lane >> 5, c = (lane >> 2) & 7, sub = lane & 3;
#pragma unroll
    for (int j = 0; j < 8; ++j) {
        const int n4 = 2 * j + hh;
        const LAS float* p = scr + (16 * (8 * c) + (n4 ^ c)) * 4 + sub;
        float v[8];
#pragma unroll
        for (int i = 0; i < 8; ++i) v[i] = p[i * 64] * W8_SCALE;
        u32x2 o; o.x = pk4_fp8(v[0], v[1], v[2], v[3]); o.y = pk4_fp8(v[4], v[5], v[6], v[7]);
        *(u32x2*)(WT8 + (dst_row0 + 4 * n4 + sub) * (size_t)Kd + k0 + 8 * c) = o;
    }
    LDS_WAIT(); asm volatile("" ::: "memory");
}

__device__ __forceinline__ void rms_rows4_to_bf16(const float* x0, const f32x4 (&gg)[4], bf16_t* o0, int lane) {
    f32x4 v[4][4];
#pragma unroll
    for (int r = 0; r < 4; ++r)
#pragma unroll
        for (int j = 0; j < 4; ++j) v[r][j] = __builtin_nontemporal_load((const f32x4*)(x0 + (size_t)r * D) + 64 * j + lane);
#pragma unroll
    for (int r = 0; r < 4; ++r) {
        float s = 0.f;
#pragma unroll
        for (int j = 0; j < 4; ++j) s += (v[r][j].x * v[r][j].x + v[r][j].y * v[r][j].y) + (v[r][j].z * v[r][j].z + v[r][j].w * v[r][j].w);
        const float rstd = 1.0f / sqrtf(wave_sum(s) * (1.f / D) + EPS);
        u32x2* o8 = (u32x2*)(o0 + (size_t)r * D) + lane;
#pragma unroll
        for (int j = 0; j < 4; ++j) { u32x2 w; w.x = pk2(v[r][j].x * rstd * gg[j].x, v[r][j].y * rstd * gg[j].y); w.y = pk2(v[r][j].z * rstd * gg[j].z, v[r][j].w * rstd * gg[j].w); o8[64 * j] = w; }
    }
}

__device__ __forceinline__ void weight_filler(const Ctx& F, const int which, const int k_lo, const int k_hi) {
    LAS float* scr = (LAS float*)(F.lds + F.wave * 16384);
    const int gw = F.bid * 8 + F.wave, NGW = F.G * 8;
    if (k_lo >= k_hi) return;
    if (which == 0) {
        for (int r = gw + k_lo * NGW; r < 8192 && r < gw + k_hi * NGW; r += NGW) { const int e = r >> 9, q = r & 511, kb = q >> 4, nb = q & 15;
            transpose_item8(F.w_down + (size_t)e * DFF * D, D, 64 * kb, 64 * nb, (unsigned char*)(F.ws + WS_WD) + (size_t)e * D * DFF, (size_t)(64 * nb), DFF, scr, F.lane); }
    } else {
        unsigned char* WG = (unsigned char*)(F.ws + WS_WGU);
        for (int it = gw + (which - 1) * 8192 + k_lo * NGW; it < which * 8192 && it < gw + (which - 1) * 8192 + k_hi * NGW; it += NGW) {
            const int e = it >> 10, src = (it >> 9) & 1, q = it & 511, kb = q >> 5, nb = q & 31;
            const int f0 = 64 * nb; const size_t dst_row0 = (size_t)e * 4096 + (size_t)(f0 >> 7) * 256 + (src ? 128 : 0) + (f0 & 127);
            transpose_item8((src ? F.w_up : F.w_gate) + (size_t)e * D * DFF, DFF, 64 * kb, f0, WG, dst_row0, D, scr, F.lane);
        }
    }
    __syncthreads();
}

__device__ __forceinline__ void p0_prep(const Ctx& F, const int parts) {
    LAS float* scr = (LAS float*)(F.lds + F.wave * 16384);
    LAS float* tab128 = (LAS float*)(F.lds + LDS_X_OFF);
    if (F.tid < 128) tab128[F.tid] = cospif((float)F.tid * (1.0f / 64.0f));
    __syncthreads();
    const int gw = F.bid * 8 + F.wave, NGW = F.G * 8;
    bf16_t* WinT = (bf16_t*)(F.ws + WS_WIN);
    if (parts & 1) {
        constexpr int I1 = 16 * 56, I2 = 8 * 16, I3 = 8 * 16, I4 = 16 * 16;
        constexpr int NIT = I1 + I2 + I3 + I4;
        for (int it = gw; it < NIT; it += NGW) {
            int r = it;
            if (r < I1) { const int kb = r / 56, nb = r % 56;
                size_t drow = (size_t)(64 * nb); if (nb >= 24) { const int c = 64 * nb - 1536, cc = c & 1023; drow = (size_t)(1536 + (cc >> 7) * 256 + (c >= 1024 ? 128 : 0) + (cc & 127)); }
                transpose_item(F.w_in, INW, 64 * kb, 64 * nb, WinT, drow, D, scr, F.lane); continue; } r -= I1;
            if (r < I2) { const int kb = r / 16, nb = r % 16; transpose_item(F.w_fo, D, 64 * kb, 64 * nb, (bf16_t*)(F.ws + WS_WFO), (size_t)(64 * nb), FW, scr, F.lane); continue; } r -= I2;
            if (r < I3) { const int kb = r / 16, nb = r % 16; transpose_item(F.w_so, D, 64 * kb, 64 * nb, (bf16_t*)(F.ws + WS_WSO), (size_t)(64 * nb), SWD, scr, F.lane); continue; } r -= I3;
            { const int kb = r / 16, nb = r % 16; transpose_item(F.w_out, D, 64 * kb, 64 * nb, (bf16_t*)(F.ws + WS_WOUT), (size_t)(64 * nb), D, scr, F.lane); }
        }
    }
    if (parts & 4) {
        bf16_t* HN = (bf16_t*)(F.ws + WS_HN);
        f32x4 gg[4];
#pragma unroll
        for (int j = 0; j < 4; ++j) gg[j] = ((const f32x4*)F.norm1_g)[64 * j + F.lane];
        for (int m4 = gw; m4 < MTOK / 4; m4 += NGW) rms_rows4_to_bf16(F.x + (size_t)m4 * 4 * D, gg, HN + (size_t)m4 * 4 * D, F.lane);
    }
    if (parts & 8) {
        bf16_t* MA = (bf16_t*)(F.ws + WS_MA); bf16_t* MB = (bf16_t*)(F.ws + WS_MB);
        const int gt = F.bid * 512 + F.tid, NT = F.G * 512;
        for (int i = gt; i < 32 * 4 * 16; i += NT) {
            const int e = i & 15, kg = (i >> 4) & 3, ks = i >> 6; const int d0 = 32 * ks + 8 * kg;
            bf16x8 hi, lo;
#pragma unroll
            for (int j = 0; j < 8; ++j) { const float w = F.norm2_g[d0 + j] * F.w_router[(size_t)(d0 + j) * 16 + e]; const unsigned h = f2bf(w); hi[j] = (short)h; lo[j] = (short)f2bf(w - __builtin_bit_cast(float, h << 16)); }
            ((bf16x8*)(F.ws + WS_WRT))[i] = hi; ((bf16x8*)(F.ws + WS_WRT))[2048 + i] = lo;
        }
        for (int i = gt; i < 256 * 128; i += NT) {
            const int jp = i >> 7, c = i & 127; const float a = (float)(((jp & 127) * c) & 127) * (1.0f / 64.0f);
            ((bf16_t*)(F.ws + WS_CST))[i] = (bf16_t)f2bf((jp < 128 ? cospif(a) : sinpif(a)) * 0.08838834764831845f);
        }
        for (int q = gt; q < 128 * 128 + 64 * 128; q += NT) {
            if (q < 128 * 128) { const int o = q >> 7, k = q & 127, kl = o >> 1, ri = o & 1, sh = k >> 1, half = k & 1; const float a = (float)((kl * sh) & 63) * (1.0f / 32.0f);
                const float C = cospif(a), S = sinpif(a); const float v = (ri == 0) ? (half == 0 ? C : -S) : (half == 0 ? -S : -C); MA[q] = (bf16_t)f2bf(v * 0.125f); }
            else { const int qq = q - 128 * 128, kh = qq >> 7, k = qq & 127, sl = k >> 1, ri = k & 1; const float a = (float)((kh * sl) & 63) * (1.0f / 32.0f);
                MB[qq] = (bf16_t)f2bf((ri == 0 ? cospif(a) : sinpif(a)) * 0.125f); }
        }
    }
}

struct Sched1 {
    const char* A; const char* B; int G, c;
    __device__ __forceinline__ bool next(int i, Unit& u) const {
        int pm, pn; if (!pg8::static_tile(MTOK / 256, N1 / 256, G, c, i, pm, pn)) return false;
        u.A = A + (size_t)pm * 256 * D * 2; u.B = B + (size_t)pn * 256 * D * 2; u.ridx = nullptr; u.pm = pm; u.pn = pn; u.kind = 0; return true;
    }
};
struct Epi1 {
    static constexpr bool PERM = true;
    unsigned char* ws;
    __device__ __forceinline__ bool operator()(f32x4 (&acc)[2][2][4][2], const Unit& u, int wr, int wc, int fr, int fq) const {
        const int pn = u.pn;
        if (pn < 2) {
            bf16_t* Z = (bf16_t*)(ws + WS_YF);
            const int b = u.pm >> 4;
#pragma unroll
            for (int ai = 0; ai < 2; ++ai)
#pragma unroll
                for (int m = 0; m < 4; ++m) { const int s_lo = m * 16 + fr, s_hi = (u.pm & 15) * 4 + ai * 2 + wr;
#pragma unroll
                    for (int bj = 0; bj < 2; ++bj) { const f32x4 v0 = acc[ai][bj][m][0], v1 = acc[ai][bj][m][1];
                        u32x4 w; w.x = cvt_pk_bf16(v0[0], v0[1]); w.y = cvt_pk_bf16(v0[2], v0[3]); w.z = cvt_pk_bf16(v1[0], v1[1]); w.w = cvt_pk_bf16(v1[2], v1[3]);
                        *(u32x4*)(Z + ((size_t)((b * 4 + 2 * pn + bj) * 64 + s_lo) * 64 + s_hi) * 128 + wc * 32 + 8 * fq) = w; } }
            return false;
        }
        const int row0 = u.pm * 256 + wr * 64 + fr;
        if (pn >= 6) {
            bf16_t* RHO = (bf16_t*)(ws + WS_SGF); bf16_t* SGS = (bf16_t*)(ws + WS_SGS);
            const int col0 = (pn - 6) * 128 + wc * 32 + 8 * fq;
#pragma unroll
            for (int ai = 0; ai < 2; ++ai)
#pragma unroll
                for (int m = 0; m < 4; ++m) { const size_t off = (size_t)(row0 + ai * 128 + m * 16) * 1024 + col0;
                    float rho[8], sg[8];
#pragma unroll
                    for (int n = 0; n < 2; ++n)
#pragma unroll
                        for (int j = 0; j < 4; ++j) { const float ef = __builtin_amdgcn_exp2f(-1.44269504089f * acc[ai][0][m][n][j]), es = __builtin_amdgcn_exp2f(-1.44269504089f * acc[ai][1][m][n][j]);
                            const float s_ = __builtin_amdgcn_rcpf(1.0f + es); sg[n * 4 + j] = s_; rho[n * 4 + j] = (1.0f + es) * __builtin_amdgcn_rcpf(1.0f + ef); }
                    u32x4 w; w.x = cvt_pk_bf16(rho[0], rho[1]); w.y = cvt_pk_bf16(rho[2], rho[3]); w.z = cvt_pk_bf16(rho[4], rho[5]); w.w = cvt_pk_bf16(rho[6], rho[7]);
                    *(u32x4*)(RHO + off) = w;
                    w.x = cvt_pk_bf16(sg[0], sg[1]); w.y = cvt_pk_bf16(sg[2], sg[3]); w.z = cvt_pk_bf16(sg[4], sg[5]); w.w = cvt_pk_bf16(sg[6], sg[7]);
                    *(u32x4*)(SGS + off) = w; }
            return false;
        }
        bf16_t* base = (bf16_t*)(ws + (pn < 4 ? WS_GU : WS_GV)); const int colt = (pn & 1) * 256;
        const int col0 = colt + wc * 32 + 8 * fq;
#pragma unroll
        for (int ai = 0; ai < 2; ++ai)
#pragma unroll
            for (int m = 0; m < 4; ++m) { bf16_t* rowp = base + (size_t)(row0 + ai * 128 + m * 16) * 512 + col0;
#pragma unroll
                for (int bj = 0; bj < 2; ++bj) { f32x4 v0 = acc[ai][bj][m][0], v1 = acc[ai][bj][m][1];
#pragma unroll
                    for (int j = 0; j < 4; ++j) { v0[j] = gelu_tanh(v0[j]); v1[j] = gelu_tanh(v1[j]); }
                    u32x4 w; w.x = cvt_pk_bf16(v0[0], v0[1]); w.y = cvt_pk_bf16(v0[2], v0[3]); w.z = cvt_pk_bf16(v1[0], v1[1]); w.w = cvt_pk_bf16(v1[2], v1[3]);
                    *(u32x4*)(rowp + bj * 128) = w; } }
        return false;
    }
};

__device__ __forceinline__ void p2_sgu(const Ctx& F) {
    constexpr int PITCH = 136;
    LAS bf16_t* Ws = (LAS bf16_t*)(F.lds);
    LAS bf16_t* Vt = (LAS bf16_t*)(F.lds + 128 * PITCH * 2);
    const bf16_t* GU = (const bf16_t*)(F.ws + WS_GU); const bf16_t* GV = (const bf16_t*)(F.ws + WS_GV); bf16_t* SG = (bf16_t*)(F.ws + WS_SG);
    const int lane = F.lane, wave = F.wave, cp = lane & 15, rs4 = lane >> 4;
    int h_loaded = -1;
    u32x4 raw[4]; u32x2 uu[8];
    if (F.bid < 1024) { const int h = F.bid & 3; const size_t r0 = (size_t)(F.bid >> 2) * 128;
#pragma unroll
        for (int i = 0; i < 4; ++i) raw[i] = __builtin_nontemporal_load((const u32x4*)(GV + (r0 + wave * 16 + i * 4 + rs4) * 512 + h * 128 + 8 * cp));
#pragma unroll
        for (int ct = 0; ct < 8; ++ct) uu[ct] = __builtin_nontemporal_load((const u32x2*)(GU + (r0 + wave * 16 + (lane & 15)) * 512 + h * 128 + ct * 16 + 4 * (lane >> 4))); }
    for (int tt = F.bid; tt < 1024; tt += F.G) {
        const int h = tt & 3, bn = tt >> 2; const size_t r0 = (size_t)bn * 128;
        __syncthreads();
        if (h != h_loaded) {
            const float* wsrc = F.w_sp + (size_t)h * 128 * 128;
#pragma unroll
            for (int i = 0; i < 8; ++i) { const int idx = F.tid * 4 + i * 2048; const int p = idx >> 7, q = idx & 127; const f32x4 v = *(const f32x4*)(wsrc + idx);
                u32x2 w; w.x = pk2(v.x, v.y); w.y = pk2(v.z, v.w); *(LAS u32x2*)(Ws + p * PITCH + q) = w; }
            h_loaded = h;
        }
        { const f32x4 g0v = *(const f32x4*)(F.ln_g + h * 128 + 8 * cp), g1v = *(const f32x4*)(F.ln_g + h * 128 + 8 * cp + 4), b0v = *(const f32x4*)(F.ln_b + h * 128 + 8 * cp), b1v = *(const f32x4*)(F.ln_b + h * 128 + 8 * cp + 4);
#pragma unroll
          for (int i = 0; i < 4; ++i) { const int q = wave * 16 + i * 4 + rs4;
              float x[8] = {bf_lo(raw[i].x), bf_hi(raw[i].x), bf_lo(raw[i].y), bf_hi(raw[i].y), bf_lo(raw[i].z), bf_hi(raw[i].z), bf_lo(raw[i].w), bf_hi(raw[i].w)};
              float sm = ((x[0] + x[1]) + (x[2] + x[3])) + ((x[4] + x[5]) + (x[6] + x[7]));
#pragma unroll
              for (int o = 1; o < 16; o <<= 1) sm += __shfl_xor(sm, o);
              const float mu = sm * (1.0f / 128.0f); float sq = 0.f;
#pragma unroll
              for (int j = 0; j < 8; ++j) { x[j] -= mu; sq += x[j] * x[j]; }
#pragma unroll
              for (int o = 1; o < 16; o <<= 1) sq += __shfl_xor(sq, o);
              const float rs = 1.0f / sqrtf(sq * (1.0f / 128.0f) + EPS);
              const float gq[8] = {g0v.x, g0v.y, g0v.z, g0v.w, g1v.x, g1v.y, g1v.z, g1v.w}, bq[8] = {b0v.x, b0v.y, b0v.z, b0v.w, b1v.x, b1v.y, b1v.z, b1v.w};
#pragma unroll
              for (int j = 0; j < 8; ++j) Vt[(8 * cp + j) * PITCH + (q ^ (cp << 3))] = (bf16_t)f2bf(x[j] * rs * gq[j] + bq[j]); } }
        const int p = wave * 16 + (lane & 15);
        u32x2 uc[8];
#pragma unroll
        for (int ct = 0; ct < 8; ++ct) uc[ct] = uu[ct];
        if (tt + F.G < 1024) { const int tn = tt + F.G, hn = tn & 3; const size_t rn = (size_t)(tn >> 2) * 128;
#pragma unroll
            for (int i = 0; i < 4; ++i) raw[i] = __builtin_nontemporal_load((const u32x4*)(GV + (rn + wave * 16 + i * 4 + rs4) * 512 + hn * 128 + 8 * cp));
#pragma unroll
            for (int ct = 0; ct < 8; ++ct) uu[ct] = __builtin_nontemporal_load((const u32x2*)(GU + (rn + p) * 512 + hn * 128 + ct * 16 + 4 * (lane >> 4))); }
        __syncthreads();
        f32x4 acc[8];
#pragma unroll
        for (int ct = 0; ct < 8; ++ct) acc[ct] = (f32x4){0.f, 0.f, 0.f, 0.f};
#pragma unroll
        for (int ks = 0; ks < 4; ++ks) {
            const bf16x8 bw = *(const LAS bf16x8*)(Ws + (wave * 16 + (lane & 15)) * PITCH + ks * 32 + 8 * (lane >> 4));
#pragma unroll
            for (int ct = 0; ct < 8; ++ct) { const int c_ = ct * 16 + (lane & 15); const bf16x8 av = *(const LAS bf16x8*)(Vt + c_ * PITCH + ((ks * 32 + 8 * (lane >> 4)) ^ (((c_ >> 3) & 15) << 3)));
                acc[ct] = __builtin_amdgcn_mfma_f32_16x16x32_bf16(av, bw, acc[ct], 0, 0, 0); }
        }
        const float bs = F.b_sp[h * 128 + p];
#pragma unroll
        for (int ct = 0; ct < 8; ++ct) { const size_t off = (r0 + p) * 512 + h * 128 + ct * 16 + 4 * (lane >> 4);
            u32x2 o; o.x = pk2(bf_lo(uc[ct].x) * (acc[ct][0] + bs), bf_hi(uc[ct].x) * (acc[ct][1] + bs)); o.y = pk2(bf_lo(uc[ct].y) * (acc[ct][2] + bs), bf_hi(uc[ct].y) * (acc[ct][3] + bs));
            *(u32x2*)(SG + off) = o; }
    }
    __syncthreads();
}

typedef short s16x4 __attribute__((ext_vector_type(4)));
template <int STAGE>
__device__ __forceinline__ void fft_stage(const Ctx& F) {
    constexpr int OPITCH = 272;
    constexpr int OBYTES = 128 * OPITCH;
    constexpr int IMG = (STAGE == 0) ? 16384 : 32768;
    constexpr int NDMA = IMG / 8192;
    LAS unsigned char* lds = F.lds;
    const int lane = F.lane, wave = F.wave, tid = F.tid, l15 = lane & 15;
    const int G = lane >> 4, q = (lane >> 2) & 3, p = lane & 3, fsw = q | ((G & 1) << 2);
    const bf16_t* MAT = (const bf16_t*)(F.ws + (STAGE == 0 ? WS_MA : WS_MB));
    const bf16_t* SRC = (const bf16_t*)(F.ws + (STAGE == 0 ? WS_YF : WS_AP));
    const int mt = (STAGE == 0) ? wave : (wave & 3);
    constexpr int NJT = (STAGE == 0) ? 8 : 4;
    const int jt0 = (STAGE == 0) ? 0 : 4 * (wave >> 2);
    bf16x8 afr[4];
#pragma unroll
    for (int ks = 0; ks < 4; ++ks) afr[ks] = *(const bf16x8*)(MAT + (size_t)(mt * 16 + l15) * 128 + ks * 32 + 8 * G);
    bf16x8 bcs[2][4];
    if constexpr (STAGE == 0) {
#pragma unroll
        for (int t2 = 0; t2 < 2; ++t2)
#pragma unroll
            for (int ks = 0; ks < 4; ++ks) bcs[t2][ks] = *(const bf16x8*)((const bf16_t*)(F.ws + WS_CST) + (size_t)(16 * (2 * wave + t2) + l15) * 128 + ks * 32 + 8 * G);
    }
    unsigned soff[NDMA];
#pragma unroll
    for (int i = 0; i < NDMA; ++i) { const int pos = i * 512 + tid, row = pos >> 4, cp = pos & 15; const int f = (row & 3) | (((row >> 3) & 1) << 2);
        soff[i] = (unsigned)(row * 256 + ((STAGE == 0 ? (cp ^ (row & 15)) : (cp ^ (f << 1))) << 4)); }
    const unsigned rbase = (unsigned)((8 * G + q) * 256 + p * 8);
#define FFT_DMA(buf, t) do { const char* src_ = (const char*)SRC + (size_t)(t) * IMG; _Pragma("unroll") for (int i_ = 0; i_ < NDMA; ++i_) \
        __builtin_amdgcn_global_load_lds((const unsigned*)(src_ + soff[i_]), (LAS unsigned*)(lds + (buf) * IMG + i_ * 8192 + wave * 1024), 16, 0, 2); } while (0)
#define FFT_STORE(tp, ob) do { const int bg_ = (tp) >> 6, lo6_ = (tp) & 63; \
        if constexpr (STAGE == 0) { bf16_t* AP = (bf16_t*)(F.ws + WS_AP); _Pragma("unroll") for (int i_ = 0; i_ < 4; ++i_) { const int id_ = tid + 512 * i_, row_ = id_ >> 4, c_ = id_ & 15; \
                const u32x4 v_ = *(const LAS u32x4*)((ob) + row_ * OPITCH + c_ * 16); \
                *(u32x4*)(AP + ((size_t)(bg_ * 64 + (row_ >> 1)) * 64 + lo6_) * 256 + (row_ & 1) * 128 + c_ * 8) = v_; } } \
        else { bf16_t* FM = (bf16_t*)(F.ws + WS_FM); _Pragma("unroll") for (int i_ = 0; i_ < 2; ++i_) { const int id_ = tid + 512 * i_, row_ = id_ >> 4, c_ = id_ & 15; \
                const u32x4 v_ = *(const LAS u32x4*)((ob) + row_ * OPITCH + c_ * 16); \
                *(u32x4*)(FM + ((size_t)(bg_ >> 2) * SEQ + lo6_ + 64 * row_) * FW + (bg_ & 3) * 128 + c_ * 8) = v_; } } } while (0)
    int t = F.bid, buf = 0, tprev = -1;
    if (t < 2048) FFT_DMA(0, t);
    for (; t < 2048; tprev = t, t += F.G, buf ^= 1) {
        asm volatile("s_waitcnt vmcnt(0) lgkmcnt(0)" ::: "memory");
        __builtin_amdgcn_s_barrier();
        asm volatile("" ::: "memory");
        if (t + F.G < 2048) FFT_DMA(buf ^ 1, t + F.G);
        if (tprev >= 0) FFT_STORE(tprev, lds + 65536 + (buf ^ 1) * OBYTES);
        const LAS unsigned char* xb;
        if constexpr (STAGE == 0) {
            const LAS unsigned char* zb = lds + buf * IMG;
            f32x4 a1[4][2];
#pragma unroll
            for (int st = 0; st < 4; ++st) { a1[st][0] = (f32x4){0.f, 0.f, 0.f, 0.f}; a1[st][1] = (f32x4){0.f, 0.f, 0.f, 0.f}; }
#pragma unroll
            for (int ks = 0; ks < 4; ++ks)
#pragma unroll
                for (int st = 0; st < 4; ++st) { const bf16x8 az = *(const LAS bf16x8*)(zb + (16 * st + l15) * 256 + (((4 * ks + G) ^ l15) << 4));
                    a1[st][0] = __builtin_amdgcn_mfma_f32_16x16x32_bf16(az, bcs[0][ks], a1[st][0], 0, 0, 0);
                    a1[st][1] = __builtin_amdgcn_mfma_f32_16x16x32_bf16(az, bcs[1][ks], a1[st][1], 0, 0, 0); }
            LAS unsigned char* xw = lds + 32768;
#pragma unroll
            for (int t2 = 0; t2 < 2; ++t2) { const int jt = 2 * wave + t2, half = jt >> 3, j = 16 * (jt & 7) + l15;
#pragma unroll
                for (int st = 0; st < 4; ++st)
#pragma unroll
                    for (int r = 0; r < 4; ++r) { const int k = 2 * (16 * st + 4 * G + r) + half; const int f = (k & 3) | (((k >> 3) & 1) << 2);
                        *(LAS bf16_t*)(xw + k * 256 + ((((j >> 3) ^ (f << 1))) << 4) + (j & 7) * 2) = (bf16_t)f2bf(a1[st][t2][r]); } }
            asm volatile("s_waitcnt lgkmcnt(0)" ::: "memory");
            __builtin_amdgcn_s_barrier();
            asm volatile("" ::: "memory");
            xb = lds + 32768 + rbase;
        } else {
            xb = lds + buf * IMG + rbase;
        }
        f32x4 acc[NJT];
#pragma unroll
        for (int jt = 0; jt < NJT; ++jt) acc[jt] = (f32x4){0.f, 0.f, 0.f, 0.f};
#pragma unroll
        for (int ks = 0; ks < 4; ++ks)
#pragma unroll
            for (int jt = 0; jt < NJT; ++jt) {
                const unsigned o = (unsigned)(ks * 32 * 256) + ((unsigned)(((jt0 + jt) ^ fsw)) << 5);
                const s16x4 lo = __builtin_amdgcn_ds_read_tr16_b64_v4i16((LAS s16x4*)(xb + o));
                const s16x4 hi = __builtin_amdgcn_ds_read_tr16_b64_v4i16((LAS s16x4*)(xb + o + 4 * 256));
                bf16x8 bfr; bfr[0] = lo[0]; bfr[1] = lo[1]; bfr[2] = lo[2]; bfr[3] = lo[3]; bfr[4] = hi[0]; bfr[5] = hi[1]; bfr[6] = hi[2]; bfr[7] = hi[3];
                acc[jt] = __builtin_amdgcn_mfma_f32_16x16x32_bf16(afr[ks], bfr, acc[jt], 0, 0, 0);
            }
        LAS unsigned char* ob = lds + 65536 + buf * OBYTES;
        if constexpr (STAGE == 0) {
            const int s_lo = t & 63, kl0 = 8 * wave + 2 * G;
            float c0, s0, c1, s1;
            sincospif((float)((kl0 * s_lo) & 4095) * (1.0f / 2048.0f), &s0, &c0);
            sincospif((float)(((kl0 + 1) * s_lo) & 4095) * (1.0f / 2048.0f), &s1, &c1);
#pragma unroll
            for (int jt = 0; jt < NJT; ++jt) { const f32x4 a = acc[jt]; const int col = 16 * jt + l15;
                LAS bf16_t* o0 = (LAS bf16_t*)(ob + (mt * 16 + 4 * G) * OPITCH) + col;
                o0[0 * (OPITCH / 2)] = (bf16_t)f2bf(a[0] * c0 + a[1] * s0); o0[1 * (OPITCH / 2)] = (bf16_t)f2bf(a[1] * c0 - a[0] * s0);
                o0[2 * (OPITCH / 2)] = (bf16_t)f2bf(a[2] * c1 + a[3] * s1); o0[3 * (OPITCH / 2)] = (bf16_t)f2bf(a[3] * c1 - a[2] * s1); }
        } else {
#pragma unroll
            for (int jt = 0; jt < NJT; ++jt) { const f32x4 a = acc[jt]; const int col = 16 * (jt0 + jt) + l15;
                LAS bf16_t* o0 = (LAS bf16_t*)(ob + (mt * 16 + 4 * G) * OPITCH) + col;
#pragma unroll
                for (int r = 0; r < 4; ++r) o0[r * (OPITCH / 2)] = (bf16_t)f2bf(a[r]); }
        }
    }
    asm volatile("s_waitcnt lgkmcnt(0)" ::: "memory");
    __builtin_amdgcn_s_barrier();
    asm volatile("" ::: "memory");
    if (tprev >= 0) FFT_STORE(tprev, lds + 65536 + (buf ^ 1) * OBYTES);
    asm volatile("s_waitcnt vmcnt(0) lgkmcnt(0)" ::: "memory");
    __builtin_amdgcn_s_barrier();
#undef FFT_STORE
#undef FFT_DMA
}

struct Sched3 {
    const char* A0; const char* A1; const char* B0; const char* B1; int G, c;
    __device__ __forceinline__ bool next(int i, Unit& u) const {
        int pm, pn; if (!pg8::static_tile(MTOK / 256, D / 256, G, c, i >> 1, pm, pn)) return false;
        const int sub = i & 1;
        u.A = (sub ? A1 : A0) + (size_t)pm * 256 * 512 * 2; u.B = (sub ? B1 : B0) + (size_t)pn * 256 * 512 * 2; u.ridx = nullptr; u.pm = pm; u.pn = pn; u.kind = sub; return true;
    }
};
struct Epi3 {
    static constexpr bool PERM = true;
    const bf16_t* RHO; const bf16_t* SGS; bf16_t* MRG;
    __device__ __forceinline__ bool operator()(f32x4 (&acc)[2][2][4][2], const Unit& u, int wr, int wc, int fr, int fq) const {
        const int row0 = u.pm * 256 + wr * 64 + fr, col0 = u.pn * 256 + wc * 32 + 8 * fq;
        const bf16_t* G = (u.kind == 0) ? RHO : SGS;
        u32x4 g[2][4][2];
#pragma unroll
        for (int ai = 0; ai < 2; ++ai)
#pragma unroll
            for (int m = 0; m < 4; ++m)
#pragma unroll
                for (int bj = 0; bj < 2; ++bj) g[ai][m][bj] = __builtin_nontemporal_load((const u32x4*)(G + (size_t)(row0 + ai * 128 + m * 16) * D + col0 + bj * 128));
#pragma unroll
        for (int ai = 0; ai < 2; ++ai)
#pragma unroll
            for (int m = 0; m < 4; ++m)
#pragma unroll
                for (int bj = 0; bj < 2; ++bj) { const u32x4 s = g[ai][m][bj]; f32x4& v0 = acc[ai][bj][m][0]; f32x4& v1 = acc[ai][bj][m][1];
                    v0[0] *= bf_lo(s.x); v0[1] *= bf_hi(s.x); v0[2] *= bf_lo(s.y); v0[3] *= bf_hi(s.y); v1[0] *= bf_lo(s.z); v1[1] *= bf_hi(s.z); v1[2] *= bf_lo(s.w); v1[3] *= bf_hi(s.w);
                    if (u.kind != 0) { u32x4 w; w.x = cvt_pk_bf16(v0[0], v0[1]); w.y = cvt_pk_bf16(v0[2], v0[3]); w.z = cvt_pk_bf16(v1[0], v1[1]); w.w = cvt_pk_bf16(v1[2], v1[3]);
                        *(u32x4*)(MRG + (size_t)(row0 + ai * 128 + m * 16) * D + col0 + bj * 128) = w; } }
        return u.kind == 0;
    }
};

struct Sched4 {
    const char* A; const char* B; int G, c;
    __device__ __forceinline__ bool next(int i, Unit& u) const {
        int pm, pn; if (!pg8::static_tile(MTOK / 256, D / 256, G, c, i, pm, pn)) return false;
        u.A = A + (size_t)pm * 256 * D * 2; u.B = B + (size_t)pn * 256 * D * 2; u.ridx = nullptr; u.pm = pm; u.pn = pn; u.kind = 0; return true;
    }
};
struct Epi4 {
    static constexpr bool PERM = true;
    bf16_t* DLT;
    __device__ __forceinline__ bool operator()(f32x4 (&acc)[2][2][4][2], const Unit& u, int wr, int wc, int fr, int fq) const {
        const int row0 = u.pm * 256 + wr * 64 + fr, col0 = u.pn * 256 + wc * 32 + 8 * fq;
#pragma unroll
        for (int ai = 0; ai < 2; ++ai)
#pragma unroll
            for (int m = 0; m < 4; ++m) { bf16_t* rowp = DLT + (size_t)(row0 + ai * 128 + m * 16) * D + col0;
#pragma unroll
                for (int bj = 0; bj < 2; ++bj) { const f32x4 v0 = acc[ai][bj][m][0], v1 = acc[ai][bj][m][1];
                    u32x4 w; w.x = cvt_pk_bf16(v0[0], v0[1]); w.y = cvt_pk_bf16(v0[2], v0[3]); w.z = cvt_pk_bf16(v1[0], v1[1]); w.w = cvt_pk_bf16(v1[2], v1[3]);
                    *(u32x4*)(rowp + bj * 128) = w; } }
        return false;
    }
};

__device__ __forceinline__ void p5_rows(const Ctx& F, const int parts) {
    LAS float* scr = (LAS float*)(F.lds + F.wave * 16384);
    const int gw = F.bid * 8 + F.wave, NGW = F.G * 8;
    if (!(parts & 2)) return;
    LAS bf16x8* WB = (LAS bf16x8*)F.lds;
    LAS float* G2L = (LAS float*)(F.lds + 65536);
    for (int i = F.tid; i < 4096; i += 512) WB[i] = ((const bf16x8*)(F.ws + WS_WRT))[i];
    for (int i = F.tid; i < 256; i += 512) ((LAS f32x4*)G2L)[i] = ((const f32x4*)F.norm2_g)[i];
    __syncthreads();
    const float* X1 = F.x; const bf16_t* DLT = (const bf16_t*)(F.ws + WS_DLT); unsigned char* H2 = (unsigned char*)(F.ws + WS_H2); float* AFF = (float*)(F.ws + WS_AFF); float* RSTD = (float*)(F.ws + WS_RSTD);
    const int lane = F.lane, row = lane & 15, kg = lane >> 4;
    for (int task = gw; task < MTOK / 16; task += NGW) {
        const size_t r0 = (size_t)task * 16;
        const float* xp = X1 + (r0 + row) * D + 8 * kg; const bf16_t* dp = DLT + (r0 + row) * D + 8 * kg;
        unsigned char* hp = H2 + (r0 + row) * D + 8 * kg;
        f32x4 acc = (f32x4){0.f, 0.f, 0.f, 0.f}; float ss = 0.f;
#define ROWS_LOAD(XA, XB, DD, c) do { _Pragma("unroll") for (int u = 0; u < 4; ++u) { XA[u] = __builtin_nontemporal_load((const f32x4*)(xp + ((c) * 4 + u) * 32)); XB[u] = __builtin_nontemporal_load((const f32x4*)(xp + ((c) * 4 + u) * 32 + 4)); DD[u] = __builtin_nontemporal_load((const u32x4*)(dp + ((c) * 4 + u) * 32)); } } while (0)
#define ROWS_PROC(XA, XB, DD, c) do { _Pragma("unroll") for (int u = 0; u < 4; ++u) { \
            const int ks = (c) * 4 + u; \
            const f32x4 a = XA[u] + (f32x4){bf_lo(DD[u].x), bf_hi(DD[u].x), bf_lo(DD[u].y), bf_hi(DD[u].y)}, b = XB[u] + (f32x4){bf_lo(DD[u].z), bf_hi(DD[u].z), bf_lo(DD[u].w), bf_hi(DD[u].w)};     \
            ss += (a.x * a.x + a.y * a.y) + (a.z * a.z + a.w * a.w) + (b.x * b.x + b.y * b.y) + (b.z * b.z + b.w * b.w); \
            const f32x4 ga = *(const LAS f32x4*)(G2L + 32 * ks + 8 * kg), gb = *(const LAS f32x4*)(G2L + 32 * ks + 8 * kg + 4); \
            u32x2 h8; h8.x = pk4_fp8(a.x * ga.x, a.y * ga.y, a.z * ga.z, a.w * ga.w); h8.y = pk4_fp8(b.x * gb.x, b.y * gb.y, b.z * gb.z, b.w * gb.w); \
            *(u32x2*)(hp + 32 * ks) = h8; \
            u32x4 hw, lw; \
            hw.x = cvt_pk_bf16(a.x, a.y); hw.y = cvt_pk_bf16(a.z, a.w); hw.z = cvt_pk_bf16(b.x, b.y); hw.w = cvt_pk_bf16(b.z, b.w); \
            lw.x = cvt_pk_bf16(a.x - bf_lo(hw.x), a.y - bf_hi(hw.x)); lw.y = cvt_pk_bf16(a.z - bf_lo(hw.y), a.w - bf_hi(hw.y)); \
            lw.z = cvt_pk_bf16(b.x - bf_lo(hw.z), b.y - bf_hi(hw.z)); lw.w = cvt_pk_bf16(b.z - bf_lo(hw.w), b.w - bf_hi(hw.w)); \
            const bf16x8 xh = __builtin_bit_cast(bf16x8, hw), xl = __builtin_bit_cast(bf16x8, lw); \
            const bf16x8 wh = WB[(ks * 4 + kg) * 16 + row], wl = WB[2048 + (ks * 4 + kg) * 16 + row];     \
            acc = __builtin_amdgcn_mfma_f32_16x16x32_bf16(xh, wh, acc, 0, 0, 0); \
            acc = __builtin_amdgcn_mfma_f32_16x16x32_bf16(xl, wh, acc, 0, 0, 0); \
            acc = __builtin_amdgcn_mfma_f32_16x16x32_bf16(xh, wl, acc, 0, 0, 0); } } while (0)
        f32x4 xaA[4], xbA[4], xaB[4], xbB[4]; u32x4 ddA[4], ddB[4];
        ROWS_LOAD(xaA, xbA, ddA, 0);
#pragma unroll 1
        for (int kc = 0; kc < 8; kc += 2) {
            ROWS_LOAD(xaB, xbB, ddB, kc + 1);
            ROWS_PROC(xaA, xbA, ddA, kc);
            if (kc + 2 < 8) ROWS_LOAD(xaA, xbA, ddA, kc + 2);
            ROWS_PROC(xaB, xbB, ddB, kc + 1);
        }
#undef ROWS_LOAD
#undef ROWS_PROC
        ss += __shfl_xor(ss, 16); ss += __shfl_xor(ss, 32);
        const float rstd = 1.0f / sqrtf(ss * (1.f / D) + EPS);
        if (kg == 0) RSTD[r0 + row] = rstd;
#pragma unroll
        for (int r = 0; r < 4; ++r) {
            const float lg = acc[r] * __shfl(rstd, 4 * kg + r);
            float mx = lg;
#pragma unroll
            for (int o = 1; o < 16; o <<= 1) mx = fmaxf(mx, __shfl_xor(mx, o));
            const float pe = __expf(lg - mx); float den = pe;
#pragma unroll
            for (int o = 1; o < 16; o <<= 1) den += __shfl_xor(den, o);
            AFF[(r0 + 4 * kg + r) * 16 + row] = pe / den;
        }
    }
    __syncthreads();
}

__device__ __forceinline__ void p6_topk(const Ctx& F) {
    LAS unsigned* cnt = (LAS unsigned*)F.lds;
    const float* AFF = (const float*)(F.ws + WS_AFF);
    int* IDX = (int*)(F.ws + WS_IDX); float* GATE = (float*)(F.ws + WS_GATE); unsigned short* INV = (unsigned short*)(F.ws + WS_INV);
    const int lane = F.lane, wave = F.wave, tid = F.tid;
    for (int item = F.bid; item < NB * NE; item += F.G) {
        const int b = item >> 4, e = item & 15;
        unsigned key[8];
#pragma unroll
        for (int i = 0; i < 8; ++i) key[i] = __builtin_bit_cast(unsigned, AFF[((size_t)b * SEQ + 8 * tid + i) * 16 + e]);
        __syncthreads();
        unsigned T = 0u;
        for (int bit = 30; bit >= 0; --bit) {
            const unsigned cand = T | (1u << bit);
            unsigned c = 0;
#pragma unroll
            for (int i = 0; i < 8; ++i) c += (unsigned)__popcll(__ballot(key[i] >= cand));
            LAS unsigned* cb = cnt + (bit & 1) * 8;
            if (lane == 0) cb[wave] = c;
            __syncthreads();
            unsigned tot = 0;
#pragma unroll
            for (int w = 0; w < 8; ++w) tot += cb[w];
            if (tot >= (unsigned)CAP) T = cand;
        }
        __syncthreads();
        unsigned ngt_w = 0;
        int neq_t = 0;
#pragma unroll
        for (int i = 0; i < 8; ++i) { ngt_w += (unsigned)__popcll(__ballot(key[i] > T)); neq_t += (key[i] == T) ? 1 : 0; }
        LAS unsigned* sc = cnt + 16;
        int incl = neq_t;
#pragma unroll
        for (int o = 1; o < 64; o <<= 1) { const int t = __shfl_up(incl, o); if (lane >= o) incl += t; }
        if (lane == 63) sc[wave] = (unsigned)incl;
        if (lane == 0) sc[16 + wave] = ngt_w;
        __syncthreads();
        unsigned eq_base = 0, ngt = 0;
#pragma unroll
        for (int w = 0; w < 8; ++w) { eq_base += (w < wave) ? sc[w] : 0u; ngt += sc[16 + w]; }
        const int need = CAP - (int)ngt;
        int eq_rank = (int)eq_base + incl - neq_t;
        unsigned selm = 0; int nsel = 0;
#pragma unroll
        for (int i = 0; i < 8; ++i) { bool s = key[i] > T; if (key[i] == T) { s = eq_rank < need; ++eq_rank; } if (s) { selm |= 1u << i; ++nsel; } }
        int incl2 = nsel;
#pragma unroll
        for (int o = 1; o < 64; o <<= 1) { const int t = __shfl_up(incl2, o); if (lane >= o) incl2 += t; }
        if (lane == 63) sc[8 + wave] = (unsigned)incl2;
        __syncthreads();
        unsigned sbase = 0;
#pragma unroll
        for (int w = 0; w < 8; ++w) sbase += (w < wave) ? sc[8 + w] : 0u;
        int slot = (int)sbase + incl2 - nsel;
#pragma unroll
        for (int i = 0; i < 8; ++i) { const int tok = 8 * tid + i; unsigned short iv = 0xFFFFu;
            if (selm & (1u << i)) { IDX[(size_t)item * CAP + slot] = tok; GATE[(size_t)item * CAP + slot] = __builtin_bit_cast(float, key[i]); iv = (unsigned short)slot; ++slot; }
            INV[((size_t)b * SEQ + tok) * 16 + e] = iv; }
        __syncthreads();
    }
}

struct Sched7 {
    const char* H2; const char* WG; const int* IDX; int G, c;
    __device__ __forceinline__ bool next(int i, Unit& u) const {
        if (i >= 16) return false;
        const int e = i, x = c & 7, j = c >> 3;
        const int mt = (x >> 1) * 4 + (j & 3), nt = (x & 1) * 8 + (j >> 2);
        const int b = mt >> 1;
        u.A = H2 + (size_t)b * SEQ * D; u.B = WG + ((size_t)e * 4096 + (size_t)nt * 256) * D;
        u.ridx = IDX + ((size_t)(b * NE + e) * CAP + (mt & 1) * 256); u.pm = e * 16 + mt; u.pn = nt; u.kind = 0; return true;
    }
};
struct Epi7 {
    static constexpr bool PERM = true;
    unsigned char* H; const float* RSTD;
    __device__ __forceinline__ bool operator()(f32x4 (&acc)[2][2][4][2], const Unit& u, int wr, int wc, int fr, int fq) const {
        const int row0 = u.pm * 256 + wr * 64 + fr, col0 = u.pn * 128 + wc * 32 + 8 * fq;
        const int b = (u.pm & 15) >> 1;
        int tok[8]; float rs[8];
#pragma unroll
        for (int i = 0; i < 8; ++i) tok[i] = u.ridx[(i >> 2) * 128 + wr * 64 + (i & 3) * 16 + fr];
#pragma unroll
        for (int i = 0; i < 8; ++i) rs[i] = RSTD[(size_t)b * SEQ + tok[i]];
#pragma unroll
        for (int ai = 0; ai < 2; ++ai)
#pragma unroll
            for (int m = 0; m < 4; ++m) {
                const float ws = rs[ai * 4 + m] * (1.0f / W8_SCALE); const float k1 = -1.44269504089f * ws, k2 = ws * ws * H8_SCALE;
                float r[8];
#pragma unroll
                for (int n = 0; n < 2; ++n)
#pragma unroll
                    for (int j2 = 0; j2 < 2; ++j2) { const f32x2 a = (f32x2){acc[ai][0][m][n][2 * j2], acc[ai][0][m][n][2 * j2 + 1]}, g = (f32x2){acc[ai][1][m][n][2 * j2], acc[ai][1][m][n][2 * j2 + 1]};
                        const f32x2 t = a * k1; f32x2 e; e.x = __builtin_amdgcn_exp2f(t.x); e.y = __builtin_amdgcn_exp2f(t.y);
                        const f32x2 d = e + 1.0f; f32x2 sg; sg.x = __builtin_amdgcn_rcpf(d.x); sg.y = __builtin_amdgcn_rcpf(d.y);
                        const f32x2 o = ((a * g) * sg) * k2; r[n * 4 + 2 * j2] = o.x; r[n * 4 + 2 * j2 + 1] = o.y; }
                u32x2 w; w.x = pk4_fp8(r[0], r[1], r[2], r[3]); w.y = pk4_fp8(r[4], r[5], r[6], r[7]);
                *(u32x2*)(H + (size_t)(row0 + ai * 128 + m * 16) * DFF + col0) = w; }
        return false;
    }
};

struct Sched8 {
    const char* H; const char* WD; int G, c;
    __device__ __forceinline__ bool next(int i, Unit& u) const {
        if (i >= 4) return false;
        const int x = c & 7, j = c >> 3;
        const int e = i * 4 + (x >> 1), mt = (x & 1) * 8 + (j & 7), nt = j >> 3;
        u.A = H + ((size_t)e * 4096 + (size_t)mt * 256) * DFF; u.B = WD + ((size_t)e * D + (size_t)nt * 256) * DFF; u.ridx = nullptr; u.pm = e * 16 + mt; u.pn = nt; u.kind = 0; return true;
    }
};
struct Epi8 {
    static constexpr bool PERM = true;
    unsigned char* Y; const float* GATE;
    __device__ __forceinline__ bool operator()(f32x4 (&acc)[2][2][4][2], const Unit& u, int wr, int wc, int fr, int fq) const {
        const int e = u.pm >> 4, mt = u.pm & 15, b = mt >> 1;
        const int rl0 = (mt & 1) * 256 + wr * 64 + fr;
        const int col0 = u.pn * 256 + wc * 32 + 8 * fq;
        float gv[8];
#pragma unroll
        for (int i = 0; i < 8; ++i) gv[i] = GATE[(size_t)(b * NE + e) * CAP + rl0 + (i >> 2) * 128 + (i & 3) * 16] * (Y8_SCALE / (W8_SCALE * H8_SCALE));
#pragma unroll
        for (int ai = 0; ai < 2; ++ai)
#pragma unroll
            for (int m = 0; m < 4; ++m) { const int sl = rl0 + ai * 128 + m * 16; const float g = gv[ai * 4 + m];
                unsigned char* rowp = Y + ((size_t)e * 4096 + (size_t)b * CAP + sl) * D + col0;
#pragma unroll
                for (int bj = 0; bj < 2; ++bj) { const f32x4 v0 = acc[ai][bj][m][0] * g, v1 = acc[ai][bj][m][1] * g;
                    u32x2 w; w.x = pk4_fp8(v0[0], v0[1], v0[2], v0[3]); w.y = pk4_fp8(v1[0], v1[1], v1[2], v1[3]);
                    *(u32x2*)(rowp + bj * 128) = w; } }
        return false;
    }
};

__device__ __forceinline__ void p9_final(const Ctx& F) {
    const int gw = F.bid * 8 + F.wave, NGW = F.G * 8, lane = F.lane;
    const unsigned short* INV = (const unsigned short*)(F.ws + WS_INV); const unsigned char* Y = (const unsigned char*)(F.ws + WS_RA); const bf16_t* DLT = (const bf16_t*)(F.ws + WS_DLT);
    f32x4 gg[4];
#pragma unroll
    for (int j = 0; j < 4; ++j) gg[j] = ((const f32x4*)F.final_g)[64 * j + lane];
    for (int m2 = gw; m2 < MTOK / 2; m2 += NGW) {
        const int m = m2 * 2, b = m >> 12;
        const f32x4* xr = (const f32x4*)(F.x + (size_t)m * D) + lane; const u32x2* dr = (const u32x2*)(DLT + (size_t)m * D) + lane;
        f32x4* orow = (f32x4*)(F.out + (size_t)m * D) + lane;
        f32x4 v[2][4]; u32x2 dl[2][4];
#pragma unroll
        for (int r = 0; r < 2; ++r)
#pragma unroll
            for (int j = 0; j < 4; ++j) { v[r][j] = __builtin_nontemporal_load(xr + r * 256 + 64 * j); dl[r][j] = __builtin_nontemporal_load(dr + r * 256 + 64 * j); }
        const unsigned myinv = INV[(size_t)m * 16 + (lane & 31)];
#pragma unroll
        for (int r = 0; r < 2; ++r)
#pragma unroll
            for (int j = 0; j < 4; ++j) { v[r][j].x += bf_lo(dl[r][j].x); v[r][j].y += bf_hi(dl[r][j].x); v[r][j].z += bf_lo(dl[r][j].y); v[r][j].w += bf_hi(dl[r][j].y); }
        f32x4 ys[2][4];
#pragma unroll
        for (int r = 0; r < 2; ++r)
#pragma unroll
            for (int j = 0; j < 4; ++j) ys[r][j] = (f32x4){0.f, 0.f, 0.f, 0.f};
#pragma unroll 1
        for (int e = 0; e < 16; ++e) {
#pragma unroll
            for (int r = 0; r < 2; ++r) {
                const unsigned sl = (unsigned)__builtin_amdgcn_readlane((int)myinv, e + 16 * r);
                if (sl != 0xFFFFu) {
                    const unsigned* yr = (const unsigned*)(Y + ((size_t)e * 4096 + (size_t)b * CAP + sl) * D) + lane;
#pragma unroll
                    for (int j = 0; j < 4; ++j) { const unsigned w = __builtin_nontemporal_load(yr + 64 * j); const f32x2 lo = __builtin_amdgcn_cvt_pk_f32_fp8((int)w, false), hi = __builtin_amdgcn_cvt_pk_f32_fp8((int)w, true);
                        ys[r][j].x += lo.x; ys[r][j].y += lo.y; ys[r][j].z += hi.x; ys[r][j].w += hi.y; }
                }
            }
        }
#pragma unroll
        for (int r = 0; r < 2; ++r) {
            float s = 0.f;
#pragma unroll
            for (int j = 0; j < 4; ++j) { v[r][j] = v[r][j] + ys[r][j] * (1.0f / Y8_SCALE); s += (v[r][j].x * v[r][j].x + v[r][j].y * v[r][j].y) + (v[r][j].z * v[r][j].z + v[r][j].w * v[r][j].w); }
            const float rstd = 1.0f / sqrtf(wave_sum(s) * (1.f / D) + EPS);
#pragma unroll
            for (int j = 0; j < 4; ++j) __builtin_nontemporal_store(v[r][j] * rstd * gg[j], orow + r * 256 + 64 * j);
        }
    }
}

__global__ void __launch_bounds__(512, 2) mk_fwd(Args args) {
    extern __shared__ __attribute__((aligned(16))) unsigned char lds_raw[];
    cg::grid_group grid = cg::this_grid();
    Ctx F;
    F.lds = (LAS unsigned char*)lds_raw;
    F.tid = threadIdx.x; F.lane = F.tid & 63; F.wave = __builtin_amdgcn_readfirstlane(F.tid >> 6); F.G = gridDim.x; F.bid = blockIdx.x;
    F.x = args.in[0]; F.norm1_g = args.in[1]; F.w_in = args.in[2]; F.ln_g = args.in[3]; F.ln_b = args.in[4]; F.w_sp = args.in[5]; F.b_sp = args.in[6];
    F.w_fo = args.in[7]; F.w_so = args.in[8]; F.w_out = args.in[9]; F.norm2_g = args.in[10]; F.w_router = args.in[11]; F.w_gate = args.in[12]; F.w_up = args.in[13];
    F.w_down = args.in[14]; F.final_g = args.in[15]; F.out = args.out; F.ws = args.ws;
    const unsigned pm_ = args.ph_mask;
    unsigned char* ws = args.ws;
    if (F.tid < 2) ((LAS unsigned*)(F.lds + LDS_MISC))[F.tid] = 0u;
    __syncthreads();
    if (args.pad == 0x5eedu) grid.sync();
    const XcdBarrier xbar = xcd_barrier_post((unsigned*)(ws + WS_CTL), (volatile LAS unsigned*)(F.lds + LDS_MISC));
#ifndef PROBE_PHASE
#define PROBE_PHASE -1
#endif
    volatile LAS unsigned long long* stamps_ = (volatile LAS unsigned long long*)(F.lds + LDS_BYTES - 256);
#define STAMP(k) do { if (PROBE_PHASE >= 0 && F.bid == 0 && F.tid == 0) stamps_[k] = __builtin_amdgcn_s_memrealtime(); } while (0)
#ifndef PH_CT_MASK
#define PH_CT_MASK 0xffffu
#endif
#define RUN(k) ((((PH_CT_MASK) >> (k)) & 1u) && ((pm_ >> (k)) & 1u))
#define SEAM(k) do { if ((pm_ & ((2u << (k)) - 1u)) && (pm_ >> ((k) + 1))) { xcd_barrier(xbar); } } while (0)
    STAMP(0); if ((F.bid & 1) && RUN(2)) p0_prep(F, 4);
    if (RUN(0)) p0_prep(F, 1); STAMP(1); if (RUN(1)) p0_prep(F, 2); STAMP(2); if (!(F.bid & 1) && RUN(2)) p0_prep(F, 4); STAMP(3); if (RUN(3)) p0_prep(F, 8);
    SEAM(3); STAMP(4);
    if (RUN(4)) {
        const int nk = (8192 + F.G * 8 - 1) / (F.G * 8);
        weight_filler(F, 0, 0, (F.bid & 1) ? nk : 0);
        Sched1 S{(const char*)(ws + WS_HN), (const char*)(ws + WS_WIN), F.G, F.bid}; Epi1 E{ws};
        pg8::gemm_phase<Epi1, Sched1, false>(F.lds, D, S, E);
        weight_filler(F, 0, (F.bid & 1) ? nk : 0, nk);
    }
    SEAM(4); STAMP(5);
    if (RUN(5)) p2_sgu(F);
    STAMP(6);
    if (RUN(6)) fft_stage<0>(F);
    SEAM(6); STAMP(7);
    if (RUN(7)) fft_stage<1>(F);
    SEAM(7); STAMP(8);
    if (RUN(8)) {
        Sched3 S{(const char*)(ws + WS_FM), (const char*)(ws + WS_SG), (const char*)(ws + WS_WFO), (const char*)(ws + WS_WSO), F.G, F.bid};
        Epi3 E{(const bf16_t*)(ws + WS_SGF), (const bf16_t*)(ws + WS_SGS), (bf16_t*)(ws + WS_MRG)};
        const int nk = (8192 + F.G * 8 - 1) / (F.G * 8);
        weight_filler(F, 1, 0, (F.bid & 1) ? nk : 0);
        pg8::gemm_phase<Epi3, Sched3, false>(F.lds, 512, S, E);
        weight_filler(F, 1, (F.bid & 1) ? nk : 0, nk);
    }
    SEAM(8); STAMP(9);
    if (RUN(9)) {
        Sched4 S{(const char*)(ws + WS_MRG), (const char*)(ws + WS_WOUT), F.G, F.bid}; Epi4 E{(bf16_t*)(ws + WS_DLT)};
        const int nk = (8192 + F.G * 8 - 1) / (F.G * 8);
        weight_filler(F, 2, 0, (F.bid & 1) ? nk : 0);
        pg8::gemm_phase<Epi4, Sched4, false>(F.lds, D, S, E);
        weight_filler(F, 2, (F.bid & 1) ? nk : 0, nk);
    }
    SEAM(9); STAMP(10);
    if (RUN(10)) p5_rows(F, 1);
    STAMP(11);
    if (RUN(11)) p5_rows(F, 2);
    SEAM(11); STAMP(12);
    if (RUN(12)) p6_topk(F);
    SEAM(12); STAMP(13);
    if (RUN(13)) {
        Sched7 S{(const char*)(ws + WS_H2), (const char*)(ws + WS_WGU), (const int*)(ws + WS_IDX), F.G, F.bid}; Epi7 E{(unsigned char*)(ws + WS_H), (const float*)(ws + WS_RSTD)};
        pg8::gemm_phase<Epi7, Sched7, true, true>(F.lds, D / 2, S, E);
    }
    SEAM(13); STAMP(14);
    if (RUN(14)) {
        Sched8 S{(const char*)(ws + WS_H), (const char*)(ws + WS_WD), F.G, F.bid}; Epi8 E{(unsigned char*)(ws + WS_RA), (const float*)(ws + WS_GATE)};
        pg8::gemm_phase<Epi8, Sched8, false, true>(F.lds, DFF / 2, S, E);
    }
    SEAM(14); STAMP(15);
    if (RUN(15)) p9_final(F);
    STAMP(16);
    if (PROBE_PHASE >= 0 && F.bid == 0 && F.tid == 0) { const unsigned long long dt = 4ull * (stamps_[PROBE_PHASE + 1] - stamps_[PROBE_PHASE]), t0 = __builtin_amdgcn_s_memrealtime();
        while (__builtin_amdgcn_s_memrealtime() - t0 < dt) __builtin_amdgcn_s_sleep(32); }
#undef RUN
#undef SEAM
}

extern "C" void kernel_launch(void* const* d_in, const int* in_sizes, int n_in, void* d_out, int out_size, void* d_ws, size_t ws_size, hipStream_t stream) {
    static int grid = 0;
    if (grid == 0) {
        if (n_in != 16 || out_size != MTOK * D || ws_size < WS_END) { fprintf(stderr, "kernel_launch: unexpected shapes (n_in %d, out %d, ws %zu < %zu)\n", n_in, out_size, ws_size, (size_t)WS_END); grid = -1; return; }
        int dev = 0, cus = 0, per_cu = 0;
        if (hipGetDevice(&dev) != hipSuccess || hipDeviceGetAttribute(&cus, hipDeviceAttributeMultiprocessorCount, dev) != hipSuccess) { grid = -1; return; }
        if (hipFuncSetAttribute((const void*)mk_fwd, hipFuncAttributeMaxDynamicSharedMemorySize, LDS_BYTES) != hipSuccess) { fprintf(stderr, "kernel_launch: hipFuncSetAttribute failed\n"); grid = -1; return; }
        if (hipOccupancyMaxActiveBlocksPerMultiprocessor(&per_cu, (const void*)mk_fwd, 512, LDS_BYTES) != hipSuccess || per_cu < 1) { fprintf(stderr, "kernel_launch: occupancy query failed (%d)\n", per_cu); grid = -1; return; }
        if (per_cu > 1) per_cu = 1;
        grid = cus * per_cu;
        if (grid != 256) fprintf(stderr, "kernel_launch: note: grid %d (tile orders are tuned for 256)\n", grid);
    }
    if (grid < 0) return;
    if (hipMemsetAsync((char*)d_ws + WS_CTL, 0, CTL_BYTES, stream) != hipSuccess) { fprintf(stderr, "kernel_launch: hipMemsetAsync failed\n"); return; }
    Args a{};
    for (int i = 0; i < 16; ++i) a.in[i] = (const float*)d_in[i];
    a.out = (float*)d_out; a.ws = (unsigned char*)d_ws;
#if MK_N_LAUNCHES == 1
    a.ph_mask = 0xffffu;
    void* kargs[] = {&a};
    hipError_t e = hipLaunchCooperativeKernel((const void*)mk_fwd, dim3(grid), dim3(512), kargs, LDS_BYTES, stream);
    if (e != hipSuccess) fprintf(stderr, "kernel_launch: cooperative launch failed: %s (grid %d)\n", hipGetErrorString(e), grid);
#else
#ifndef PROBE_DUP
#define PROBE_DUP 0
#endif
    for (int p = 0; p < 16; ++p) {
        const int reps = ((PROBE_DUP >> p) & 1) ? 2 : 1;
        for (int r = 0; r < reps; ++r) { a.ph_mask = 1u << p; hipLaunchKernelGGL(mk_fwd, dim3(grid), dim3(512), LDS_BYTES, stream, a); }
    }
#endif
}
```

```cpp
#include <hip/hip_runtime.h>
#include <hip/hip_cooperative_groups.h>
#include <cstdio>
#include <cstdint>
namespace cg = cooperative_groups;

#ifndef MK_N_LAUNCHES
#define MK_N_LAUNCHES 1
#endif

#define LAS __attribute__((address_space(3)))
typedef unsigned short bf16_t;
typedef short bf16x8 __attribute__((ext_vector_type(8)));
typedef float f32x4 __attribute__((ext_vector_type(4)));
typedef float f32x2 __attribute__((ext_vector_type(2)));
typedef unsigned u32x4 __attribute__((ext_vector_type(4)));
typedef unsigned u32x2 __attribute__((ext_vector_type(2)));
typedef short s16x4 __attribute__((ext_vector_type(4)));
typedef int i32x4 __attribute__((ext_vector_type(4)));
typedef int i32x8 __attribute__((ext_vector_type(8)));

constexpr int D = 1024, NB = 8, SEQ = 4096, MTOK = NB * SEQ;
constexpr int FW = 512, SWD = 512, NE = 16, CAP = 512, DFF = 2048;
constexpr int N1 = 3584;
constexpr int INW = 3584;
constexpr float EPS = 1e-6f;

constexpr size_t MiB = 1u << 20;
constexpr size_t WS_RA = 0;
constexpr size_t WS_WGU = 64 * MiB;
constexpr size_t WS_WD = 128 * MiB;
constexpr size_t WS_RH = 192 * MiB;
constexpr size_t WS_YF = WS_RH;
constexpr size_t WS_GU = WS_RH + 64 * MiB;
constexpr size_t WS_GV = WS_RH + 96 * MiB;
constexpr size_t WS_SGF = WS_RH + 128 * MiB;
constexpr size_t WS_SGS = WS_RH + 192 * MiB;
constexpr size_t WS_FM = WS_GU;
constexpr size_t WS_MRG = WS_RH;
constexpr size_t WS_H = WS_RH + 128 * MiB;
constexpr size_t WS_DLT = WS_RH + 64 * MiB;
constexpr size_t WS_RS = 448 * MiB;
constexpr size_t WS_HN = WS_RS;
constexpr size_t WS_AP = WS_RS;
constexpr size_t WS_SG = WS_RA;
constexpr size_t WS_H2 = WS_RS;
constexpr size_t WS_WIN = 512 * MiB;
constexpr size_t WS_WFO = 520 * MiB;
constexpr size_t WS_WSO = 521 * MiB;
constexpr size_t WS_WOUT = 522 * MiB;
constexpr size_t WS_AFF = 524 * MiB;
constexpr size_t WS_INV = 526 * MiB;
constexpr size_t WS_IDX = 527 * MiB;
constexpr size_t WS_GATE = WS_IDX + 256 * 1024;
constexpr size_t WS_MA = WS_IDX + 512 * 1024;
constexpr size_t WS_MB = WS_MA + 32 * 1024;
constexpr size_t WS_RSTD = WS_IDX + 832 * 1024;
constexpr size_t WS_WRT = WS_IDX + 960 * 1024;
constexpr size_t WS_CST = WS_IDX + 576 * 1024;
constexpr size_t WS_CTL = WS_IDX + 768 * 1024;
constexpr size_t CTL_BYTES = 16384;
constexpr size_t WS_END = 528 * MiB;

constexpr int LDS_STAGE = 131072;
constexpr int LDS_X_OFF = LDS_STAGE;
constexpr int LDS_BYTES = 155648;
constexpr int LDS_MISC = LDS_BYTES - 64;

__device__ __forceinline__ unsigned f2bf(float f) { unsigned u = __builtin_bit_cast(unsigned, f); return (u + 0x7fffu + ((u >> 16) & 1u)) >> 16; }
__device__ __forceinline__ unsigned pk2(float lo, float hi) { return f2bf(lo) | (f2bf(hi) << 16); }
__device__ __forceinline__ unsigned cvt_pk_bf16(float lo, float hi) { unsigned r; asm volatile("v_cvt_pk_bf16_f32 %0, %1, %2" : "=v"(r) : "v"(lo), "v"(hi)); return r; }
__device__ __forceinline__ u32x4 widen16(u32x2 P, u32x2 Q) {
    const auto rx = __builtin_amdgcn_permlane16_swap(P.x, Q.x, false, false); const auto ry = __builtin_amdgcn_permlane16_swap(P.y, Q.y, false, false);
    return (u32x4){rx[0], ry[0], rx[1], ry[1]};
}
__device__ __forceinline__ float bf_lo(unsigned w) { return __builtin_bit_cast(float, w << 16); }
__device__ __forceinline__ float bf_hi(unsigned w) { return __builtin_bit_cast(float, w & 0xffff0000u); }
template <int N> __device__ __forceinline__ float row_ror(float x) { return __builtin_bit_cast(float, __builtin_amdgcn_update_dpp(0, __builtin_bit_cast(int, x), 0x120 + N, 0xF, 0xF, false)); }
__device__ __forceinline__ float row16_sum(float v) { v += row_ror<8>(v); v += row_ror<4>(v); v += row_ror<2>(v); v += row_ror<1>(v); return v; }
__device__ __forceinline__ float row16_max(float v) { v = fmaxf(v, row_ror<8>(v)); v = fmaxf(v, row_ror<4>(v)); v = fmaxf(v, row_ror<2>(v)); v = fmaxf(v, row_ror<1>(v)); return v; }
__device__ __forceinline__ float lane_bcast(float v, int l) { return __builtin_bit_cast(float, __builtin_amdgcn_readlane(__builtin_bit_cast(int, v), l)); }
__device__ __forceinline__ float wave_sum(float v) { v = row16_sum(v); return (lane_bcast(v, 0) + lane_bcast(v, 16)) + (lane_bcast(v, 32) + lane_bcast(v, 48)); }
__device__ __forceinline__ float fast_sigmoid(float x) { return __builtin_amdgcn_rcpf(1.0f + __builtin_amdgcn_exp2f(-1.44269504089f * x)); }
__device__ __forceinline__ float gelu_tanh(float x) {
    const float u = 1.5957691216f * (x + 0.044715f * x * x * x);
    return x * fast_sigmoid(u);
}
#define LDS_WAIT() asm volatile("s_waitcnt lgkmcnt(0)" ::: "memory")
__device__ __forceinline__ void glds16_asm(const void* gsrc, unsigned lds_dst) {
    unsigned keep;
    asm volatile("s_mov_b32 %0, m0\n\ts_mov_b32 m0, %2\n\ts_nop 0\n\tglobal_load_lds_dwordx4 %1, off nt\n\ts_mov_b32 m0, %0" : "=&s"(keep) : "v"(gsrc), "s"(lds_dst) : "memory");
}
__device__ __forceinline__ unsigned pk4_fp8(float a, float b, float c, float d) {
    a = __builtin_amdgcn_fmed3f(a, -448.f, 448.f); b = __builtin_amdgcn_fmed3f(b, -448.f, 448.f); c = __builtin_amdgcn_fmed3f(c, -448.f, 448.f); d = __builtin_amdgcn_fmed3f(d, -448.f, 448.f);
    int r = 0; r = __builtin_amdgcn_cvt_pk_fp8_f32(a, b, r, false); r = __builtin_amdgcn_cvt_pk_fp8_f32(c, d, r, true); return (unsigned)r;
}
constexpr float W8_SCALE = 32.0f;
constexpr float H8_SCALE = 8.0f;
constexpr float Y8_SCALE = 64.0f;

namespace pg8 {
constexpr int BM = 256, BK = 64, HALF = 128, HTB = HALF * BK * 2, NXCD = 8, WGM = 8;
__device__ __forceinline__ int lds_byte(int r, int c) { const int st = (r >> 4) * 2 + (c >> 5), rr = r & 15, cc = c & 31, ob = rr * 64 + cc * 2; return st * 1024 + (ob ^ (((ob >> 9) & 1) << 5)); }
__device__ __forceinline__ void stage_rc(int b, int& R, int& C) { const int st = b / 1024, sb = b % 1024, swz = sb ^ (((sb >> 9) & 1) << 5); R = (st >> 1) * 16 + swz / 64; C = (st & 1) * 32 + (swz % 64) / 2; }
__device__ __forceinline__ int perm32(int rho) { const int n = rho >> 4, i = rho & 15; return 8 * (i >> 2) + 4 * n + (i & 3); }

struct Unit { const char* A; const char* B; const int* ridx; int pm, pn, kind; };

__device__ __forceinline__ bool static_tile(int nM, int nN, int G, int c, int i, int& pm, int& pn) {
    const int nwg = nM * nN; const long L = (long)i * G + c; if (L >= nwg) return false;
    int wgid = (int)L; { const int q = nwg / NXCD, r = nwg % NXCD, xcd = wgid % NXCD, off = wgid / NXCD; wgid = (xcd < r ? xcd * (q + 1) : r * (q + 1) + (xcd - r) * q) + off; }
    const int nig = WGM * nN, gid = wgid / nig, fm = gid * WGM, gsz = (nM - fm) < WGM ? (nM - fm) : WGM;
    pm = fm + ((wgid % nig) % gsz); pn = (wgid % nig) / gsz; return true;
}

template <class Epi, class Sched, bool GATHER, bool FP8 = false>
__device__ __forceinline__ void gemm_phase(LAS unsigned char* lds, const int K, const Sched& S, const Epi& E) {
    const int tid = threadIdx.x, wid = __builtin_amdgcn_readfirstlane(tid >> 6), lane = tid & 63, wr = wid >> 2, wc = wid & 3, fr = lane & 15, fq = lane >> 4;
    const int nt = K / BK;
    unsigned voffA[2], voffB[2]; int RA[2], CA2[2];
#pragma unroll
    for (int i = 0; i < 2; ++i) { int R, C; stage_rc(tid * 16 + i * 8192, R, C); const int Rb = Epi::PERM ? ((R & ~31) + perm32(R & 31)) : R;
        voffA[i] = (unsigned)(R * K + C) * 2u; voffB[i] = (unsigned)(Rb * K + C) * 2u; RA[i] = R; CA2[i] = C * 2; }
    const size_t kstep = (size_t)(BK * 2);
    const size_t hstep = (size_t)HALF * K * 2;
    const unsigned ldsw = (unsigned)wid * 1024u;
    const int aoff = lds_byte(wr * 64 + fr, fq * 8), boff = lds_byte(wc * 32 + fr, fq * 8);
#define PG8_SA(b, h) (((b) * 2 + (h)) * HTB)
#define PG8_SB(b, h) ((4 + (b) * 2 + (h)) * HTB)
#define PG8_GLDS(bufoff, gptr, _i) __builtin_amdgcn_global_load_lds((const unsigned*)(gptr), (LAS unsigned*)(lds + (bufoff) + ldsw + (_i) * 8192), 16, 0, 0)
#define PG8_STAGE_B(bufoff, gbase) do { _Pragma("unroll") for (int _i = 0; _i < 2; ++_i) PG8_GLDS(bufoff, (const char*)(gbase) + voffB[_i], _i); } while (0)
#define PG8_STAGE_A(bufoff, gbase, h, go) do { _Pragma("unroll") for (int _i = 0; _i < 2; ++_i) { \
        if constexpr (GATHER) PG8_GLDS(bufoff, (const char*)(gbase) + go[h][_i], _i); else PG8_GLDS(bufoff, (const char*)(gbase) + (h) * hstep + voffA[_i], _i); } } while (0)
#define PG8_LD2(d2, d8, base) do { const LAS i32x4* p_ = (const LAS i32x4*)(base); const i32x4 lo_ = p_[0], hi_ = p_[64]; \
        if constexpr (FP8) d8 = __builtin_shufflevector(lo_, hi_, 0, 1, 2, 3, 4, 5, 6, 7); else { d2[0] = __builtin_bit_cast(bf16x8, lo_); d2[1] = __builtin_bit_cast(bf16x8, hi_); } } while (0)
#define PG8_LDA(dst, b, h) do { _Pragma("unroll") for (int m = 0; m < 4; ++m) PG8_LD2(dst[m], dst##8[m], lds + PG8_SA(b, h) + aoff + m * 2048); } while (0)
#define PG8_LDB(dst, b, h) do { _Pragma("unroll") for (int n = 0; n < 2; ++n) PG8_LD2(dst[n], dst##8[n], lds + PG8_SB(b, h) + boff + n * 2048); } while (0)
#define PG8_MMA(ai, bj, At, Bt) do { __builtin_amdgcn_s_setprio(1); _Pragma("unroll") for (int m = 0; m < 4; ++m) _Pragma("unroll") for (int n = 0; n < 2; ++n) { \
        if constexpr (FP8) asm volatile("v_mfma_f32_16x16x128_f8f6f4 %0, %1, %2, %0" : "+v"(acc[ai][bj][m][n]) : "v"(Bt##8[n]), "v"(At##8[m])); \
        else { _Pragma("unroll") for (int k = 0; k < 2; ++k) acc[ai][bj][m][n] = __builtin_amdgcn_mfma_f32_16x16x32_bf16(Bt[n][k], At[m][k], acc[ai][bj][m][n], 0, 0, 0); } } \
        __builtin_amdgcn_s_setprio(0); } while (0)
#define PG8_WAIT_V(n) asm volatile("s_waitcnt vmcnt(" #n ")" ::: "memory")
#define PG8_WAIT_L(n) asm volatile("s_waitcnt lgkmcnt(" #n ")" ::: "memory")
#define PG8_BAR __builtin_amdgcn_s_barrier()
#define PG8_SCHED __builtin_amdgcn_sched_barrier(0)
#define PG8_GOFS(dst, u) do { if constexpr (GATHER) { _Pragma("unroll") for (int _h = 0; _h < 2; ++_h) _Pragma("unroll") for (int _i = 0; _i < 2; ++_i) \
        dst[_h][_i] = (unsigned)(u).ridx[_h * HALF + RA[_i]] * (unsigned)(K * 2) + (unsigned)CA2[_i]; } } while (0)
    Unit cur, nxt; int ui = 0;
    if (!S.next(0, cur)) return;
    f32x4 acc[2][2][4][2];
#pragma unroll
    for (int a = 0; a < 2; ++a)
#pragma unroll
        for (int b = 0; b < 2; ++b)
#pragma unroll
            for (int m = 0; m < 4; ++m)
#pragma unroll
                for (int n = 0; n < 2; ++n) acc[a][b][m][n] = (f32x4){0.f, 0.f, 0.f, 0.f};
    bf16x8 At[4][2], B0[2][2], B1[2][2]; i32x8 At8[4], B08[2], B18[2];
    unsigned gA[2][2] = {{0u, 0u}, {0u, 0u}}, gN[2][2] = {{0u, 0u}, {0u, 0u}};
    PG8_GOFS(gA, cur);
    const char* cA = cur.A; const char* cB = cur.B;
    PG8_STAGE_B(PG8_SB(0, 0), cB); PG8_STAGE_B(PG8_SB(0, 1), cB + hstep); PG8_STAGE_A(PG8_SA(0, 0), cA, 0, gA); PG8_STAGE_A(PG8_SA(0, 1), cA, 1, gA);
    if (wr == 1) PG8_BAR;
    PG8_WAIT_V(2); PG8_BAR;
    PG8_STAGE_B(PG8_SB(1, 0), cB + kstep); PG8_STAGE_A(PG8_SA(1, 0), cA + kstep, 0, gA); PG8_STAGE_B(PG8_SB(1, 1), cB + hstep + kstep);
    PG8_WAIT_V(6); PG8_BAR;
    for (;;) {
        const bool has_next = S.next(ui + 1, nxt);
        if (!has_next) nxt = cur;
        PG8_GOFS(gN, nxt);
        const char* nA = nxt.A; const char* nB = nxt.B;
#pragma clang loop unroll(disable)
        for (int t = 0; t < nt; t += 2) {
            const bool last = (t == nt - 2);
            const char* a1 = cA + (size_t)(t + 1) * kstep;
            const char* a2 = last ? nA : cA + (size_t)(t + 2) * kstep; const char* b2 = last ? nB : cB + (size_t)(t + 2) * kstep;
            const char* a3 = a2 + kstep; const char* b3 = b2 + kstep;
            unsigned g2[2][2];
#pragma unroll
            for (int _h = 0; _h < 2; ++_h)
#pragma unroll
                for (int _i = 0; _i < 2; ++_i) g2[_h][_i] = last ? gN[_h][_i] : gA[_h][_i];
            PG8_LDB(B0, 0, 0); PG8_LDB(B1, 0, 1); PG8_SCHED; PG8_LDA(At, 0, 0); PG8_STAGE_A(PG8_SA(1, 1), a1, 1, gA);
            PG8_WAIT_V(8); PG8_WAIT_L(0); PG8_BAR; PG8_MMA(0, 0, At, B0); PG8_MMA(0, 1, At, B1); PG8_BAR; PG8_SCHED;
            PG8_LDA(At, 0, 1); PG8_STAGE_B(PG8_SB(0, 0), b2); PG8_STAGE_B(PG8_SB(0, 1), b2 + hstep); PG8_STAGE_A(PG8_SA(0, 0), a2, 0, g2);
            PG8_WAIT_V(8); PG8_WAIT_L(0); PG8_BAR; PG8_MMA(1, 0, At, B0); PG8_MMA(1, 1, At, B1); PG8_BAR; PG8_SCHED;
            PG8_LDB(B0, 1, 0); PG8_LDB(B1, 1, 1); PG8_SCHED; PG8_LDA(At, 1, 0); PG8_STAGE_A(PG8_SA(0, 1), a2, 1, g2);
            PG8_WAIT_V(8); PG8_WAIT_L(0); PG8_BAR; PG8_MMA(0, 0, At, B0); PG8_MMA(0, 1, At, B1); PG8_BAR; PG8_SCHED;
            PG8_LDA(At, 1, 1); PG8_STAGE_B(PG8_SB(1, 0), b3); PG8_STAGE_B(PG8_SB(1, 1), b3 + hstep); PG8_STAGE_A(PG8_SA(1, 0), a3, 0, g2);
            PG8_WAIT_V(8); PG8_WAIT_L(0); PG8_BAR; PG8_MMA(1, 0, At, B0); PG8_MMA(1, 1, At, B1); PG8_BAR; PG8_SCHED;
        }
        if (wr == 0) PG8_BAR;
        if constexpr (FP8) asm volatile("s_nop 15\n\ts_nop 15" ::: "memory");
        const bool keep = E(acc, cur, wr, wc, fr, fq);
        if (!has_next) break;
        if (!keep) {
#pragma unroll
            for (int a = 0; a < 2; ++a)
#pragma unroll
                for (int b = 0; b < 2; ++b)
#pragma unroll
                    for (int m = 0; m < 4; ++m)
#pragma unroll
                        for (int n = 0; n < 2; ++n) acc[a][b][m][n] = (f32x4){0.f, 0.f, 0.f, 0.f};
        }
        cur = nxt; cA = nA; cB = nB; ++ui;
#pragma unroll
        for (int _h = 0; _h < 2; ++_h)
#pragma unroll
            for (int _i = 0; _i < 2; ++_i) gA[_h][_i] = gN[_h][_i];
        if (wr == 1) PG8_BAR;
    }
    PG8_WAIT_V(0);
    PG8_BAR;
#undef PG8_SA
#undef PG8_SB
#undef PG8_GLDS
#undef PG8_STAGE_A
#undef PG8_STAGE_B
#undef PG8_LDA
#undef PG8_LDB
#undef PG8_MMA
#undef PG8_LD2
#undef PG8_WAIT_V
#undef PG8_WAIT_L
#undef PG8_BAR
#undef PG8_SCHED
#undef PG8_GOFS
}
}
using pg8::Unit;

#define XB_TMO      128
#define XB_XCNT(j)  (256  + 64 * (j))
#define XB_XSUB(j)  (1280 + 64 * (j))
#define XB_XGEN(j)  (2304 + 64 * (j))
#define XB_TOP      3328
#define XB_TOPGEN   3392
#define XB_SPIN_CAP (1u << 22)
__device__ __forceinline__ unsigned xb_ld(unsigned* p)              { return __hip_atomic_load(p, __ATOMIC_RELAXED, __HIP_MEMORY_SCOPE_AGENT); }
__device__ __forceinline__ unsigned xb_add(unsigned* p, unsigned v) { return __hip_atomic_fetch_add(p, v, __ATOMIC_RELAXED, __HIP_MEMORY_SCOPE_AGENT); }
__device__ __forceinline__ unsigned xb_xcc_id() { return (unsigned)__builtin_amdgcn_s_getreg((3 << 11) | 20) & 0xFu; }
#define XB_SPIN(cond, bar) do { unsigned _sp = 0; while (cond) { __builtin_amdgcn_s_sleep(1); \
    if ((++_sp & 255u) == 0u) { if (xb_ld(&(bar)[XB_TMO])) break; if (_sp > XB_SPIN_CAP) { atomicAdd(&(bar)[XB_TMO], 1u); break; } } } } while (0)
struct XcdBarrier { unsigned* bar; unsigned x; volatile LAS unsigned* st; };
__device__ __forceinline__ XcdBarrier xcd_barrier_post(unsigned* bar, volatile LAS unsigned* st) {
    XcdBarrier b; b.bar = bar; b.x = xb_xcc_id(); b.st = st;
    if (threadIdx.x == 0) (void)xb_add(&bar[XB_XCNT(b.x)], 1u);
    return b;
}
__device__ __forceinline__ void xcd_barrier_complete(unsigned* bar, unsigned x, unsigned& nloc, unsigned& nx) {
    const unsigned G = gridDim.x * gridDim.y * gridDim.z;
    unsigned sum, cnt, mine, sp = 0u;
    for (;;) {
        sum = 0u; cnt = 0u; mine = 0u;
#pragma unroll
        for (unsigned j = 0; j < 16; ++j) { const unsigned c = xb_ld(&bar[XB_XCNT(j)]); sum += c; cnt += (c > 0u) ? 1u : 0u; mine = (j == x) ? c : mine; }
        if (sum == G) break;
        __builtin_amdgcn_s_sleep(1);
        if ((++sp & 255u) == 0u) { if (xb_ld(&bar[XB_TMO])) break; if (sp > XB_SPIN_CAP) { atomicAdd(&bar[XB_TMO], 1u); break; } }
    }
    nloc = mine > 0u ? mine : 1u; nx = cnt > 0u ? cnt : 1u;
}
__device__ __forceinline__ void xcd_barrier(const XcdBarrier& b) {
    asm volatile("s_waitcnt vmcnt(0)" ::: "memory");
    __syncthreads();
    if (threadIdx.x == 0) {
        unsigned* bar = b.bar;
        __builtin_amdgcn_s_waitcnt(0);
        unsigned nloc = b.st[0], nx = b.st[1];
        if (nloc == 0u) { xcd_barrier_complete(bar, b.x, nloc, nx); b.st[0] = nloc; b.st[1] = nx; }
        const unsigned old = xb_add(&bar[XB_XSUB(b.x)], 1u);
        const unsigned gen = old / nloc;
        if (old + 1u == (gen + 1u) * nloc) {
            __builtin_amdgcn_fence(__ATOMIC_RELEASE, "agent");
            asm volatile("s_waitcnt vmcnt(0)" ::: "memory");
            const unsigned og = xb_add(&bar[XB_TOP], 1u);
            const unsigned tg = og / nx;
            if (og + 1u != (tg + 1u) * nx) XB_SPIN(xb_ld(&bar[XB_TOP]) < (tg + 1u) * nx, bar);
            xb_add(&bar[XB_XGEN(b.x)], 1u);
            __builtin_amdgcn_fence(__ATOMIC_ACQUIRE, "agent");
            asm volatile("s_waitcnt vmcnt(0)" ::: "memory");
        } else {
            __builtin_amdgcn_fence(__ATOMIC_ACQUIRE, "agent");
            asm volatile("s_waitcnt vmcnt(0)" ::: "memory");
            XB_SPIN(xb_ld(&bar[XB_XGEN(b.x)]) == gen, bar);
            asm volatile("" ::: "memory");
        }
    }
    __syncthreads();
}

struct Args {
    const float* in[16];
    float* out;
    unsigned char* ws;
    unsigned ph_mask, pad;
};

struct Ctx {
    LAS unsigned char* lds;
    int tid, lane, wave, G, bid;
    const float *x, *norm1_g, *w_in, *ln_g, *ln_b, *w_sp, *b_sp, *w_fo, *w_so, *w_out, *norm2_g, *w_router, *w_gate, *w_up, *w_down, *final_g;
    float* out;
    unsigned char* ws;
};

__device__ __forceinline__ void transpose_item(const float* W, int N, int k0, int n0, bf16_t* WT, size_t dst_row0, int Kd, LAS float* scr, int lane) {
    const float* src = W + (size_t)(k0 + (lane >> 4)) * N + n0;
#pragma unroll
    for (int i = 0; i < 16; ++i) {
        const int n4 = (lane & 15) ^ ((i >> 1) & 7);
        __builtin_amdgcn_global_load_lds((const unsigned*)(src + (size_t)(4 * i) * N + 4 * n4), (LAS unsigned*)(scr + i * 256), 16, 0, 2);
    }
    asm volatile("s_waitcnt vmcnt(0)" ::: "memory");
    const int hh = lane >> 5, c = (lane >> 2) & 7, sub = lane & 3;
#pragma unroll
    for (int j = 0; j < 8; ++j) {
        const int n4 = 2 * j + hh;
        const LAS float* p = scr + (16 * (8 * c) + (n4 ^ c)) * 4 + sub;
        float v[8];
#pragma unroll
        for (int i = 0; i < 8; ++i) v[i] = p[i * 64];
        u32x4 o; o.x = pk2(v[0], v[1]); o.y = pk2(v[2], v[3]); o.z = pk2(v[4], v[5]); o.w = pk2(v[6], v[7]);
        *(u32x4*)(WT + (dst_row0 + 4 * n4 + sub) * (size_t)Kd + k0 + 8 * c) = o;
    }
    LDS_WAIT(); asm volatile("" ::: "memory");
}

__device__ __forceinline__ void transpose_item8(const float* W, int N, int k0, int n0, unsigned char* WT8, size_t dst_row0, int Kd, LAS float* scr, int lane) {
    const float* src = W + (size_t)(k0 + (lane >> 4)) * N + n0;
#pragma unroll
    for (int i = 0; i < 16; ++i) {
        const int n4 = (lane & 15) ^ ((i >> 1) & 7);
        __builtin_amdgcn_global_load_lds((const unsigned*)(src + (size_t)(4 * i) * N + 4 * n4), (LAS unsigned*)(scr + i * 256), 16, 0, 2);
    }
    asm volatile("s_waitcnt vmcnt(0)" ::: "memory");
    const int hh = lane >> 5, c = (lane >> 2) & 7, sub = lane & 3;
#pragma unroll
    for (int j = 0; j < 8; ++j) {
        const int n4 = 2 * j + hh;
        const LAS float* p = scr + (16 * (8 * c) + (n4 ^ c)) * 4 + sub;
        float v[8];
#pragma unroll
        for (int i = 0; i < 8; ++i) v[i] = p[i * 64] * W8_SCALE;
        u32x2 o; o.x = pk4_fp8(v[0], v[1], v[2], v[3]); o.y = pk4_fp8(v[4], v[5], v[6], v[7]);
        *(u32x2*)(WT8 + (dst_row0 + 4 * n4 + sub) * (size_t)Kd + k0 + 8 * c) = o;
    }
    LDS_WAIT(); asm volatile("" ::: "memory");
}

__device__ __forceinline__ void rms_rows4_to_bf16(const float* x0, const f32x4 (&gg)[4], bf16_t* o0, int lane) {
    f32x4 v[4][4];
#pragma unroll
    for (int r = 0; r < 4; ++r)
#pragma unroll
        for (int j = 0; j < 4; ++j) v[r][j] = __builtin_nontemporal_load((const f32x4*)(x0 + (size_t)r * D) + 64 * j + lane);
#pragma unroll
    for (int r = 0; r < 4; ++r) {
        float s = 0.f;
#pragma unroll
        for (int j = 0; j < 4; ++j) s += (v[r][j].x * v[r][j].x + v[r][j].y * v[r][j].y) + (v[r][j].z * v[r][j].z + v[r][j].w * v[r][j].w);
        const float rstd = 1.0f / sqrtf(wave_sum(s) * (1.f / D) + EPS);
        u32x2* o8 = (u32x2*)(o0 + (size_t)r * D) + lane;
#pragma unroll
        for (int j = 0; j < 4; ++j) { u32x2 w; w.x = pk2(v[r][j].x * rstd * gg[j].x, v[r][j].y * rstd * gg[j].y); w.y = pk2(v[r][j].z * rstd * gg[j].z, v[r][j].w * rstd * gg[j].w); o8[64 * j] = w; }
    }
}

__device__ __forceinline__ void weight_filler_item(const Ctx& F, const int which, const int gw, const int k, LAS float* scr) {
    const int NGW = F.G * 8;
    if (which == 0) { const int r = gw + k * NGW; if (r >= 8192) return; const int e = r >> 9, q = r & 511, kb = q >> 4, nb = q & 15;
        transpose_item8(F.w_down + (size_t)e * DFF * D, D, 64 * kb, 64 * nb, (unsigned char*)(F.ws + WS_WD) + (size_t)e * D * DFF, (size_t)(64 * nb), DFF, scr, F.lane);
    } else { const int q_ = gw + k * NGW; if (q_ >= 8192) return; const int it = q_ + (which - 1) * 8192;
        unsigned char* WG = (unsigned char*)(F.ws + WS_WGU);
        const int e = it >> 10, src = (it >> 9) & 1, q = it & 511, kb = q >> 5, nb = q & 31;
        const int f0 = 64 * nb; const size_t dst_row0 = (size_t)e * 4096 + (size_t)(f0 >> 7) * 256 + (src ? 128 : 0) + (f0 & 127);
        transpose_item8((src ? F.w_up : F.w_gate) + (size_t)e * D * DFF, DFF, 64 * kb, f0, WG, dst_row0, D, scr, F.lane); }
}
__device__ __forceinline__ void weight_filler(const Ctx& F, const int which, const int k_lo, const int k_hi) {
    LAS float* scr = (LAS float*)(F.lds + F.wave * 16384);
    if (k_lo >= k_hi) return;
    for (int k = k_lo; k < k_hi; ++k) weight_filler_item(F, which, F.bid * 8 + F.wave, k, scr);
    __syncthreads();
}
__device__ __forceinline__ void weight_filler_pool(const Ctx& F, const int which, unsigned* ctr, const int k_odd) {
    LAS float* scr = (LAS float*)(F.lds + F.wave * 16384);
    volatile LAS unsigned* slot = (volatile LAS unsigned*)(F.lds + LDS_X_OFF);
    const int NGW = F.G * 8, nk = (8192 + NGW - 1) / NGW, nev8 = ((F.G + 1) / 2) * 8, nod8 = (F.G / 2) * 8; const unsigned tot_e = (unsigned)(nk * nev8), total = tot_e + (unsigned)((nk - k_odd) * nod8);
    if (F.tid == 0) slot[0] = __hip_atomic_fetch_add(ctr, 8u, __ATOMIC_RELAXED, __HIP_MEMORY_SCOPE_AGENT);
    __syncthreads();
    for (int rnd = 0; ; ++rnd) {
        const unsigned base = slot[rnd & 1];
        if (base >= total) break;
        unsigned nxt = 0u;
        if (F.tid == 0) nxt = __hip_atomic_fetch_add(ctr, 8u, __ATOMIC_RELAXED, __HIP_MEMORY_SCOPE_AGENT);
        const unsigned p = base + (unsigned)F.wave;
        if (p < tot_e) { const int k = (int)(p / (unsigned)nev8), j = (int)(p % (unsigned)nev8); weight_filler_item(F, which, (2 * (j >> 3)) * 8 + (j & 7), k, scr); }
        else if (p < total) { const unsigned q = p - tot_e; const int k = k_odd + (int)(q / (unsigned)nod8), j = (int)(q % (unsigned)nod8); weight_filler_item(F, which, (2 * (j >> 3) + 1) * 8 + (j & 7), k, scr); }
        if (F.tid == 0) slot[(rnd + 1) & 1] = nxt;
        __syncthreads();
    }
}

__device__ __forceinline__ void p0_prep(const Ctx& F, const int parts) {
    LAS float* scr = (LAS float*)(F.lds + F.wave * 16384);
    LAS float* tab128 = (LAS float*)(F.lds + LDS_X_OFF);
    if (F.tid < 128) tab128[F.tid] = cospif((float)F.tid * (1.0f / 64.0f));
    __syncthreads();
    const int gw = F.bid * 8 + F.wave, NGW = F.G * 8;
    bf16_t* WinT = (bf16_t*)(F.ws + WS_WIN);
    if (parts & 1) {
        constexpr int I1 = 16 * 56, I2 = 8 * 16, I3 = 8 * 16, I4 = 16 * 16;
        constexpr int NIT = I1 + I2 + I3 + I4;
        for (int it = gw; it < NIT; it += NGW) {
            int r = it;
            if (r < I1) { const int kb = r / 56, nb = r % 56;
                size_t drow = (size_t)(64 * nb); if (nb >= 24) { const int c = 64 * nb - 1536, cc = c & 1023; drow = (size_t)(1536 + (cc >> 7) * 256 + (c >= 1024 ? 128 : 0) + (cc & 127)); }
                transpose_item(F.w_in, INW, 64 * kb, 64 * nb, WinT, drow, D, scr, F.lane); continue; } r -= I1;
            if (r < I2) { const int kb = r / 16, nb = r % 16; transpose_item(F.w_fo, D, 64 * kb, 64 * nb, (bf16_t*)(F.ws + WS_WFO), (size_t)(64 * nb), FW, scr, F.lane); continue; } r -= I2;
            if (r < I3) { const int kb = r / 16, nb = r % 16; transpose_item(F.w_so, D, 64 * kb, 64 * nb, (bf16_t*)(F.ws + WS_WSO), (size_t)(64 * nb), SWD, scr, F.lane); continue; } r -= I3;
            { const int kb = r / 16, nb = r % 16; transpose_item(F.w_out, D, 64 * kb, 64 * nb, (bf16_t*)(F.ws + WS_WOUT), (size_t)(64 * nb), D, scr, F.lane); }
        }
    }
    if (parts & 4) {
        bf16_t* HN = (bf16_t*)(F.ws + WS_HN);
        f32x4 gg[4];
#pragma unroll
        for (int j = 0; j < 4; ++j) gg[j] = ((const f32x4*)F.norm1_g)[64 * j + F.lane];
        for (int m4 = gw; m4 < MTOK / 4; m4 += NGW) rms_rows4_to_bf16(F.x + (size_t)m4 * 4 * D, gg, HN + (size_t)m4 * 4 * D, F.lane);
    }
    if (parts & 8) {
        bf16_t* MA = (bf16_t*)(F.ws + WS_MA); bf16_t* MB = (bf16_t*)(F.ws + WS_MB);
        const int gt = F.bid * 512 + F.tid, NT = F.G * 512;
        for (int i = gt; i < 32 * 4 * 16; i += NT) {
            const int e = i & 15, kg = (i >> 4) & 3, ks = i >> 6; const int d0 = 32 * ks + 8 * kg;
            bf16x8 hi, lo;
#pragma unroll
            for (int j = 0; j < 8; ++j) { const float w = F.norm2_g[d0 + j] * F.w_router[(size_t)(d0 + j) * 16 + e]; const unsigned h = f2bf(w); hi[j] = (short)h; lo[j] = (short)f2bf(w - __builtin_bit_cast(float, h << 16)); }
            ((bf16x8*)(F.ws + WS_WRT))[i] = hi; ((bf16x8*)(F.ws + WS_WRT))[2048 + i] = lo;
        }
        for (int i = gt; i < 256 * 128; i += NT) {
            const int jp = i >> 7, c = i & 127; const float a = (float)(((jp & 127) * c) & 127) * (1.0f / 64.0f);
            ((bf16_t*)(F.ws + WS_CST))[i] = (bf16_t)f2bf((jp < 128 ? cospif(a) : sinpif(a)) * 0.08838834764831845f);
        }
        for (int q = gt; q < 128 * 128 + 64 * 128; q += NT) {
            if (q < 128 * 128) { const int jj = q & 7, ln = (q >> 3) & 63, kap = (q >> 9) & 3, ot = q >> 11; const int o = 16 * ot + (ln & 15), kl = o >> 1, ri = o & 1, sh = 16 * kap + 4 * (ln >> 4) + (jj & 3), half = jj >> 2;
                const float a = (float)((kl * sh) & 63) * (1.0f / 32.0f);
                const float C = cospif(a), S = sinpif(a); const float v = (ri == 0) ? (half == 0 ? C : -S) : (half == 0 ? -S : -C); MA[q] = (bf16_t)f2bf(v * 0.125f); }
            else { const int qq = q - 128 * 128, kh = qq >> 7, k = qq & 127, sl = k >> 1, ri = k & 1; const float a = (float)((kh * sl) & 63) * (1.0f / 32.0f);
                MB[qq] = (bf16_t)f2bf((ri == 0 ? cospif(a) : sinpif(a)) * 0.125f); }
        }
    }
}

struct Sched1 {
    const char* A; const char* B; int G, c;
    __device__ __forceinline__ bool next(int i, Unit& u) const {
        int pm, pn; if (!pg8::static_tile(MTOK / 256, N1 / 256, G, c, i, pm, pn)) return false;
        u.A = A + (size_t)pm * 256 * D * 2; u.B = B + (size_t)pn * 256 * D * 2; u.ridx = nullptr; u.pm = pm; u.pn = pn; u.kind = 0; return true;
    }
};
struct Epi1 {
    static constexpr bool PERM = true;
    unsigned char* ws;
    __device__ __forceinline__ bool operator()(f32x4 (&acc)[2][2][4][2], const Unit& u, int wr, int wc, int fr, int fq) const {
        const int pn = u.pn;
        if (pn < 2) {
            bf16_t* Z = (bf16_t*)(ws + WS_YF);
            const int b = u.pm >> 4;
#pragma unroll
            for (int ai = 0; ai < 2; ++ai)
#pragma unroll
                for (int m = 0; m < 4; ++m) { const int s_lo = m * 16 + fr, s_hi = (u.pm & 15) * 4 + ai * 2 + wr;
#pragma unroll
                    for (int bj = 0; bj < 2; ++bj) { const f32x4 v0 = acc[ai][bj][m][0], v1 = acc[ai][bj][m][1];
                        u32x4 w; w.x = cvt_pk_bf16(v0[0], v0[1]); w.y = cvt_pk_bf16(v0[2], v0[3]); w.z = cvt_pk_bf16(v1[0], v1[1]); w.w = cvt_pk_bf16(v1[2], v1[3]);
                        *(u32x4*)(Z + ((size_t)((b * 4 + 2 * pn + bj) * 64 + s_lo) * 64 + s_hi) * 128 + wc * 32 + 8 * fq) = w; } }
            return false;
        }
        const int row0 = u.pm * 256 + wr * 64 + fr;
        if (pn >= 6) {
            bf16_t* RHO = (bf16_t*)(ws + WS_SGF); bf16_t* SGS = (bf16_t*)(ws + WS_SGS);
            const int col0 = (pn - 6) * 128 + wc * 32 + 8 * fq;
#pragma unroll
            for (int ai = 0; ai < 2; ++ai)
#pragma unroll
                for (int m = 0; m < 4; ++m) { const size_t off = (size_t)(row0 + ai * 128 + m * 16) * 1024 + col0;
                    float rho[8], sg[8];
#pragma unroll
                    for (int n = 0; n < 2; ++n)
#pragma unroll
                        for (int j = 0; j < 4; ++j) { const float ef = __builtin_amdgcn_exp2f(-1.44269504089f * acc[ai][0][m][n][j]), es = __builtin_amdgcn_exp2f(-1.44269504089f * acc[ai][1][m][n][j]);
                            const float s_ = __builtin_amdgcn_rcpf(1.0f + es); sg[n * 4 + j] = s_; rho[n * 4 + j] = (1.0f + es) * __builtin_amdgcn_rcpf(1.0f + ef); }
                    u32x4 w; w.x = cvt_pk_bf16(rho[0], rho[1]); w.y = cvt_pk_bf16(rho[2], rho[3]); w.z = cvt_pk_bf16(rho[4], rho[5]); w.w = cvt_pk_bf16(rho[6], rho[7]);
                    *(u32x4*)(RHO + off) = w;
                    w.x = cvt_pk_bf16(sg[0], sg[1]); w.y = cvt_pk_bf16(sg[2], sg[3]); w.z = cvt_pk_bf16(sg[4], sg[5]); w.w = cvt_pk_bf16(sg[6], sg[7]);
                    *(u32x4*)(SGS + off) = w; }
            return false;
        }
        bf16_t* base = (bf16_t*)(ws + (pn < 4 ? WS_GU : WS_GV)); const int colt = (pn & 1) * 256;
        const int col0 = colt + wc * 32 + 8 * fq;
#pragma unroll
        for (int ai = 0; ai < 2; ++ai)
#pragma unroll
            for (int m = 0; m < 4; ++m) { bf16_t* rowp = base + (size_t)(row0 + ai * 128 + m * 16) * 512 + col0;
#pragma unroll
                for (int bj = 0; bj < 2; ++bj) { f32x4 v0 = acc[ai][bj][m][0], v1 = acc[ai][bj][m][1];
#pragma unroll
                    for (int j = 0; j < 4; ++j) { v0[j] = gelu_tanh(v0[j]); v1[j] = gelu_tanh(v1[j]); }
                    u32x4 w; w.x = cvt_pk_bf16(v0[0], v0[1]); w.y = cvt_pk_bf16(v0[2], v0[3]); w.z = cvt_pk_bf16(v1[0], v1[1]); w.w = cvt_pk_bf16(v1[2], v1[3]);
                    *(u32x4*)(rowp + bj * 128) = w; } }
        return false;
    }
};

__device__ __forceinline__ int p2_sgu_prefill(const Ctx& F) {
    if (F.bid >= 1024 || (F.G & 3)) return -1;
    constexpr int PITCH = 136; LAS bf16_t* Ws = (LAS bf16_t*)(F.lds);
    const int h = F.bid & 3; const float* wsrc = F.w_sp + (size_t)h * 128 * 128;
#pragma unroll
    for (int i = 0; i < 8; ++i) { const int idx = F.tid * 4 + i * 2048; const int p = idx >> 7, q = idx & 127; const f32x4 v = *(const f32x4*)(wsrc + idx);
        u32x2 w; w.x = cvt_pk_bf16(v.x, v.y); w.y = cvt_pk_bf16(v.z, v.w); *(LAS u32x2*)(Ws + p * PITCH + q) = w; }
    return h;
}
__device__ __forceinline__ void p2_sgu(const Ctx& F, const int h_pre) {
    constexpr int PITCH = 136;
    LAS bf16_t* Ws = (LAS bf16_t*)(F.lds);
    constexpr int SPITCH = 528;
    LAS unsigned char* Vq = F.lds + 128 * PITCH * 2;
    LAS unsigned char* ST = Vq + 32768;
    const bf16_t* GU = (const bf16_t*)(F.ws + WS_GU); const bf16_t* GV = (const bf16_t*)(F.ws + WS_GV); bf16_t* SG = (bf16_t*)(F.ws + WS_SG);
    const int lane = F.lane, wave = F.wave, cp = lane & 15, rs4 = lane >> 4;
    int h_loaded = h_pre; float bs = (h_pre >= 0) ? F.b_sp[h_pre * 128 + F.wave * 16 + (F.lane & 15)] : 0.f;
    u32x4 raw[4], uu[4];
    if (F.bid < 1024) { const int h = F.bid & 3; const size_t r0 = (size_t)(F.bid >> 2) * 128;
#pragma unroll
        for (int i = 0; i < 4; ++i) raw[i] = __builtin_nontemporal_load((const u32x4*)(GV + (r0 + wave * 16 + i * 4 + rs4) * 512 + h * 128 + 8 * cp));
#pragma unroll
        for (int i = 0; i < 4; ++i) uu[i] = __builtin_nontemporal_load((const u32x4*)(GU + (r0 + wave * 16 + i * 4 + rs4) * 512 + h * 128 + 8 * cp)); }
    for (int tt = F.bid; tt < 1024; tt += F.G) {
        const int h = tt & 3, bn = tt >> 2; const size_t r0 = (size_t)bn * 128;
        __builtin_amdgcn_s_barrier();
        asm volatile("" ::: "memory");
        if (h != h_loaded) {
            const float* wsrc = F.w_sp + (size_t)h * 128 * 128;
#pragma unroll
            for (int i = 0; i < 8; ++i) { const int idx = F.tid * 4 + i * 2048; const int p = idx >> 7, q = idx & 127; const f32x4 v = *(const f32x4*)(wsrc + idx);
                u32x2 w; w.x = cvt_pk_bf16(v.x, v.y); w.y = cvt_pk_bf16(v.z, v.w); *(LAS u32x2*)(Ws + p * PITCH + q) = w; }
            bs = F.b_sp[h * 128 + wave * 16 + (lane & 15)];
            h_loaded = h;
        }
        float ln_tok = 0.f;
        { const f32x4 g0v = *(const f32x4*)(F.ln_g + h * 128 + 8 * cp), g1v = *(const f32x4*)(F.ln_g + h * 128 + 8 * cp + 4), b0v = *(const f32x4*)(F.ln_b + h * 128 + 8 * cp), b1v = *(const f32x4*)(F.ln_b + h * 128 + 8 * cp + 4);
#pragma unroll
          for (int i = 0; i < 4; ++i) { const int q = wave * 16 + i * 4 + rs4;
              float x[8] = {bf_lo(raw[i].x), bf_hi(raw[i].x), bf_lo(raw[i].y), bf_hi(raw[i].y), bf_lo(raw[i].z), bf_hi(raw[i].z), bf_lo(raw[i].w), bf_hi(raw[i].w)};
              float sm = ((x[0] + x[1]) + (x[2] + x[3])) + ((x[4] + x[5]) + (x[6] + x[7]));
              sm = row16_sum(sm);
              const float mu = sm * (1.0f / 128.0f); float sq = 0.f;
#pragma unroll
              for (int j = 0; j < 8; ++j) { x[j] -= mu; sq += x[j] * x[j]; }
              sq = row16_sum(sq);
              const float rs = 1.0f / sqrtf(sq * (1.0f / 128.0f) + EPS); ln_tok = rs;
              const float gq[8] = {g0v.x, g0v.y, g0v.z, g0v.w, g1v.x, g1v.y, g1v.z, g1v.w}, bq[8] = {b0v.x, b0v.y, b0v.z, b0v.w, b1v.x, b1v.y, b1v.z, b1v.w};
              u32x4 w; w.x = cvt_pk_bf16(x[0] * rs * gq[0] + bq[0], x[1] * rs * gq[1] + bq[1]); w.y = cvt_pk_bf16(x[2] * rs * gq[2] + bq[2], x[3] * rs * gq[3] + bq[3]);
              w.z = cvt_pk_bf16(x[4] * rs * gq[4] + bq[4], x[5] * rs * gq[5] + bq[5]); w.w = cvt_pk_bf16(x[6] * rs * gq[6] + bq[6], x[7] * rs * gq[7] + bq[7]);
              const int fq_ = (q & 3) | (((q >> 3) & 1) << 2);
              *(LAS u32x4*)(Vq + q * 256 + ((cp ^ (fq_ << 1)) << 4)) = w; } }
        const int p = wave * 16 + (lane & 15);
        u32x4 uc[4];
#pragma unroll
        for (int ct = 0; ct < 4; ++ct) { asm volatile("" : "+v"(uu[ct].x), "+v"(uu[ct].y), "+v"(uu[ct].z), "+v"(uu[ct].w) : "v"(ln_tok));
            uc[ct] = uu[ct]; }
        if (tt + F.G < 1024) { const int tn = tt + F.G, hn = tn & 3; const size_t rn = (size_t)(tn >> 2) * 128;
#pragma unroll
            for (int i = 0; i < 4; ++i) raw[i] = __builtin_nontemporal_load((const u32x4*)(GV + (rn + wave * 16 + i * 4 + rs4) * 512 + hn * 128 + 8 * cp));
#pragma unroll
            for (int i = 0; i < 4; ++i) uu[i] = __builtin_nontemporal_load((const u32x4*)(GU + (rn + wave * 16 + i * 4 + rs4) * 512 + hn * 128 + 8 * cp)); }
        asm volatile("s_waitcnt lgkmcnt(0)" ::: "memory");
        __builtin_amdgcn_s_barrier();
        asm volatile("" ::: "memory");
        f32x4 acc[8];
#pragma unroll
        for (int ct = 0; ct < 8; ++ct) acc[ct] = (f32x4){0.f, 0.f, 0.f, 0.f};
        { const int G_ = lane >> 4, q_ = (lane >> 2) & 3, p_ = lane & 3, fsw_ = q_ | ((G_ & 1) << 2);
          const LAS unsigned char* vb = Vq + (8 * G_ + q_) * 256 + p_ * 8;
#pragma unroll
          for (int ks = 0; ks < 4; ++ks) {
            const bf16x8 bw = *(const LAS bf16x8*)(Ws + (wave * 16 + (lane & 15)) * PITCH + ks * 32 + 8 * (lane >> 4));
#pragma unroll
            for (int ct = 0; ct < 8; ++ct) { const unsigned o = (unsigned)(ks * 32 * 256) + ((unsigned)(ct ^ fsw_) << 5);
                const s16x4 lo = __builtin_amdgcn_ds_read_tr16_b64_v4i16((LAS s16x4*)(vb + o));
                const s16x4 hi = __builtin_amdgcn_ds_read_tr16_b64_v4i16((LAS s16x4*)(vb + o + 4 * 256));
                bf16x8 av; av[0] = lo[0]; av[1] = lo[1]; av[2] = lo[2]; av[3] = lo[3]; av[4] = hi[0]; av[5] = hi[1]; av[6] = hi[2]; av[7] = hi[3];
                acc[ct] = __builtin_amdgcn_mfma_f32_16x16x32_bf16(av, bw, acc[ct], 0, 0, 0); }
          } }
#pragma unroll
        for (int ct = 0; ct < 8; ++ct) { const int slot = (2 * ct + ((lane >> 5) & 1)) | (((lane >> 4) & 1) << 4);
            *(LAS f32x4*)(ST + p * SPITCH + slot * 16) = (f32x4){acc[ct][0] + bs, acc[ct][1] + bs, acc[ct][2] + bs, acc[ct][3] + bs}; }
        asm volatile("" ::: "memory");
#pragma unroll
        for (int i = 0; i < 4; ++i) { const int row = wave * 16 + i * 4 + rs4;
            const f32x4 g0 = *(const LAS f32x4*)(ST + row * SPITCH + cp * 16), g1 = *(const LAS f32x4*)(ST + row * SPITCH + (16 + cp) * 16);
            u32x4 o; o.x = cvt_pk_bf16(bf_lo(uc[i].x) * g0[0], bf_hi(uc[i].x) * g0[1]); o.y = cvt_pk_bf16(bf_lo(uc[i].y) * g0[2], bf_hi(uc[i].y) * g0[3]);
            o.z = cvt_pk_bf16(bf_lo(uc[i].z) * g1[0], bf_hi(uc[i].z) * g1[1]); o.w = cvt_pk_bf16(bf_lo(uc[i].w) * g1[2], bf_hi(uc[i].w) * g1[3]);
            *(u32x4*)(SG + (r0 + row) * 512 + h * 128 + 8 * cp) = o; }
    }
    __syncthreads();
}

template <int STAGE>
__device__ __forceinline__ void fft_stage(const Ctx& F) {
    constexpr int OPITCH = 272;
    constexpr int OBYTES = 128 * OPITCH;
    constexpr int IMG = (STAGE == 0) ? 16384 : 32768;
    constexpr int NDMA = IMG / 8192;
    LAS unsigned char* lds = F.lds;
    const int lane = F.lane, wave = F.wave, tid = F.tid, l15 = lane & 15;
    const int G = lane >> 4, q = (lane >> 2) & 3, p = lane & 3, fsw = q | ((G & 1) << 2);
    const bf16_t* MAT = (const bf16_t*)(F.ws + (STAGE == 0 ? WS_MA : WS_MB));
    const bf16_t* SRC = (const bf16_t*)(F.ws + (STAGE == 0 ? WS_YF : WS_AP));
    const int mt = (STAGE == 0) ? wave : (wave & 3);
    constexpr int NJT = (STAGE == 0) ? 8 : 4;
    const int jt0 = (STAGE == 0) ? 0 : 4 * (wave >> 2);
    bf16x8 afr[4];
#pragma unroll
    for (int ks = 0; ks < 4; ++ks) afr[ks] = *(const bf16x8*)(MAT + (size_t)(mt * 16 + l15) * 128 + ks * 32 + 8 * G);
    bf16x8 bcs[2][4];
    if constexpr (STAGE == 0) {
#pragma unroll
        for (int t2 = 0; t2 < 2; ++t2)
#pragma unroll
            for (int ks = 0; ks < 4; ++ks) bcs[t2][ks] = *(const bf16x8*)((const bf16_t*)(F.ws + WS_CST) + (size_t)(16 * (2 * wave + t2) + l15) * 128 + ks * 32 + 8 * G);
    }
    unsigned soff[NDMA];
#pragma unroll
    for (int i = 0; i < NDMA; ++i) { const int pos = i * 512 + tid, row = pos >> 4, cp = pos & 15; const int f = (row & 3) | (((row >> 3) & 1) << 2);
        soff[i] = (unsigned)(row * 256 + ((STAGE == 0 ? (cp ^ (row & 15)) : (cp ^ (f << 1))) << 4)); }
    const unsigned rbase = (unsigned)((8 * G + q) * 256 + p * 8);
#define FFT_DMA(buf, t) do { const char* src_ = (const char*)SRC + (size_t)(t) * IMG; _Pragma("unroll") for (int i_ = 0; i_ < NDMA; ++i_) \
        glds16_asm(src_ + soff[i_], (unsigned)__builtin_amdgcn_readfirstlane((int)(unsigned)(size_t)(lds + (buf) * IMG + i_ * 8192 + wave * 1024))); } while (0)
#define FFT_STORE(tp, ob) do { const int bg_ = (tp) >> 6, lo6_ = (tp) & 63; \
        if constexpr (STAGE == 0) { bf16_t* AP = (bf16_t*)(F.ws + WS_AP); _Pragma("unroll") for (int i_ = 0; i_ < 4; ++i_) { const int id_ = tid + 512 * i_, row_ = id_ >> 4, c_ = id_ & 15; \
                const u32x4 v_ = *(const LAS u32x4*)((ob) + row_ * OPITCH + c_ * 16); \
                *(u32x4*)(AP + ((size_t)(bg_ * 64 + (row_ >> 1)) * 64 + lo6_) * 256 + (row_ & 1) * 128 + c_ * 8) = v_; } } \
        else { bf16_t* FM = (bf16_t*)(F.ws + WS_FM); _Pragma("unroll") for (int i_ = 0; i_ < 2; ++i_) { const int id_ = tid + 512 * i_, row_ = id_ >> 4, c_ = id_ & 15; \
                const u32x4 v_ = *(const LAS u32x4*)((ob) + row_ * OPITCH + c_ * 16); \
                *(u32x4*)(FM + ((size_t)(bg_ >> 2) * SEQ + lo6_ + 64 * row_) * FW + (bg_ & 3) * 128 + c_ * 8) = v_; } } } while (0)
    int t = F.bid, buf = 0, tprev = -1;
    if (t < 2048) FFT_DMA(0, t);
    for (; t < 2048; tprev = t, t += F.G, buf ^= 1) {
        asm volatile("s_waitcnt vmcnt(0) lgkmcnt(0)" ::: "memory");
        __builtin_amdgcn_s_barrier();
        asm volatile("" ::: "memory");
        if (t + F.G < 2048) FFT_DMA(buf ^ 1, t + F.G);
        if (tprev >= 0) FFT_STORE(tprev, lds + 65536 + (buf ^ 1) * OBYTES);
        const LAS unsigned char* xb;
        if constexpr (STAGE == 0) {
            const LAS unsigned char* zb = lds + buf * IMG;
            f32x4 a1[4][2];
#pragma unroll
            for (int st = 0; st < 4; ++st) { a1[st][0] = (f32x4){0.f, 0.f, 0.f, 0.f}; a1[st][1] = (f32x4){0.f, 0.f, 0.f, 0.f}; }
#pragma unroll
            for (int ks = 0; ks < 4; ++ks) { bf16x8 az[4];
#pragma unroll
                for (int st = 0; st < 4; ++st) az[st] = *(const LAS bf16x8*)(zb + (16 * st + l15) * 256 + (((4 * ks + G) ^ l15) << 4));
                __builtin_amdgcn_sched_barrier(0);
#pragma unroll
                for (int st = 0; st < 4; ++st) { a1[st][0] = __builtin_amdgcn_mfma_f32_16x16x32_bf16(az[st], bcs[0][ks], a1[st][0], 0, 0, 0);
                    a1[st][1] = __builtin_amdgcn_mfma_f32_16x16x32_bf16(az[st], bcs[1][ks], a1[st][1], 0, 0, 0); }
                __builtin_amdgcn_sched_barrier(0); }
            LAS unsigned char* xw = lds + 32768;
#pragma unroll
            for (int t2 = 0; t2 < 2; ++t2) { const int jt = 2 * wave + t2, half = jt >> 3, j = 16 * (jt & 7) + l15;
#pragma unroll
                for (int st = 0; st < 4; ++st)
#pragma unroll
                    for (int r = 0; r < 4; ++r) { const int k = 2 * (16 * st + 4 * G + r) + half; const int f = (k & 3) | (((k >> 3) & 1) << 2);
                        *(LAS bf16_t*)(xw + k * 256 + ((((j >> 3) ^ (f << 1))) << 4) + (j & 7) * 2) = (bf16_t)f2bf(a1[st][t2][r]); } }
            asm volatile("s_waitcnt lgkmcnt(0)" ::: "memory");
            __builtin_amdgcn_s_barrier();
            asm volatile("" ::: "memory");
            xb = lds + 32768 + rbase;
        } else {
            xb = lds + buf * IMG + rbase;
        }
        f32x4 acc[NJT];
#pragma unroll
        for (int jt = 0; jt < NJT; ++jt) acc[jt] = (f32x4){0.f, 0.f, 0.f, 0.f};
#pragma unroll
        for (int ks = 0; ks < 4; ++ks) { s16x4 lo[NJT], hi[NJT];
#pragma unroll
            for (int jt = 0; jt < NJT; ++jt) { const unsigned o = (unsigned)(ks * 32 * 256) + ((unsigned)(((jt0 + jt) ^ fsw)) << 5);
                lo[jt] = __builtin_amdgcn_ds_read_tr16_b64_v4i16((LAS s16x4*)(xb + o)); hi[jt] = __builtin_amdgcn_ds_read_tr16_b64_v4i16((LAS s16x4*)(xb + o + 4 * 256)); }
            __builtin_amdgcn_sched_barrier(0);
#pragma unroll
            for (int jt = 0; jt < NJT; ++jt) { bf16x8 bfr; bfr[0] = lo[jt][0]; bfr[1] = lo[jt][1]; bfr[2] = lo[jt][2]; bfr[3] = lo[jt][3]; bfr[4] = hi[jt][0]; bfr[5] = hi[jt][1]; bfr[6] = hi[jt][2]; bfr[7] = hi[jt][3];
                acc[jt] = (STAGE == 0) ? __builtin_amdgcn_mfma_f32_16x16x32_bf16(afr[ks], bfr, acc[jt], 0, 0, 0) : __builtin_amdgcn_mfma_f32_16x16x32_bf16(bfr, afr[ks], acc[jt], 0, 0, 0); }
            __builtin_amdgcn_sched_barrier(0); }
        LAS unsigned char* ob = lds + 65536 + buf * OBYTES;
        if constexpr (STAGE == 0) {
            const int s_lo = t & 63, kl0 = 8 * wave + 2 * G;
            float c0, s0, c1, s1;
            sincospif((float)((kl0 * s_lo) & 4095) * (1.0f / 2048.0f), &s0, &c0);
            sincospif((float)(((kl0 + 1) * s_lo) & 4095) * (1.0f / 2048.0f), &s1, &c1);
#pragma unroll
            for (int jt = 0; jt < NJT; ++jt) { const f32x4 a = acc[jt]; const int col = 16 * jt + l15;
                LAS bf16_t* o0 = (LAS bf16_t*)(ob + (mt * 16 + 4 * G) * OPITCH) + col;
                o0[0 * (OPITCH / 2)] = (bf16_t)f2bf(a[0] * c0 + a[1] * s0); o0[1 * (OPITCH / 2)] = (bf16_t)f2bf(a[1] * c0 - a[0] * s0);
                o0[2 * (OPITCH / 2)] = (bf16_t)f2bf(a[2] * c1 + a[3] * s1); o0[3 * (OPITCH / 2)] = (bf16_t)f2bf(a[3] * c1 - a[2] * s1); }
        } else {
            if constexpr (NJT == 4) asm volatile("s_nop 15\n\ts_nop 15" : "+v"(acc[0]), "+v"(acc[1]), "+v"(acc[2]), "+v"(acc[3]));
#pragma unroll
            for (int jt = 0; jt < NJT; ++jt) { const f32x4 a = acc[jt];
                *(LAS u32x2*)(ob + (mt * 16 + l15) * OPITCH + (16 * (jt0 + jt) + 4 * G) * 2) = (u32x2){cvt_pk_bf16(a[0], a[1]), cvt_pk_bf16(a[2], a[3])}; }
        }
    }
    asm volatile("s_waitcnt lgkmcnt(0)" ::: "memory");
    __builtin_amdgcn_s_barrier();
    asm volatile("" ::: "memory");
    if (tprev >= 0) FFT_STORE(tprev, lds + 65536 + (buf ^ 1) * OBYTES);
    asm volatile("s_waitcnt vmcnt(0) lgkmcnt(0)" ::: "memory");
    __builtin_amdgcn_s_barrier();
#undef FFT_STORE
#undef FFT_DMA
}

__device__ __forceinline__ void fft_stage_a(const Ctx& F) {
    constexpr int OPITCH = 272, OBYTES = 128 * OPITCH, IMG = 16384;
    constexpr int MAP_OFF = 32768, OUT_OFF = 65536, TW_OFF = OUT_OFF + 2 * OBYTES;
    LAS unsigned char* lds = F.lds;
    const int lane = F.lane, wave = F.wave, tid = F.tid, l15 = lane & 15, G = lane >> 4;
    const bf16_t* SRC = (const bf16_t*)(F.ws + WS_YF);
    bf16x8 bcs[2][4];
#pragma unroll
    for (int t2 = 0; t2 < 2; ++t2)
#pragma unroll
        for (int ks = 0; ks < 4; ++ks) bcs[t2][ks] = *(const bf16x8*)((const bf16_t*)(F.ws + WS_CST) + (size_t)(16 * (wave + 8 * t2) + l15) * 128 + ks * 32 + 8 * G);
    bf16x8 am[8][2];
#pragma unroll
    for (int ot = 0; ot < 8; ++ot)
#pragma unroll
        for (int kap = 0; kap < 2; ++kap) am[ot][kap] = *(const bf16x8*)(F.ws + WS_MA + ((ot * 4 + kap) * 64 + lane) * 16);
    for (int i = tid; i < 2048; i += 512) ((LAS u32x4*)(lds + MAP_OFF))[i] = ((const u32x4*)(F.ws + WS_MA))[i];
    unsigned soff[2];
#pragma unroll
    for (int i = 0; i < 2; ++i) { const int pos = i * 512 + tid, row = pos >> 4, cp = pos & 15; soff[i] = (unsigned)(row * 256 + ((cp ^ (row & 15)) << 4)); }
#define FA_DMA(buf, t) do { const char* src_ = (const char*)SRC + (size_t)(t) * IMG; _Pragma("unroll") for (int i_ = 0; i_ < 2; ++i_) \
        glds16_asm(src_ + soff[i_], (unsigned)__builtin_amdgcn_readfirstlane((int)(unsigned)(size_t)(lds + (buf) * IMG + i_ * 8192 + wave * 1024))); } while (0)
#define FA_TW(slot, t) do { if (wave == 0) { float c_, s_; sincospif((float)((lane * ((t) & 63)) & 4095) * (1.0f / 2048.0f), &s_, &c_); ((LAS f32x2*)(lds + TW_OFF))[(slot) * 64 + lane] = (f32x2){c_, s_}; } } while (0)
#define FA_STORE(tp, ob) do { const int bg_ = (tp) >> 6, lo6_ = (tp) & 63; bf16_t* AP = (bf16_t*)(F.ws + WS_AP); _Pragma("unroll") for (int i_ = 0; i_ < 4; ++i_) { const int id_ = tid + 512 * i_, row_ = id_ >> 4, c_ = id_ & 15; \
        const u32x4 v_ = *(const LAS u32x4*)((ob) + row_ * OPITCH + c_ * 16); \
        *(u32x4*)(AP + ((size_t)(bg_ * 64 + (row_ >> 1)) * 64 + lo6_) * 256 + (row_ & 1) * 128 + c_ * 8) = v_; } } while (0)
    int t = F.bid, buf = 0, tprev = -1;
    const bool tw_varies = (F.G & 63) != 0;
    if (t < 2048) { FA_DMA(0, t); FA_TW(0, t); FA_TW(1, t + F.G); }
    for (; t < 2048; tprev = t, t += F.G, buf ^= 1) {
        asm volatile("s_waitcnt vmcnt(0) lgkmcnt(0)" ::: "memory");
        __builtin_amdgcn_s_barrier();
        asm volatile("" ::: "memory");
        if (t + F.G < 2048) { FA_DMA(buf ^ 1, t + F.G); if (tw_varies) FA_TW(buf ^ 1, t + F.G); }
        if (tprev >= 0) FA_STORE(tprev, lds + OUT_OFF + (buf ^ 1) * OBYTES);
        const LAS unsigned char* zb = lds + buf * IMG;
        f32x4 a1[4][2];
#pragma unroll
        for (int st = 0; st < 4; ++st) { a1[st][0] = (f32x4){0.f, 0.f, 0.f, 0.f}; a1[st][1] = (f32x4){0.f, 0.f, 0.f, 0.f}; }
#pragma unroll
        for (int ks = 0; ks < 4; ++ks) { bf16x8 az[4];
#pragma unroll
            for (int st = 0; st < 4; ++st) az[st] = *(const LAS bf16x8*)(zb + (16 * st + l15) * 256 + (((4 * ks + G) ^ l15) << 4));
            __builtin_amdgcn_sched_barrier(0);
#pragma unroll
            for (int st = 0; st < 4; ++st) { a1[st][0] = __builtin_amdgcn_mfma_f32_16x16x32_bf16(az[st], bcs[0][ks], a1[st][0], 0, 0, 0);
                a1[st][1] = __builtin_amdgcn_mfma_f32_16x16x32_bf16(az[st], bcs[1][ks], a1[st][1], 0, 0, 0); }
            __builtin_amdgcn_sched_barrier(0); }
        asm volatile("s_nop 15\n\ts_nop 15" : "+v"(a1[0][0]), "+v"(a1[0][1]), "+v"(a1[1][0]), "+v"(a1[1][1]), "+v"(a1[2][0]), "+v"(a1[2][1]), "+v"(a1[3][0]), "+v"(a1[3][1]));
        f32x4 acc[8];
#pragma unroll
        for (int ot = 0; ot < 8; ++ot) acc[ot] = (f32x4){0.f, 0.f, 0.f, 0.f};
#pragma unroll
        for (int kap = 0; kap < 4; ++kap) {
            u32x4 bw; bw.x = cvt_pk_bf16(a1[kap][0][0], a1[kap][0][1]); bw.y = cvt_pk_bf16(a1[kap][0][2], a1[kap][0][3]); bw.z = cvt_pk_bf16(a1[kap][1][0], a1[kap][1][1]); bw.w = cvt_pk_bf16(a1[kap][1][2], a1[kap][1][3]);
            const bf16x8 bfr = __builtin_bit_cast(bf16x8, bw);
            if (kap < 2) {
#pragma unroll
                for (int ot = 0; ot < 8; ++ot) acc[ot] = __builtin_amdgcn_mfma_f32_16x16x32_bf16(bfr, am[ot][kap], acc[ot], 0, 0, 0);
            } else {
                bf16x8 al[8];
#pragma unroll
                for (int ot = 0; ot < 8; ++ot) al[ot] = *(const LAS bf16x8*)(lds + MAP_OFF + ((ot * 4 + kap) * 64 + lane) * 16);
                __builtin_amdgcn_sched_barrier(0);
#pragma unroll
                for (int ot = 0; ot < 8; ++ot) acc[ot] = __builtin_amdgcn_mfma_f32_16x16x32_bf16(bfr, al[ot], acc[ot], 0, 0, 0);
                __builtin_amdgcn_sched_barrier(0);
            }
        }
        LAS unsigned char* ob = lds + OUT_OFF + buf * OBYTES;
        const LAS f32x2* twp = (const LAS f32x2*)(lds + TW_OFF + buf * 512) + (l15 >> 1);
#pragma unroll
        for (int ot = 0; ot < 8; ++ot) { const f32x2 tw = twp[8 * ot]; const float c = tw[0], sg = (l15 & 1) ? -tw[1] : tw[1]; const f32x4 a = acc[ot]; float y[4];
#pragma unroll
            for (int r = 0; r < 4; ++r) { float xr = a[r]; asm volatile("" : "+v"(xr));
                const float pr = __builtin_bit_cast(float, __builtin_amdgcn_update_dpp(0, __builtin_bit_cast(int, xr), 0xB1, 0xF, 0xF, true)); y[r] = xr * c + pr * sg; }
            *(LAS u32x2*)(ob + (16 * ot + l15) * OPITCH + (16 * wave + 4 * G) * 2) = (u32x2){pk2(y[0], y[1]), pk2(y[2], y[3])}; }
    }
    asm volatile("s_waitcnt lgkmcnt(0)" ::: "memory");
    __builtin_amdgcn_s_barrier();
    asm volatile("" ::: "memory");
    if (tprev >= 0) FA_STORE(tprev, lds + OUT_OFF + (buf ^ 1) * OBYTES);
    asm volatile("s_waitcnt vmcnt(0) lgkmcnt(0)" ::: "memory");
    __builtin_amdgcn_s_barrier();
#undef FA_DMA
#undef FA_TW
#undef FA_STORE
}

struct Sched3 {
    const char* A0; const char* A1; const char* B0; const char* B1; int G, c;
    __device__ __forceinline__ bool next(int i, Unit& u) const {
        int pm, pn; if (!pg8::static_tile(MTOK / 256, D / 256, G, c, i >> 1, pm, pn)) return false;
        const int sub = i & 1;
        u.A = (sub ? A1 : A0) + (size_t)pm * 256 * 512 * 2; u.B = (sub ? B1 : B0) + (size_t)pn * 256 * 512 * 2; u.ridx = nullptr; u.pm = pm; u.pn = pn; u.kind = sub; return true;
    }
};
struct Epi3 {
    static constexpr bool PERM = true;
    const bf16_t* RHO; const bf16_t* SGS; bf16_t* MRG;
    __device__ __forceinline__ bool operator()(f32x4 (&acc)[2][2][4][2], const Unit& u, int wr, int wc, int fr, int fq) const {
        const int row0 = u.pm * 256 + wr * 64 + fr, col0 = u.pn * 256 + wc * 32 + 8 * fq;
        const bf16_t* G = (u.kind == 0) ? RHO : SGS;
        u32x4 g[2][4][2];
#pragma unroll
        for (int ai = 0; ai < 2; ++ai)
#pragma unroll
            for (int m = 0; m < 4; ++m)
#pragma unroll
                for (int bj = 0; bj < 2; ++bj) g[ai][m][bj] = __builtin_nontemporal_load((const u32x4*)(G + (size_t)(row0 + ai * 128 + m * 16) * D + col0 + bj * 128));
#pragma unroll
        for (int ai = 0; ai < 2; ++ai)
#pragma unroll
            for (int m = 0; m < 4; ++m)
#pragma unroll
                for (int bj = 0; bj < 2; ++bj) { const u32x4 s = g[ai][m][bj]; f32x4& v0 = acc[ai][bj][m][0]; f32x4& v1 = acc[ai][bj][m][1];
                    v0[0] *= bf_lo(s.x); v0[1] *= bf_hi(s.x); v0[2] *= bf_lo(s.y); v0[3] *= bf_hi(s.y); v1[0] *= bf_lo(s.z); v1[1] *= bf_hi(s.z); v1[2] *= bf_lo(s.w); v1[3] *= bf_hi(s.w);
                    if (u.kind != 0) { u32x4 w; w.x = cvt_pk_bf16(v0[0], v0[1]); w.y = cvt_pk_bf16(v0[2], v0[3]); w.z = cvt_pk_bf16(v1[0], v1[1]); w.w = cvt_pk_bf16(v1[2], v1[3]);
                        *(u32x4*)(MRG + (size_t)(row0 + ai * 128 + m * 16) * D + col0 + bj * 128) = w; } }
        return u.kind == 0;
    }
};

struct Sched4 {
    const char* A; const char* B; int G, c;
    __device__ __forceinline__ bool next(int i, Unit& u) const {
        int pm, pn; if (!pg8::static_tile(MTOK / 256, D / 256, G, c, i, pm, pn)) return false;
        u.A = A + (size_t)pm * 256 * D * 2; u.B = B + (size_t)pn * 256 * D * 2; u.ridx = nullptr; u.pm = pm; u.pn = pn; u.kind = 0; return true;
    }
};
struct Epi4 {
    static constexpr bool PERM = true;
    bf16_t* DLT;
    __device__ __forceinline__ bool operator()(f32x4 (&acc)[2][2][4][2], const Unit& u, int wr, int wc, int fr, int fq) const {
        const int row0 = u.pm * 256 + wr * 64 + fr, col0 = u.pn * 256 + wc * 32 + 8 * fq;
#pragma unroll
        for (int ai = 0; ai < 2; ++ai)
#pragma unroll
            for (int m = 0; m < 4; ++m) { bf16_t* rowp = DLT + (size_t)(row0 + ai * 128 + m * 16) * D + col0;
#pragma unroll
                for (int bj = 0; bj < 2; ++bj) { const f32x4 v0 = acc[ai][bj][m][0], v1 = acc[ai][bj][m][1];
                    u32x4 w; w.x = cvt_pk_bf16(v0[0], v0[1]); w.y = cvt_pk_bf16(v0[2], v0[3]); w.z = cvt_pk_bf16(v1[0], v1[1]); w.w = cvt_pk_bf16(v1[2], v1[3]);
                    *(u32x4*)(rowp + bj * 128) = w; } }
        return false;
    }
};

__device__ __forceinline__ void p5_rows_prefill(const Ctx& F) {
    LAS bf16x8* WB = (LAS bf16x8*)F.lds; LAS float* G2L = (LAS float*)(F.lds + 65536);
    for (int i = F.tid; i < 4096; i += 512) WB[i] = ((const bf16x8*)(F.ws + WS_WRT))[i];
    for (int i = F.tid; i < 256; i += 512) ((LAS f32x4*)G2L)[i] = ((const f32x4*)F.norm2_g)[i];
}
__device__ __forceinline__ void p5_rows(const Ctx& F, const int parts, const bool prefilled = false) {
    LAS float* scr = (LAS float*)(F.lds + F.wave * 16384);
    const int gw = F.bid * 8 + F.wave, NGW = F.G * 8;
    if (!(parts & 2)) return;
    LAS bf16x8* WB = (LAS bf16x8*)F.lds;
    LAS float* G2L = (LAS float*)(F.lds + 65536);
    if (!prefilled) { for (int i = F.tid; i < 4096; i += 512) WB[i] = ((const bf16x8*)(F.ws + WS_WRT))[i];
        for (int i = F.tid; i < 256; i += 512) ((LAS f32x4*)G2L)[i] = ((const f32x4*)F.norm2_g)[i]; }
    __syncthreads();
    const float* X1 = F.x; const bf16_t* DLT = (const bf16_t*)(F.ws + WS_DLT); unsigned char* H2 = (unsigned char*)(F.ws + WS_H2); float* AFF = (float*)(F.ws + WS_AFF); float* RSTD = (float*)(F.ws + WS_RSTD);
    const int lane = F.lane, row = lane & 15, kg = lane >> 4;
    for (int task = gw; task < MTOK / 16; task += NGW) {
        const size_t r0 = (size_t)task * 16;
        const float* xp = X1 + (r0 + row) * D + 8 * kg; const bf16_t* dp = DLT + (r0 + row) * D + 8 * kg;
        unsigned char* hq = H2 + (r0 + row) * D + (kg & 1) * 32 + (kg >> 1) * 16; u32x2 h8p = (u32x2){0u, 0u};
        f32x4 acc = (f32x4){0.f, 0.f, 0.f, 0.f}; float ss = 0.f;
#define ROWS_LOAD(XA, XB, DD, c) do { _Pragma("unroll") for (int u = 0; u < 4; ++u) { XA[u] = __builtin_nontemporal_load((const f32x4*)(xp + ((c) * 4 + u) * 32)); XB[u] = __builtin_nontemporal_load((const f32x4*)(xp + ((c) * 4 + u) * 32 + 4)); DD[u] = __builtin_nontemporal_load((const u32x4*)(dp + ((c) * 4 + u) * 32)); } } while (0)
#define ROWS_PROC(XA, XB, DD, c) do { _Pragma("unroll") for (int u = 0; u < 4; ++u) { \
            const int ks = (c) * 4 + u; \
            const f32x4 a = XA[u] + (f32x4){bf_lo(DD[u].x), bf_hi(DD[u].x), bf_lo(DD[u].y), bf_hi(DD[u].y)}, b = XB[u] + (f32x4){bf_lo(DD[u].z), bf_hi(DD[u].z), bf_lo(DD[u].w), bf_hi(DD[u].w)};     \
            ss += (a.x * a.x + a.y * a.y) + (a.z * a.z + a.w * a.w) + (b.x * b.x + b.y * b.y) + (b.z * b.z + b.w * b.w); \
            const f32x4 ga = *(const LAS f32x4*)(G2L + 32 * ks + 8 * kg), gb = *(const LAS f32x4*)(G2L + 32 * ks + 8 * kg + 4); \
            u32x2 h8; h8.x = pk4_fp8(a.x * ga.x, a.y * ga.y, a.z * ga.z, a.w * ga.w); h8.y = pk4_fp8(b.x * gb.x, b.y * gb.y, b.z * gb.z, b.w * gb.w); \
            if (u & 1) *(u32x4*)(hq + 32 * (ks - 1)) = widen16(h8p, h8); else h8p = h8;     \
            u32x4 hw, lw; \
            hw.x = cvt_pk_bf16(a.x, a.y); hw.y = cvt_pk_bf16(a.z, a.w); hw.z = cvt_pk_bf16(b.x, b.y); hw.w = cvt_pk_bf16(b.z, b.w); \
            lw.x = cvt_pk_bf16(a.x - bf_lo(hw.x), a.y - bf_hi(hw.x)); lw.y = cvt_pk_bf16(a.z - bf_lo(hw.y), a.w - bf_hi(hw.y)); \
            lw.z = cvt_pk_bf16(b.x - bf_lo(hw.z), b.y - bf_hi(hw.z)); lw.w = cvt_pk_bf16(b.z - bf_lo(hw.w), b.w - bf_hi(hw.w)); \
            const bf16x8 xh = __builtin_bit_cast(bf16x8, hw), xl = __builtin_bit_cast(bf16x8, lw); \
            const bf16x8 wh = WB[(ks * 4 + kg) * 16 + row], wl = WB[2048 + (ks * 4 + kg) * 16 + row];     \
            acc = __builtin_amdgcn_mfma_f32_16x16x32_bf16(xh, wh, acc, 0, 0, 0); \
            acc = __builtin_amdgcn_mfma_f32_16x16x32_bf16(xl, wh, acc, 0, 0, 0); \
            acc = __builtin_amdgcn_mfma_f32_16x16x32_bf16(xh, wl, acc, 0, 0, 0); } } while (0)
        f32x4 xaA[4], xbA[4], xaB[4], xbB[4]; u32x4 ddA[4], ddB[4];
        ROWS_LOAD(xaA, xbA, ddA, 0);
#pragma unroll 1
        for (int kc = 0; kc < 8; kc += 2) {
            ROWS_LOAD(xaB, xbB, ddB, kc + 1);
            ROWS_PROC(xaA, xbA, ddA, kc);
            if (kc + 2 < 8) ROWS_LOAD(xaA, xbA, ddA, kc + 2);
            ROWS_PROC(xaB, xbB, ddB, kc + 1);
        }
#undef ROWS_LOAD
#undef ROWS_PROC
        ss += __shfl_xor(ss, 16); ss += __shfl_xor(ss, 32);
        const float rstd = 1.0f / sqrtf(ss * (1.f / D) + EPS);
        if (kg == 0) RSTD[r0 + row] = rstd;
#pragma unroll
        for (int r = 0; r < 4; ++r) {
            const float lg = acc[r] * __shfl(rstd, 4 * kg + r);
            const float mx = row16_max(lg);
            const float pe = __expf(lg - mx); const float den = row16_sum(pe);
            AFF[(r0 + 4 * kg + r) * 16 + row] = pe / den;
        }
    }
    __syncthreads();
}

template <int SHIFT, int BITS>
__device__ __forceinline__ void topk_radix_round(const unsigned (&key)[8], unsigned& prefix, unsigned& need, LAS unsigned* hist, LAS unsigned* wtot, LAS unsigned* res, int tid, int lane, int wave) {
    constexpr int NBIN = 1 << BITS, PER = NBIN / 512;
    static_assert(PER >= 1, "at least one bin per thread");
#pragma unroll
    for (int j = 0; j < PER; ++j) hist[tid + 512 * j] = 0u;
    __syncthreads();
    const unsigned hi = (SHIFT + BITS >= 32) ? 0u : (prefix >> ((SHIFT + BITS) & 31));
#pragma unroll
    for (int i = 0; i < 8; ++i) { const unsigned kh = (SHIFT + BITS >= 32) ? 0u : (key[i] >> ((SHIFT + BITS) & 31));
        if (kh == hi) (void)__hip_atomic_fetch_add(&hist[(key[i] >> SHIFT) & (NBIN - 1)], 1u, __ATOMIC_RELAXED, __HIP_MEMORY_SCOPE_WORKGROUP); }
    __syncthreads();
    unsigned loc[PER]; unsigned s = 0;
#pragma unroll
    for (int j = 0; j < PER; ++j) { loc[j] = hist[PER * tid + j]; s += loc[j]; }
    unsigned v = s;
#pragma unroll
    for (int o = 1; o < 64; o <<= 1) { const unsigned tv = (unsigned)__shfl_down((int)v, o); if (lane + o < 64) v += tv; }
    if (lane == 0) wtot[wave] = v;
    __syncthreads();
    unsigned upper = 0;
#pragma unroll
    for (int w = 0; w < 8; ++w) upper += (w > wave) ? wtot[w] : 0u;
    const unsigned suf_incl = v + upper, suf_excl = suf_incl - s;
    {
        unsigned acc = suf_excl, dsel = 0u, above = 0u, found = 0u;
#pragma unroll
        for (int j = PER - 1; j >= 0; --j) { const unsigned hit = (found == 0u && acc + loc[j] >= need) ? 1u : 0u; dsel = hit ? (unsigned)(PER * tid + j) : dsel; above = hit ? acc : above; found |= hit; acc += loc[j]; }
        if (suf_excl < need && need <= suf_incl) { res[0] = dsel; res[1] = above; }
    }
    __syncthreads();
    prefix |= res[0] << SHIFT; need -= res[1];
}
__device__ __forceinline__ void p6_topk(const Ctx& F) {
    LAS unsigned* cnt = (LAS unsigned*)F.lds;
    const float* AFF = (const float*)(F.ws + WS_AFF);
    int* IDX = (int*)(F.ws + WS_IDX); float* GATE = (float*)(F.ws + WS_GATE); unsigned short* INV = (unsigned short*)(F.ws + WS_INV);
    const int lane = F.lane, wave = F.wave, tid = F.tid;
    for (int item = F.bid; item < NB * NE; item += F.G) {
        const int b = item >> 4, e = item & 15;
        unsigned key[8];
#pragma unroll
        for (int i = 0; i < 8; ++i) key[i] = __builtin_bit_cast(unsigned, AFF[((size_t)b * SEQ + 8 * tid + i) * 16 + e]);
        __syncthreads();
        unsigned T = 0u, rem = (unsigned)CAP;
        topk_radix_round<19, 12>(key, T, rem, cnt + 64, cnt + 32, cnt + 48, tid, lane, wave);
        topk_radix_round<9, 10>(key, T, rem, cnt + 64, cnt + 32, cnt + 48, tid, lane, wave);
        topk_radix_round<0, 9>(key, T, rem, cnt + 64, cnt + 32, cnt + 48, tid, lane, wave);
        __syncthreads();
        unsigned pkc = 0;
#pragma unroll
        for (int i = 0; i < 8; ++i) pkc += (key[i] > T ? 1u : 0u) + (key[i] == T ? (1u << 16) : 0u);
        LAS unsigned* sc = cnt + 16;
        unsigned incl = pkc;
#pragma unroll
        for (int o = 1; o < 64; o <<= 1) { const unsigned t = (unsigned)__shfl_up((int)incl, o); if (lane >= o) incl += t; }
        if (lane == 63) sc[wave] = incl;
        __syncthreads();
        unsigned wbase = 0;
#pragma unroll
        for (int w = 0; w < 8; ++w) wbase += (w < wave) ? sc[w] : 0u;
        const unsigned excl = wbase + incl - pkc;
        const int need = (int)rem;
        int eq_rank = (int)(excl >> 16);
        unsigned selm = 0;
#pragma unroll
        for (int i = 0; i < 8; ++i) { bool s = key[i] > T; if (key[i] == T) { s = eq_rank < need; ++eq_rank; } if (s) selm |= 1u << i; }
        int slot = (int)(excl & 0xffffu) + ((int)(excl >> 16) < need ? (int)(excl >> 16) : need);
#pragma unroll
        for (int i = 0; i < 8; ++i) { const int tok = 8 * tid + i; unsigned short iv = 0xFFFFu;
            if (selm & (1u << i)) { IDX[(size_t)item * CAP + slot] = tok; GATE[(size_t)item * CAP + slot] = __builtin_bit_cast(float, key[i]); iv = (unsigned short)slot; ++slot; }
            INV[((size_t)b * SEQ + tok) * 16 + e] = iv; }
        __syncthreads();
    }
}

struct Sched7 {
    const char* H2; const char* WG; const int* IDX; int G, c;
    __device__ __forceinline__ bool next(int i, Unit& u) const {
        if (i >= 16) return false;
        const int e = i, x = c & 7, j = c >> 3;
        const int mt = (x >> 1) * 4 + (j & 3), nt = (x & 1) * 8 + (j >> 2);
        const int b = mt >> 1;
        u.A = H2 + (size_t)b * SEQ * D; u.B = WG + ((size_t)e * 4096 + (size_t)nt * 256) * D;
        u.ridx = IDX + ((size_t)(b * NE + e) * CAP + (mt & 1) * 256); u.pm = e * 16 + mt; u.pn = nt; u.kind = 0; return true;
    }
};
struct Epi7 {
    static constexpr bool PERM = true;
    unsigned char* H; const float* RSTD;
    __device__ __forceinline__ bool operator()(f32x4 (&acc)[2][2][4][2], const Unit& u, int wr, int wc, int fr, int fq) const {
        const int row0 = u.pm * 256 + wr * 64 + fr, col0 = u.pn * 128 + wc * 32 + 8 * fq;
        const int b = (u.pm & 15) >> 1;
        int tok[8]; float rs[8]; u32x2 wp = (u32x2){0u, 0u};
        const int rowq = row0 + (fq & 1) * 16, colq = u.pn * 128 + wc * 32 + 16 * (fq >> 1);
#pragma unroll
        for (int i = 0; i < 8; ++i) tok[i] = u.ridx[(i >> 2) * 128 + wr * 64 + (i & 3) * 16 + fr];
#pragma unroll
        for (int i = 0; i < 8; ++i) rs[i] = RSTD[(size_t)b * SEQ + tok[i]];
#pragma unroll
        for (int ai = 0; ai < 2; ++ai)
#pragma unroll
            for (int m = 0; m < 4; ++m) {
                const float ws = rs[ai * 4 + m] * (1.0f / W8_SCALE); const float k1 = -1.44269504089f * ws, k2 = ws * ws * H8_SCALE;
                float r[8];
#pragma unroll
                for (int n = 0; n < 2; ++n)
#pragma unroll
                    for (int j2 = 0; j2 < 2; ++j2) { const f32x2 a = (f32x2){acc[ai][0][m][n][2 * j2], acc[ai][0][m][n][2 * j2 + 1]}, g = (f32x2){acc[ai][1][m][n][2 * j2], acc[ai][1][m][n][2 * j2 + 1]};
                        const f32x2 t = a * k1; f32x2 e; e.x = __builtin_amdgcn_exp2f(t.x); e.y = __builtin_amdgcn_exp2f(t.y);
                        const f32x2 d = e + 1.0f; f32x2 sg; sg.x = __builtin_amdgcn_rcpf(d.x); sg.y = __builtin_amdgcn_rcpf(d.y);
                        const f32x2 o = ((a * g) * sg) * k2; r[n * 4 + 2 * j2] = o.x; r[n * 4 + 2 * j2 + 1] = o.y; }
                u32x2 w; w.x = pk4_fp8(r[0], r[1], r[2], r[3]); w.y = pk4_fp8(r[4], r[5], r[6], r[7]);
                if (m & 1) *(u32x4*)(H + (size_t)(rowq + ai * 128 + (m - 1) * 16) * DFF + colq) = widen16(wp, w); else wp = w; }
        return false;
    }
};

struct Sched8 {
    const char* H; const char* WD; int G, c;
    __device__ __forceinline__ bool next(int i, Unit& u) const {
        if (i >= 4) return false;
        const int x = c & 7, j = c >> 3;
        const int e = i * 4 + (x >> 1), mt = (x & 1) * 8 + (j & 7), nt = j >> 3;
        u.A = H + ((size_t)e * 4096 + (size_t)mt * 256) * DFF; u.B = WD + ((size_t)e * D + (size_t)nt * 256) * DFF; u.ridx = nullptr; u.pm = e * 16 + mt; u.pn = nt; u.kind = 0; return true;
    }
};
struct Epi8 {
    static constexpr bool PERM = true;
    unsigned char* Y; const float* GATE;
    __device__ __forceinline__ bool operator()(f32x4 (&acc)[2][2][4][2], const Unit& u, int wr, int wc, int fr, int fq) const {
        const int e = u.pm >> 4, mt = u.pm & 15, b = mt >> 1;
        const int rl0 = (mt & 1) * 256 + wr * 64 + fr;
        const int col0 = u.pn * 256 + wc * 32 + 8 * fq;
        float gv[8];
#pragma unroll
        for (int i = 0; i < 8; ++i) gv[i] = GATE[(size_t)(b * NE + e) * CAP + rl0 + (i >> 2) * 128 + (i & 3) * 16] * (Y8_SCALE / (W8_SCALE * H8_SCALE));
        u32x2 wp[2] = {(u32x2){0u, 0u}, (u32x2){0u, 0u}};
        const int rlq = rl0 + (fq & 1) * 16, colq = u.pn * 256 + wc * 32 + 16 * (fq >> 1);
#pragma unroll
        for (int ai = 0; ai < 2; ++ai)
#pragma unroll
            for (int m = 0; m < 4; ++m) { const float g = gv[ai * 4 + m];
                unsigned char* rowp = Y + ((size_t)e * 4096 + (size_t)b * CAP + rlq + ai * 128 + (m - 1) * 16) * D + colq;
#pragma unroll
                for (int bj = 0; bj < 2; ++bj) { const f32x4 v0 = acc[ai][bj][m][0] * g, v1 = acc[ai][bj][m][1] * g;
                    u32x2 w; w.x = pk4_fp8(v0[0], v0[1], v0[2], v0[3]); w.y = pk4_fp8(v1[0], v1[1], v1[2], v1[3]);
                    if (m & 1) *(u32x4*)(rowp + bj * 128) = widen16(wp[bj], w); else wp[bj] = w; } }
        return false;
    }
};

__device__ __forceinline__ void p9_final(const Ctx& F) {
    const int gw = F.bid * 8 + F.wave, NGW = F.G * 8, lane = F.lane;
    const unsigned short* INV = (const unsigned short*)(F.ws + WS_INV); const unsigned char* Y = (const unsigned char*)(F.ws + WS_RA); const bf16_t* DLT = (const bf16_t*)(F.ws + WS_DLT);
    f32x4 gg[4];
#pragma unroll
    for (int j = 0; j < 4; ++j) gg[j] = ((const f32x4*)F.final_g)[64 * j + lane];
    for (int m2 = gw; m2 < MTOK / 2; m2 += NGW) {
        const int m = m2 * 2, b = m >> 12;
        const f32x4* xr = (const f32x4*)(F.x + (size_t)m * D) + lane; const u32x2* dr = (const u32x2*)(DLT + (size_t)m * D) + lane;
        f32x4* orow = (f32x4*)(F.out + (size_t)m * D) + lane;
        f32x4 v[2][4]; u32x2 dl[2][4];
#pragma unroll
        for (int r = 0; r < 2; ++r)
#pragma unroll
            for (int j = 0; j < 4; ++j) { v[r][j] = __builtin_nontemporal_load(xr + r * 256 + 64 * j); dl[r][j] = __builtin_nontemporal_load(dr + r * 256 + 64 * j); }
        const unsigned myinv = INV[(size_t)m * 16 + (lane & 31)];
#pragma unroll
        for (int r = 0; r < 2; ++r)
#pragma unroll
            for (int j = 0; j < 4; ++j) { v[r][j].x += bf_lo(dl[r][j].x); v[r][j].y += bf_hi(dl[r][j].x); v[r][j].z += bf_lo(dl[r][j].y); v[r][j].w += bf_hi(dl[r][j].y); }
        f32x4 ys[2][4];
#pragma unroll
        for (int r = 0; r < 2; ++r)
#pragma unroll
            for (int j = 0; j < 4; ++j) ys[r][j] = (f32x4){0.f, 0.f, 0.f, 0.f};
#pragma unroll 1
        for (int e = 0; e < 16; ++e) {
#pragma unroll
            for (int r = 0; r < 2; ++r) {
                const unsigned sl = (unsigned)__builtin_amdgcn_readlane((int)myinv, e + 16 * r);
                if (sl != 0xFFFFu) {
                    const unsigned* yr = (const unsigned*)(Y + ((size_t)e * 4096 + (size_t)b * CAP + sl) * D) + lane;
#pragma unroll
                    for (int j = 0; j < 4; ++j) { const unsigned w = __builtin_nontemporal_load(yr + 64 * j); const f32x2 lo = __builtin_amdgcn_cvt_pk_f32_fp8((int)w, false), hi = __builtin_amdgcn_cvt_pk_f32_fp8((int)w, true);
                        ys[r][j].x += lo.x; ys[r][j].y += lo.y; ys[r][j].z += hi.x; ys[r][j].w += hi.y; }
                }
            }
        }
#pragma unroll
        for (int r = 0; r < 2; ++r) {
            float s = 0.f;
#pragma unroll
            for (int j = 0; j < 4; ++j) { v[r][j] = v[r][j] + ys[r][j] * (1.0f / Y8_SCALE); s += (v[r][j].x * v[r][j].x + v[r][j].y * v[r][j].y) + (v[r][j].z * v[r][j].z + v[r][j].w * v[r][j].w); }
            const float rstd = 1.0f / sqrtf(wave_sum(s) * (1.f / D) + EPS);
#pragma unroll
            for (int j = 0; j < 4; ++j) __builtin_nontemporal_store(v[r][j] * rstd * gg[j], orow + r * 256 + 64 * j);
        }
    }
}

__global__ void __launch_bounds__(512, 2) mk_fwd(Args args) {
    extern __shared__ __attribute__((aligned(16))) unsigned char lds_raw[];
    cg::grid_group grid = cg::this_grid();
    Ctx F;
    F.lds = (LAS unsigned char*)lds_raw;
    F.tid = threadIdx.x; F.lane = F.tid & 63; F.wave = __builtin_amdgcn_readfirstlane(F.tid >> 6); F.G = gridDim.x; F.bid = blockIdx.x;
    F.x = args.in[0]; F.norm1_g = args.in[1]; F.w_in = args.in[2]; F.ln_g = args.in[3]; F.ln_b = args.in[4]; F.w_sp = args.in[5]; F.b_sp = args.in[6];
    F.w_fo = args.in[7]; F.w_so = args.in[8]; F.w_out = args.in[9]; F.norm2_g = args.in[10]; F.w_router = args.in[11]; F.w_gate = args.in[12]; F.w_up = args.in[13];
    F.w_down = args.in[14]; F.final_g = args.in[15]; F.out = args.out; F.ws = args.ws;
    const unsigned pm_ = args.ph_mask;
    unsigned char* ws = args.ws;
    if (F.tid < 2) ((LAS unsigned*)(F.lds + LDS_MISC))[F.tid] = 0u;
    __syncthreads();
    if (args.pad == 0x5eedu) grid.sync();
    const XcdBarrier xbar = xcd_barrier_post((unsigned*)(ws + WS_CTL), (volatile LAS unsigned*)(F.lds + LDS_MISC));
#ifndef PROBE_PHASE
#define PROBE_PHASE -1
#endif
    volatile LAS unsigned long long* stamps_ = (volatile LAS unsigned long long*)(F.lds + LDS_BYTES - 256);
#define STAMP(k) do { if (PROBE_PHASE >= 0 && F.bid == 0 && F.tid == 0) stamps_[k] = __builtin_amdgcn_s_memrealtime(); } while (0)
#ifndef PH_CT_MASK
#define PH_CT_MASK 0xffffu
#endif
#define RUN(k) ((((PH_CT_MASK) >> (k)) & 1u) && ((pm_ >> (k)) & 1u))
#define SEAM(k) do { if ((pm_ & ((2u << (k)) - 1u)) && (pm_ >> ((k) + 1))) { xcd_barrier(xbar); } } while (0)
    STAMP(0); if ((F.bid & 1) && RUN(2)) p0_prep(F, 4);
    if (RUN(0)) p0_prep(F, 1); STAMP(1); if (RUN(1)) p0_prep(F, 2); STAMP(2); if (!(F.bid & 1) && RUN(2)) p0_prep(F, 4); STAMP(3); if (RUN(3)) p0_prep(F, 8);
    int sgu_h_pre = -1; bool rows_pre = false;
    SEAM(3); STAMP(4);
    if (RUN(4)) {
        const int nk = (8192 + F.G * 8 - 1) / (F.G * 8);
        weight_filler(F, 0, 0, (F.bid & 1) ? nk - 1 : 0);
        Sched1 S{(const char*)(ws + WS_HN), (const char*)(ws + WS_WIN), F.G, F.bid}; Epi1 E{ws};
        pg8::gemm_phase<Epi1, Sched1, false>(F.lds, D, S, E);
        weight_filler_pool(F, 0, (unsigned*)(ws + WS_CTL + 4096), nk - 1);
        if (RUN(5)) sgu_h_pre = p2_sgu_prefill(F);
    }
    SEAM(4); STAMP(5);
    if (RUN(5)) p2_sgu(F, sgu_h_pre);
    STAMP(6);
    if (RUN(6)) fft_stage_a(F);
    SEAM(6); STAMP(7);
    if (RUN(7)) fft_stage<1>(F);
    SEAM(7); STAMP(8);
    if (RUN(8)) {
        Sched3 S{(const char*)(ws + WS_FM), (const char*)(ws + WS_SG), (const char*)(ws + WS_WFO), (const char*)(ws + WS_WSO), F.G, F.bid};
        Epi3 E{(const bf16_t*)(ws + WS_SGF), (const bf16_t*)(ws + WS_SGS), (bf16_t*)(ws + WS_MRG)};
        const int nk = (8192 + F.G * 8 - 1) / (F.G * 8);
        weight_filler(F, 1, 0, (F.bid & 1) ? nk - 1 : 0);
        pg8::gemm_phase<Epi3, Sched3, false>(F.lds, 512, S, E);
        weight_filler_pool(F, 1, (unsigned*)(ws + WS_CTL + 4160), nk - 1);
    }
    SEAM(8); STAMP(9);
    if (RUN(9)) {
        Sched4 S{(const char*)(ws + WS_MRG), (const char*)(ws + WS_WOUT), F.G, F.bid}; Epi4 E{(bf16_t*)(ws + WS_DLT)};
        const int nk = (8192 + F.G * 8 - 1) / (F.G * 8);
        weight_filler(F, 2, 0, (F.bid & 1) ? nk - 1 : 0);
        pg8::gemm_phase<Epi4, Sched4, false>(F.lds, D, S, E);
        weight_filler_pool(F, 2, (unsigned*)(ws + WS_CTL + 4224), nk - 1);
        if (RUN(11)) { p5_rows_prefill(F); rows_pre = true; }
    }
    SEAM(9); STAMP(10);
    if (RUN(10)) p5_rows(F, 1);
    STAMP(11);
    if (RUN(11)) p5_rows(F, 2, rows_pre);
    SEAM(11); STAMP(12);
    if (RUN(12)) p6_topk(F);
    SEAM(12); STAMP(13);
    if (RUN(13)) {
        Sched7 S{(const char*)(ws + WS_H2), (const char*)(ws + WS_WGU), (const int*)(ws + WS_IDX), F.G, F.bid}; Epi7 E{(unsigned char*)(ws + WS_H), (const float*)(ws + WS_RSTD)};
        pg8::gemm_phase<Epi7, Sched7, true, true>(F.lds, D / 2, S, E);
    }
    SEAM(13); STAMP(14);
    if (RUN(14)) {
        Sched8 S{(const char*)(ws + WS_H), (const char*)(ws + WS_WD), F.G, F.bid}; Epi8 E{(unsigned char*)(ws + WS_RA), (const float*)(ws + WS_GATE)};
        pg8::gemm_phase<Epi8, Sched8, false, true>(F.lds, DFF / 2, S, E);
    }
    SEAM(14); STAMP(15);
    if (RUN(15)) p9_final(F);
    STAMP(16);
    if (PROBE_PHASE >= 0 && F.bid == 0 && F.tid == 0) { const unsigned long long dt = 4ull * (stamps_[PROBE_PHASE + 1] - stamps_[PROBE_PHASE]), t0 = __builtin_amdgcn_s_memrealtime();
        while (__builtin_amdgcn_s_memrealtime() - t0 < dt) __builtin_amdgcn_s_sleep(32); }
#undef RUN
#undef SEAM
}

extern "C" void kernel_launch(void* const* d_in, const int* in_sizes, int n_in, void* d_out, int out_size, void* d_ws, size_t ws_size, hipStream_t stream) {
    static int grid = 0;
    if (grid == 0) {
        if (n_in != 16 || out_size != MTOK * D || ws_size < WS_END) { fprintf(stderr, "kernel_launch: unexpected shapes (n_in %d, out %d, ws %zu < %zu)\n", n_in, out_size, ws_size, (size_t)WS_END); grid = -1; return; }
        int dev = 0, cus = 0, per_cu = 0;
        if (hipGetDevice(&dev) != hipSuccess || hipDeviceGetAttribute(&cus, hipDeviceAttributeMultiprocessorCount, dev) != hipSuccess) { grid = -1; return; }
        if (hipFuncSetAttribute((const void*)mk_fwd, hipFuncAttributeMaxDynamicSharedMemorySize, LDS_BYTES) != hipSuccess) { fprintf(stderr, "kernel_launch: hipFuncSetAttribute failed\n"); grid = -1; return; }
        if (hipOccupancyMaxActiveBlocksPerMultiprocessor(&per_cu, (const void*)mk_fwd, 512, LDS_BYTES) != hipSuccess || per_cu < 1) { fprintf(stderr, "kernel_launch: occupancy query failed (%d)\n", per_cu); grid = -1; return; }
        if (per_cu > 1) per_cu = 1;
        grid = cus * per_cu;
        if (grid != 256) fprintf(stderr, "kernel_launch: note: grid %d (tile orders are tuned for 256)\n", grid);
    }
    if (grid < 0) return;
    if (hipMemsetAsync((char*)d_ws + WS_CTL, 0, CTL_BYTES, stream) != hipSuccess) { fprintf(stderr, "kernel_launch: hipMemsetAsync failed\n"); return; }
    Args a{};
    for (int i = 0; i < 16; ++i) a.in[i] = (const float*)d_in[i];
    a.out = (float*)d_out; a.ws = (unsigned char*)d_ws;
#if MK_N_LAUNCHES == 1
    a.ph_mask = 0xffffu;
    void* kargs[] = {&a};
    hipError_t e = hipLaunchCooperativeKernel((const void*)mk_fwd, dim3(grid), dim3(512), kargs, LDS_BYTES, stream);
    if (e != hipSuccess) fprintf(stderr, "kernel_launch: cooperative launch failed: %s (grid %d)\n", hipGetErrorString(e), grid);
#else
#ifndef PROBE_DUP
#define PROBE_DUP 0
#endif
    for (int p = 0; p < 16; ++p) {
        const int reps = ((PROBE_DUP >> p) & 1) ? 2 : 1;
        for (int r = 0; r < reps; ++r) { a.ph_mask = 1u << p; hipLaunchKernelGGL(mk_fwd, dim3(grid), dim3(512), LDS_BYTES, stream, a); }
    }
#endif
}
```
